# Optimizing an MI355X kernel written in HIP

```python
import jax
import jax.numpy as jnp
from jax import lax
import numpy as np

D_MODEL = 2048
BATCH = 2
SEQ = 4096
DEPTH = 2

GRID_W = 64
CTX_LEN = 256
EPS = 1e-6
N_MOD = 6
N_DIR = 2
GROUP_W = D_MODEL // 4

SC_WIDTH = GROUP_W
CM_WIDTH = GROUP_W
CM_GROUPS = 4
CM_GROUP_DIM = CM_WIDTH // CM_GROUPS
CM_CHUNK = 128
MB_INNER = GROUP_W
MB_HEAD_DIM = 64
MB_HEADS = MB_INNER // MB_HEAD_DIM
MB_GROUPS = 2
MB_STATE = 128
MB_BC = MB_GROUPS * MB_STATE
MB_CONV_DIM = MB_INNER + 2 * MB_BC
SSD_CHUNK = 128
GLA_HEADS = 4
GLA_V = GROUP_W
GLA_QK = GLA_V // 2
GLA_DK = GLA_QK // GLA_HEADS
GLA_DV = GLA_V // GLA_HEADS
GLA_RANK = 16
GLA_GATE_NORM = 16.0
GLA_CHUNK = 64

P_SC = 3 * SC_WIDTH
P_CM = 2 * CM_WIDTH
P_MB = MB_INNER + MB_CONV_DIM + N_DIR * MB_HEADS
P_GLA = 2 * GLA_QK + 2 * GLA_V + N_DIR * GLA_RANK
P_TOTAL = P_SC + P_CM + P_MB + P_GLA
REC_OFF = P_SC + P_CM
SPLITS = [P_SC, P_SC + P_CM, P_SC + P_CM + P_MB]
D_MIX = SC_WIDTH + CM_WIDTH + MB_INNER + GLA_V
GLA_SPLITS = [GLA_QK, 2 * GLA_QK, 2 * GLA_QK + GLA_V, 2 * GLA_QK + 2 * GLA_V]

D_FF = ((8 * D_MODEL // 3 + 255) // 256) * 256
N_EXPERTS = 8
TOP_K = 2
D_FF_EXPERT = 7 * D_MODEL // 2
N_DENSE = (DEPTH + 1) // 2
N_MOE = DEPTH // 2

kernel_name = "hybrid_parallel_mixer_dit_block"


def rmsnorm(t, g):
    tf = t.astype(jnp.float32)
    tf = tf * lax.rsqrt(jnp.mean(tf * tf, axis=-1, keepdims=True) + EPS)
    return (tf * g.astype(jnp.float32)).astype(t.dtype)


def modulate(t, shift, scale):
    return t * (1 + scale) + shift


def _dir(t, d):
    return t if d == 0 else jnp.flip(t, axis=1)


def conv3(t, w, rows):
    b, L, ch = t.shape
    tp = jnp.pad(t.reshape(b, rows, L // rows, ch), ((0, 0), (0, 0), (1, 1), (0, 0)))
    y = tp[:, :, :-2] * w[0] + tp[:, :, 1:-1] * w[1] + tp[:, :, 2:] * w[2]
    return y.reshape(b, L, ch)


def short_conv_mixer(p, w, rows):
    bg, cg, xa = jnp.split(p, 3, axis=-1)
    return bg * conv3(cg * xa, w, rows)


def chunk_mlp_mixer(p, w_s, b_s):
    b, L, _ = p.shape
    u, v = jnp.split(jax.nn.gelu(p), 2, axis=-1)
    v = v.reshape(b, L // CM_CHUNK, CM_CHUNK, CM_GROUPS, CM_GROUP_DIM)
    s = jnp.einsum('gij,bcjgd->bcigd', w_s, v) + b_s.T[:, :, None]
    return u * s.reshape(b, L, CM_WIDTH)


def ssd_scan(xs, dt, a_neg, bm, cm, s0, return_y):
    b, L, h, p = xs.shape
    g, n = bm.shape[2], bm.shape[3]
    q = SSD_CHUNK
    nc = L // q
    bh = jnp.repeat(bm, h // g, axis=2).reshape(b, nc, q, h, n)
    xc = xs.reshape(b, nc, q, h, p)
    dtc = dt.reshape(b, nc, q, h)
    acs = jnp.cumsum(dtc * a_neg, axis=2)
    a_last = acs[:, :, -1]
    w_end = jnp.exp(a_last[:, :, None] - acs) * dtc
    chunk_states = jnp.einsum('bcjhn,bcjh,bcjhp->bchpn', bh, w_end, xc)

    def step(s, inp):
        st, al = inp
        return jnp.exp(al)[:, :, None, None] * s + st, s

    s_fin, s_start = lax.scan(step, s0, (jnp.moveaxis(chunk_states, 1, 0), jnp.moveaxis(a_last, 1, 0)))
    if not return_y:
        return s_fin
    s_start = jnp.moveaxis(s_start, 0, 1)
    ch = jnp.repeat(cm, h // g, axis=2).reshape(b, nc, q, h, n)
    acs_t = jnp.moveaxis(acs, 3, 2)
    seg = acs_t[..., :, None] - acs_t[..., None, :]
    lower = jnp.tril(jnp.ones((q, q), dtype=bool))
    decay = jnp.exp(jnp.where(lower, seg, -jnp.inf))
    scores = jnp.einsum('bcihn,bcjhn->bchij', ch, bh) * decay * jnp.moveaxis(dtc, 3, 2)[:, :, :, None, :]
    y = (jnp.einsum('bchij,bcjhp->bcihp', scores, xc)
         + jnp.einsum('bcihn,bchpn->bcihp', ch, s_start) * jnp.exp(acs)[..., None])
    return y.reshape(b, L, h, p), s_fin


def mamba_prep(p, conv_w, conv_b, dt_bias, rows):
    b, L, _ = p.shape
    z, xbc, dt = jnp.split(p, [MB_INNER, MB_INNER + MB_CONV_DIM], axis=-1)
    xbc = jax.nn.silu(conv3(xbc, conv_w, rows) + conv_b)
    xs, bm, cm = jnp.split(xbc, [MB_INNER, MB_INNER + MB_BC], axis=-1)
    xs = xs.astype(jnp.float32).reshape(b, L, MB_HEADS, MB_HEAD_DIM)
    bm = bm.astype(jnp.float32).reshape(b, L, MB_GROUPS, MB_STATE)
    cm = cm.astype(jnp.float32).reshape(b, L, MB_GROUPS, MB_STATE)
    dt = jax.nn.softplus(dt.astype(jnp.float32).reshape(b, L, N_DIR, MB_HEADS) + dt_bias.astype(jnp.float32))
    return z, xs, bm, cm, dt


def mamba_out(y, z, norm_g):
    b, L = z.shape[:2]
    y = y.reshape(b, L, MB_INNER) * jax.nn.silu(z.astype(jnp.float32))
    return rmsnorm(y, norm_g).astype(z.dtype)


def mamba_mixer(p, pc, conv_w, conv_b, a_log, dt_bias, d_skip, norm_g, rows, ctx_out):
    z, xs, bm, cm, dt = mamba_prep(p, conv_w, conv_b, dt_bias, rows)
    zc, xsc, bmc, cmc, dtc = mamba_prep(pc, conv_w, conv_b, dt_bias, 1)
    s0 = jnp.zeros((p.shape[0], MB_HEADS, MB_HEAD_DIM, MB_STATE), jnp.float32)
    y, yc = 0.0, 0.0
    for d in range(N_DIR):
        a_neg = -jnp.exp(a_log[d].astype(jnp.float32))
        skip = d_skip[d].astype(jnp.float32)[:, None]
        ctx_args = (_dir(xsc, d), _dir(dtc[:, :, d], d), a_neg, _dir(bmc, d), _dir(cmc, d), s0)
        if ctx_out:
            yc_d, s_ctx = ssd_scan(*ctx_args, True)
            yc = yc + _dir(yc_d, d) + xsc * skip
        else:
            s_ctx = ssd_scan(*ctx_args, False)
        y_d, _ = ssd_scan(_dir(xs, d), _dir(dt[:, :, d], d), a_neg, _dir(bm, d), _dir(cm, d), s_ctx, True)
        y = y + _dir(y_d, d) + xs * skip
    return mamba_out(y, z, norm_g), (mamba_out(yc, zc, norm_g) if ctx_out else None)


def gla_scan(q, k, v, gk, s0, return_y):
    b, L, h, dk = k.shape
    dv = v.shape[-1]
    qn = GLA_CHUNK
    nc = L // qn
    kc = k.reshape(b, nc, qn, h, dk)
    vc = v.reshape(b, nc, qn, h, dv)
    G = jnp.cumsum(gk.reshape(b, nc, qn, h, dk), axis=2)
    G_last = G[:, :, -1]
    chunk_states = jnp.einsum('bcjhk,bcjhv->bchkv', kc * jnp.exp(G_last[:, :, None] - G), vc)

    def step(s, inp):
        st, gl = inp
        return jnp.exp(gl)[..., None] * s + st, s

    s_fin, s_start = lax.scan(step, s0, (jnp.moveaxis(chunk_states, 1, 0), jnp.moveaxis(G_last, 1, 0)))
    if not return_y:
        return s_fin
    s_start = jnp.moveaxis(s_start, 0, 1)
    qc = q.reshape(b, nc, qn, h, dk)
    y_inter = jnp.einsum('bcihk,bchkv->bcihv', qc * jnp.exp(G), s_start)
    G_ref = G[:, :, qn // 2][:, :, None]
    att = jnp.einsum('bcihk,bcjhk->bchij', qc * jnp.exp(G - G_ref), kc * jnp.exp(G_ref - G))
    lower = jnp.tril(jnp.ones((qn, qn), dtype=bool))
    att = jnp.where(lower, att, 0.0)
    y = y_inter + jnp.einsum('bchij,bcjhv->bcihv', att, vc)
    return y.reshape(b, L, h, dv), s_fin


def gla_prep(p, w_gate, b_gate):
    b, L, _ = p.shape
    q, k, v, g, glr = jnp.split(p, GLA_SPLITS, axis=-1)
    q = q.astype(jnp.float32).reshape(b, L, GLA_HEADS, GLA_DK) * GLA_DK ** -0.5
    k = k.astype(jnp.float32).reshape(b, L, GLA_HEADS, GLA_DK)
    v = v.astype(jnp.float32).reshape(b, L, GLA_HEADS, GLA_DV)
    glr = glr.astype(jnp.float32).reshape(b, L, N_DIR, GLA_RANK)
    gk = jax.nn.log_sigmoid(jnp.einsum('bldr,drk->bldk', glr, w_gate.astype(jnp.float32))
                            + b_gate.astype(jnp.float32)) / GLA_GATE_NORM
    return q, k, v, gk.reshape(b, L, N_DIR, GLA_HEADS, GLA_DK), g


def gla_out(o, g, norm_g):
    b, L = g.shape[:2]
    return (rmsnorm(o, norm_g).reshape(b, L, GLA_V) * jax.nn.silu(g.astype(jnp.float32))).astype(g.dtype)


def gla_mixer(p, pc, w_gate, b_gate, norm_g, ctx_out):
    q, k, v, gk, g = gla_prep(p, w_gate, b_gate)
    qc, kc, vc, gkc, gc = gla_prep(pc, w_gate, b_gate)
    s0 = jnp.zeros((p.shape[0], GLA_HEADS, GLA_DK, GLA_DV), jnp.float32)
    o, oc = 0.0, 0.0
    for d in range(N_DIR):
        if ctx_out:
            oc_d, s_ctx = gla_scan(_dir(qc, d), _dir(kc, d), _dir(vc, d), _dir(gkc[:, :, d], d), s0, True)
            oc = oc + _dir(oc_d, d)
        else:
            s_ctx = gla_scan(None, _dir(kc, d), _dir(vc, d), _dir(gkc[:, :, d], d), s0, False)
        o_d, _ = gla_scan(_dir(q, d), _dir(k, d), _dir(v, d), _dir(gk[:, :, d], d), s_ctx, True)
        o = o + _dir(o_d, d)
    return gla_out(o, g, norm_g), (gla_out(oc, gc, norm_g) if ctx_out else None)


def swiglu(t, wg, wu, wd):
    return (jax.nn.silu(t @ wg) * (t @ wu)) @ wd


def moe_swiglu(t, w_router, wg, wu, wd):
    b, L, d = t.shape
    tf = t.reshape(b * L, d)
    logits = (tf @ w_router).astype(jnp.float32)
    top_v, top_i = lax.top_k(logits, TOP_K)
    top_w = jax.nn.softmax(top_v, axis=-1)
    gates = jnp.sum(jax.nn.one_hot(top_i, N_EXPERTS, dtype=jnp.float32) * top_w[..., None], axis=1).astype(t.dtype)
    out = jnp.zeros_like(tf)
    for e in range(N_EXPERTS):
        out = out + gates[:, e:e + 1] * swiglu(tf, wg[e], wu[e], wd[e])
    return out.reshape(b, L, d)


def setup_inputs(seed: int = 0) -> dict:
    key = jax.random.key(seed)
    ks = iter(jax.random.split(key, 32))
    f32 = jnp.float32

    def nrm(shape, scale):
        return jax.random.normal(next(ks), shape, f32) * scale

    def gain(shape):
        return 1.0 + nrm(shape, 0.02)

    dt0 = jnp.exp(jax.random.uniform(next(ks), (DEPTH, N_DIR, MB_HEADS), f32, np.log(1e-3), np.log(1e-1)))
    return {
        "x": nrm((BATCH, SEQ, D_MODEL), 1.0),
        "c": nrm((BATCH, D_MODEL), 1.0),
        "ctx": nrm((BATCH, CTX_LEN, D_MODEL), 1.0),
        "c_ctx": nrm((D_MODEL,), 1.0),
        "w_ada": nrm((DEPTH, D_MODEL, N_MOD * D_MODEL), 0.5 * D_MODEL ** -0.5),
        "b_ada": nrm((DEPTH, N_MOD * D_MODEL), 0.01),
        "g_mix": gain((DEPTH, D_MODEL)),
        "g_ffn": gain((DEPTH, D_MODEL)),
        "w_in": nrm((DEPTH, D_MODEL, P_TOTAL), D_MODEL ** -0.5),
        "w_out": nrm((DEPTH, D_MIX, D_MODEL), D_MIX ** -0.5),
        "sc_conv_w": nrm((DEPTH, 3, SC_WIDTH), 3 ** -0.5),
        "cm_w_s": nrm((DEPTH, CM_GROUPS, CM_CHUNK, CM_CHUNK), CM_CHUNK ** -0.5),
        "cm_b_s": 1.0 + nrm((DEPTH, CM_GROUPS, CM_CHUNK), 0.01),
        "mb_conv_w": nrm((DEPTH, 3, MB_CONV_DIM), 3 ** -0.5),
        "mb_conv_b": nrm((DEPTH, MB_CONV_DIM), 0.01),
        "mb_a_log": jnp.log(jax.random.uniform(next(ks), (DEPTH, N_DIR, MB_HEADS), f32, 1.0, 16.0)),
        "mb_dt_bias": dt0 + jnp.log(-jnp.expm1(-dt0)),
        "mb_d": 1.0 + nrm((DEPTH, N_DIR, MB_HEADS), 0.1),
        "mb_norm_g": gain((DEPTH, MB_INNER)),
        "gla_w_gate": nrm((DEPTH, N_DIR, GLA_RANK, GLA_QK), GLA_RANK ** -0.5),
        "gla_b_gate": nrm((DEPTH, N_DIR, GLA_QK), 0.1),
        "gla_norm_g": gain((DEPTH, GLA_DV)),
        "ffn_w_gate": nrm((N_DENSE, D_MODEL, D_FF), D_MODEL ** -0.5),
        "ffn_w_up": nrm((N_DENSE, D_MODEL, D_FF), D_MODEL ** -0.5),
        "ffn_w_down": nrm((N_DENSE, D_FF, D_MODEL), D_FF ** -0.5),
        "moe_router": nrm((N_MOE, D_MODEL, N_EXPERTS), D_MODEL ** -0.5),
        "moe_w_gate": nrm((N_MOE, N_EXPERTS, D_MODEL, D_FF_EXPERT), D_MODEL ** -0.5),
        "moe_w_up": nrm((N_MOE, N_EXPERTS, D_MODEL, D_FF_EXPERT), D_MODEL ** -0.5),
        "moe_w_down": nrm((N_MOE, N_EXPERTS, D_FF_EXPERT, D_MODEL), D_FF_EXPERT ** -0.5),
        "g_final": gain((D_MODEL,)),
    }


def reference(x, c, ctx, c_ctx, w_ada, b_ada, g_mix, g_ffn, w_in, w_out, sc_conv_w, cm_w_s, cm_b_s,
              mb_conv_w, mb_conv_b, mb_a_log, mb_dt_bias, mb_d, mb_norm_g, gla_w_gate, gla_b_gate, gla_norm_g,
              ffn_w_gate, ffn_w_up, ffn_w_down, moe_router, moe_w_gate, moe_w_up, moe_w_down, g_final):
    rows = x.shape[1] // GRID_W
    h, hc = x, ctx
    s_c = jax.nn.silu(c)
    s_cc = jax.nn.silu(c_ctx)

    def channel_mixer(i, t):
        j = i // 2
        if i % 2 == 0:
            return swiglu(t, ffn_w_gate[j], ffn_w_up[j], ffn_w_down[j])
        return moe_swiglu(t, moe_router[j], moe_w_gate[j], moe_w_up[j], moe_w_down[j])

    for i in range(DEPTH):
        last = i == DEPTH - 1
        mod = jnp.split((s_c @ w_ada[i] + b_ada[i])[:, None, :], N_MOD, axis=-1)
        mod_c = jnp.split(s_cc @ w_ada[i] + b_ada[i], N_MOD, axis=-1)
        xn = modulate(rmsnorm(h, g_mix[i]), mod[0], mod[1])
        xcn = modulate(rmsnorm(hc, g_mix[i]), mod_c[0], mod_c[1])
        p_sc, p_cm, p_mb, p_gla = jnp.split(xn @ w_in[i], SPLITS, axis=-1)
        if last:
            pc_mb, pc_gla = jnp.split(xcn @ w_in[i][:, REC_OFF:], [P_MB], axis=-1)
        else:
            pc_sc, pc_cm, pc_mb, pc_gla = jnp.split(xcn @ w_in[i], SPLITS, axis=-1)
        y_mb, yc_mb = mamba_mixer(p_mb, pc_mb, mb_conv_w[i], mb_conv_b[i], mb_a_log[i], mb_dt_bias[i],
                                  mb_d[i], mb_norm_g[i], rows, not last)
        y_gla, yc_gla = gla_mixer(p_gla, pc_gla, gla_w_gate[i], gla_b_gate[i], gla_norm_g[i], not last)
        y = jnp.concatenate([short_conv_mixer(p_sc, sc_conv_w[i], rows),
                             chunk_mlp_mixer(p_cm, cm_w_s[i], cm_b_s[i]), y_mb, y_gla], axis=-1)
        h = h + mod[2] * (y @ w_out[i])
        h = h + mod[5] * channel_mixer(i, modulate(rmsnorm(h, g_ffn[i]), mod[3], mod[4]))
        if not last:
            yc = jnp.concatenate([short_conv_mixer(pc_sc, sc_conv_w[i], 1),
                                  chunk_mlp_mixer(pc_cm, cm_w_s[i], cm_b_s[i]), yc_mb, yc_gla], axis=-1)
            hc = hc + mod_c[2] * (yc @ w_out[i])
            hc = hc + mod_c[5] * channel_mixer(i, modulate(rmsnorm(hc, g_ffn[i]), mod_c[3], mod_c[4]))
    return rmsnorm(h, g_final)
```

```cpp
#include <hip/hip_runtime.h>
#include <cstdio>
#include <cstdint>
namespace pg8 {
#define PG8_LAS __attribute__((address_space(3)))
typedef unsigned short bf16_t;
typedef short bf16x8 __attribute__((ext_vector_type(8)));
typedef float f32x4 __attribute__((ext_vector_type(4)));
typedef unsigned u32x4 __attribute__((ext_vector_type(4)));
constexpr int BM = 256, BK = 64, HALF = 128, HTB = HALF * BK * 2  , STAGE_BYTES = 8 * HTB, NXCD = 8, WGM = 8;

__host__ __device__ __forceinline__ int lds_byte(int r, int c) { const int st = (r >> 4) * 2 + (c >> 5), rr = r & 15, cc = c & 31, ob = rr * 64 + cc * 2; return st * 1024 + (ob ^ (((ob >> 9) & 1) << 5)); }
__host__ __device__ __forceinline__ void stage_rc(int b, int& R, int& C) { const int st = b / 1024, sb = b % 1024, swz = sb ^ (((sb >> 9) & 1) << 5); R = (st >> 1) * 16 + swz / 64; C = (st & 1) * 32 + (swz % 64) / 2; }
__host__ __device__ __forceinline__ int perm32(int rho) { const int n = rho >> 4, i = rho & 15; return 8 * (i >> 2) + 4 * n + (i & 3); }

struct Unit { int pm, pn; };
struct Gemm { const bf16_t* A; const bf16_t* Bt; int M, N, K; };

__device__ __forceinline__ unsigned cvt_pk_bf16(float lo, float hi) { unsigned r; asm volatile("v_cvt_pk_bf16_f32 %0, %1, %2" : "=v"(r) : "v"(lo), "v"(hi)); return r; }
typedef float f32x2 __attribute__((ext_vector_type(2)));
struct StaticOrder {
    int nM, nN, nwg, G, c, skipctx;
    __host__ __device__ void init(int nM_, int nN_, int G_, int c_, int skipctx_) { nM = nM_; nN = nN_; nwg = nM * nN; G = G_; c = c_; skipctx = skipctx_; }
    __host__ __device__ bool next(int i, Unit& u) const {
        const long L = (long)i * G + c; if (L >= nwg) return false;
        int wgid = (int)L; { const int q = nwg / NXCD, r = nwg % NXCD, xcd = wgid % NXCD, off = wgid / NXCD; wgid = (xcd < r ? xcd * (q + 1) : r * (q + 1) + (xcd - r) * q) + off; }
        const int nig = WGM * nN, gid = wgid / nig, fm = gid * WGM, gsz = (nM - fm) < WGM ? (nM - fm) : WGM;
        int pm = fm + ((wgid % nig) % gsz); u.pn = (wgid % nig) / gsz;
        if (skipctx) pm = pm + 1 + (pm >= 16 ? 1 : 0);
        u.pm = pm; return true;
    }
    __device__ __forceinline__ void a_ready(const Unit&) const {}
    __device__ __forceinline__ void done(const Unit&) const {}
};
struct MoeOrder {
    int ntiles, NT, G, c; int tb1, tb2, tb3, tb4, tb5, tb6, tb7;
    __device__ bool next(int i, Unit& u) const {
        const long L = (long)i * G + c; if (L >= (long)ntiles * NT) return false;
        const int tile = (int)(L / NT), pl = (int)(L % NT);
        const int e = (tile >= tb1) + (tile >= tb2) + (tile >= tb3) + (tile >= tb4) + (tile >= tb5) + (tile >= tb6) + (tile >= tb7);
        u.pm = tile; u.pn = e * NT + pl; return true;
    }
    __device__ __forceinline__ void a_ready(const Unit&) const {}
    __device__ __forceinline__ void done(const Unit&) const {}
};
template <class Epi, class Sched, bool ALIGN_EPI = false, bool SP2 = false>
__device__ __forceinline__ void gemm_phase(PG8_LAS unsigned char* lds, const Gemm g, const Sched& S, const Epi& E, const int tid) {
    const int wid = __builtin_amdgcn_readfirstlane(tid >> 6), lane = tid & 63, wr = wid >> 2, wc = wid & 3, fr = lane & 15, fq = lane >> 4;
    const int K = g.K, nt = K / BK;
    unsigned voffA[2], voffB[2];
#pragma unroll
    for (int i = 0; i < 2; ++i) { int R, C; stage_rc(tid * 16 + i * 8192, R, C); const int Rb = Epi::PERM ? ((R & ~31) + perm32(R & 31)) : R;
        voffA[i] = (unsigned)(R * K + C) * 2u; voffB[i] = (unsigned)(Rb * K + C) * 2u; }
    const size_t kstep = (size_t)(BK * 2);
    const size_t hstep = (size_t)HALF * K * 2;
    const size_t tstep = 2 * hstep;
    const unsigned ldsw = (unsigned)wid * 1024u;
    const int aoff = lds_byte(wr * 64 + fr, fq * 8), boff = lds_byte(wc * 32 + fr, fq * 8);
#define PG8_SA(b, h) (((b) * 2 + (h)) * HTB)
#define PG8_SB(b, h) ((4 + (b) * 2 + (h)) * HTB)
#define PG8_STAGE(bufoff, gbase, voff) do { _Pragma("unroll") for (int _i = 0; _i < 2; ++_i) \
        __builtin_amdgcn_global_load_lds((const unsigned*)((const char*)(gbase) + (voff)[_i]), (PG8_LAS unsigned*)(lds + (bufoff) + ldsw + _i * 8192), 16, 0, 0); } while (0)
#define PG8_LDA(dst, b, h) do { _Pragma("unroll") for (int m = 0; m < 4; ++m) _Pragma("unroll") for (int k = 0; k < 2; ++k) dst[m][k] = *(const PG8_LAS bf16x8*)(lds + PG8_SA(b, h) + aoff + m * 2048 + k * 1024); } while (0)
#define PG8_LDB(dst, b, h) do { _Pragma("unroll") for (int n = 0; n < 2; ++n) _Pragma("unroll") for (int k = 0; k < 2; ++k) dst[n][k] = *(const PG8_LAS bf16x8*)(lds + PG8_SB(b, h) + boff + n * 2048 + k * 1024); } while (0)
#define PG8_MMA(ai, bj, At, Bt) do { __builtin_amdgcn_s_setprio(1); _Pragma("unroll") for (int m = 0; m < 4; ++m) _Pragma("unroll") for (int n = 0; n < 2; ++n) _Pragma("unroll") for (int k = 0; k < 2; ++k) \
        acc[ai][bj][m][n] = __builtin_amdgcn_mfma_f32_16x16x32_bf16(Bt[n][k], At[m][k], acc[ai][bj][m][n], 0, 0, 0); __builtin_amdgcn_s_setprio(0); } while (0)
#define PG8_WAIT_V(n) asm volatile("s_waitcnt vmcnt(" #n ")" ::: "memory")
#define PG8_WAIT_L(n) asm volatile("s_waitcnt lgkmcnt(" #n ")" ::: "memory")
#define PG8_BAR __builtin_amdgcn_s_barrier()
#define PG8_SCHED __builtin_amdgcn_sched_barrier(0)
    Unit cur, nxt; int ui = 0;
    if (!S.next(0, cur)) return;
    f32x4 acc[2][2][4][2];
#pragma unroll
    for (int a = 0; a < 2; ++a)
#pragma unroll
        for (int b = 0; b < 2; ++b)
#pragma unroll
            for (int m = 0; m < 4; ++m)
#pragma unroll
                for (int n = 0; n < 2; ++n) acc[a][b][m][n] = (f32x4){0.f, 0.f, 0.f, 0.f};
    bf16x8 At[4][2], B0[2][2], B1[2][2];
    const char* cA = (const char*)g.A + (size_t)cur.pm * tstep; const char* cB = (const char*)g.Bt + (size_t)cur.pn * tstep;
    S.a_ready(cur);
    if constexpr (SP2) {
        PG8_STAGE(PG8_SB(0, 0), cB, voffB); PG8_STAGE(PG8_SB(0, 1), cB + hstep, voffB); PG8_STAGE(PG8_SA(0, 0), cA, voffA); PG8_STAGE(PG8_SA(0, 1), cA + hstep, voffA);
        if (wr == 1) PG8_BAR;
        PG8_WAIT_V(2); PG8_BAR;
        PG8_STAGE(PG8_SB(1, 0), cB + kstep, voffB); PG8_STAGE(PG8_SA(1, 0), cA + kstep, voffA); PG8_STAGE(PG8_SB(1, 1), cB + hstep + kstep, voffB);
        PG8_WAIT_V(6); PG8_BAR;
    } else {
        PG8_STAGE(PG8_SB(0, 0), cB, voffB); PG8_STAGE(PG8_SA(0, 0), cA, voffA); PG8_STAGE(PG8_SB(0, 1), cB + hstep, voffB); PG8_STAGE(PG8_SA(0, 1), cA + hstep, voffA);
        if (wr == 1) PG8_BAR;
        PG8_WAIT_V(4); PG8_BAR;
        PG8_STAGE(PG8_SB(1, 0), cB + kstep, voffB); PG8_STAGE(PG8_SA(1, 0), cA + kstep, voffA); PG8_STAGE(PG8_SB(1, 1), cB + hstep + kstep, voffB);
        PG8_WAIT_V(6); PG8_BAR;
    }
    for (;;) {
        const bool has_next = S.next(ui + 1, nxt);
        const char* nA = has_next ? (const char*)g.A + (size_t)nxt.pm * tstep : cA; const char* nB = has_next ? (const char*)g.Bt + (size_t)nxt.pn * tstep : cB;
        for (int t = 0; t < nt; t += 2) {
            const bool last = (t == nt - 2);
            const char* a1 = cA + (size_t)(t + 1) * kstep;
            const char* a2 = last ? nA : cA + (size_t)(t + 2) * kstep; const char* b2 = last ? nB : cB + (size_t)(t + 2) * kstep;
            const char* a3 = a2 + kstep; const char* b3 = b2 + kstep;
            if (last && has_next) S.a_ready(nxt);
            if constexpr (SP2) {
            PG8_LDB(B0, 0, 0); PG8_LDB(B1, 0, 1); PG8_SCHED; PG8_LDA(At, 0, 0); PG8_STAGE(PG8_SA(1, 1), a1 + hstep, voffA);
            PG8_WAIT_V(8); PG8_WAIT_L(0); PG8_BAR; PG8_MMA(0, 0, At, B0); PG8_MMA(0, 1, At, B1); PG8_BAR; PG8_SCHED;
            PG8_LDA(At, 0, 1); PG8_STAGE(PG8_SB(0, 0), b2, voffB); PG8_STAGE(PG8_SB(0, 1), b2 + hstep, voffB); PG8_STAGE(PG8_SA(0, 0), a2, voffA);
            PG8_WAIT_V(8); PG8_WAIT_L(0); PG8_BAR; PG8_MMA(1, 0, At, B0); PG8_MMA(1, 1, At, B1); PG8_BAR; PG8_SCHED;
            PG8_LDB(B0, 1, 0); PG8_LDB(B1, 1, 1); PG8_SCHED; PG8_LDA(At, 1, 0); PG8_STAGE(PG8_SA(0, 1), a2 + hstep, voffA);
            PG8_WAIT_V(8); PG8_WAIT_L(0); PG8_BAR; PG8_MMA(0, 0, At, B0); PG8_MMA(0, 1, At, B1); PG8_BAR; PG8_SCHED;
            PG8_LDA(At, 1, 1); PG8_STAGE(PG8_SB(1, 0), b3, voffB); PG8_STAGE(PG8_SB(1, 1), b3 + hstep, voffB); PG8_STAGE(PG8_SA(1, 0), a3, voffA);
            PG8_WAIT_V(8); PG8_WAIT_L(0); PG8_BAR; PG8_MMA(1, 0, At, B0); PG8_MMA(1, 1, At, B1); PG8_BAR; PG8_SCHED;
            } else {
            PG8_LDB(B0, 0, 0); PG8_SCHED; PG8_LDA(At, 0, 0); PG8_STAGE(PG8_SA(1, 1), a1 + hstep, voffA);
            PG8_WAIT_L(8); PG8_BAR; PG8_WAIT_L(0); PG8_MMA(0, 0, At, B0); PG8_BAR; PG8_SCHED;
            PG8_LDB(B1, 0, 1); PG8_STAGE(PG8_SB(0, 0), b2, voffB);
            PG8_BAR; PG8_WAIT_L(0); PG8_MMA(0, 1, At, B1); PG8_BAR;
            PG8_LDA(At, 0, 1); PG8_STAGE(PG8_SA(0, 0), a2, voffA);
            PG8_BAR; PG8_WAIT_L(0); PG8_MMA(1, 0, At, B0); PG8_BAR; PG8_SCHED;
            PG8_STAGE(PG8_SB(0, 1), b2 + hstep, voffB);
            PG8_WAIT_V(6); PG8_BAR; PG8_MMA(1, 1, At, B1); PG8_BAR;
            PG8_LDB(B0, 1, 0); PG8_SCHED; PG8_LDA(At, 1, 0); PG8_STAGE(PG8_SA(0, 1), a2 + hstep, voffA);
            PG8_WAIT_L(8); PG8_BAR; PG8_WAIT_L(0); PG8_MMA(0, 0, At, B0); PG8_BAR; PG8_SCHED;
            PG8_LDB(B1, 1, 1); PG8_STAGE(PG8_SB(1, 0), b3, voffB);
            PG8_BAR; PG8_WAIT_L(0); PG8_MMA(0, 1, At, B1); PG8_BAR;
            PG8_LDA(At, 1, 1); PG8_STAGE(PG8_SA(1, 0), a3, voffA);
            PG8_BAR; PG8_WAIT_L(0); PG8_MMA(1, 0, At, B0); PG8_BAR; PG8_SCHED;
            PG8_STAGE(PG8_SB(1, 1), b3 + hstep, voffB);
            PG8_WAIT_V(6); PG8_BAR; PG8_MMA(1, 1, At, B1); PG8_BAR;
            }
        }
        if constexpr (ALIGN_EPI) { if (wr == 0) PG8_BAR; }
        if constexpr (!Epi::AFTER_DRAIN) { E(acc, cur, wr, wc, fr, fq); S.done(cur); }
        if (!has_next) break;
#pragma unroll
        for (int a = 0; a < 2; ++a)
#pragma unroll
            for (int b = 0; b < 2; ++b)
#pragma unroll
                for (int m = 0; m < 4; ++m)
#pragma unroll
                    for (int n = 0; n < 2; ++n) acc[a][b][m][n] = (f32x4){0.f, 0.f, 0.f, 0.f};
        cur = nxt; cA = nA; cB = nB; ++ui;
        if constexpr (ALIGN_EPI) { if (wr == 1) PG8_BAR; }
    }
    PG8_WAIT_V(0);
    if constexpr (!ALIGN_EPI) { if (wr == 0) PG8_BAR; }
    PG8_BAR;
    if constexpr (Epi::AFTER_DRAIN) { E.fused(acc, cur, wr, wc, fr, fq, lds, wid, lane); S.done(cur); }
#undef PG8_SA
#undef PG8_SB
#undef PG8_STAGE
#undef PG8_LDA
#undef PG8_LDB
#undef PG8_MMA
#undef PG8_WAIT_V
#undef PG8_WAIT_L
#undef PG8_BAR
#undef PG8_SCHED
}
}

constexpr int NWAVES = 8, NTHR = 512;
constexpr int D = 2048, BATCH = 2, SEQ = 4096, CTXL = 256, TB = CTXL + SEQ  , MR = BATCH * TB  ;
constexpr int NMT = MR / 256;
constexpr int PSRC = 5680, NP = 5888;
constexpr int FF = 5632, FFE = 7168, NE = 8;
constexpr int NMOD = 6, ADAW = NMOD * D;
constexpr int MOE_TILES = 72, MOE_ROWS = MOE_TILES * 256;
constexpr float EPS = 1e-6f;
constexpr int C_BG = 0, C_CG = 512, C_XA = 1024, C_CMU = 1536, C_CMV = 2048, C_Z = 2560, C_XS = 3072, C_BM = 3584, C_CM = 3840, C_Q = 4096, C_K = 4352, C_V = 4608, C_G = 5120, C_DT = 5632, C_GLR = 5648;
constexpr int NCH_M = TB / 128  , NCH_G = TB / 64  ;

constexpr size_t MiB = 1u << 20;
constexpr size_t WS_CTL = 0, CTL_ZERO_BYTES = 1 * MiB;
constexpr size_t WS_MODF = 1 * MiB;
constexpr size_t WS_ADAP = 2 * MiB;
constexpr size_t WS_ALAST = 12 * MiB;
constexpr size_t WS_GLAST = 12 * MiB + 65536;
constexpr size_t WS_EA = 13 * MiB;
constexpr size_t WS_ROUTE = 14 * MiB;
constexpr size_t WS_CNT = 14 * MiB + 512 * 1024;
constexpr size_t WS_TOKPOS = 14 * MiB + 768 * 1024;
constexpr size_t WS_MOEINFO = 15 * MiB;
constexpr size_t WS_WIN = 16 * MiB;
constexpr size_t WS_WOUT = 62 * MiB;
constexpr size_t WS_FUP = 78 * MiB;
constexpr size_t WS_FDN = 122 * MiB;
constexpr size_t WS_MUP = 144 * MiB;
constexpr size_t WS_MDN = 592 * MiB;
constexpr size_t WS_H = 816 * MiB;
constexpr size_t WS_XN = 884 * MiB;
constexpr size_t WS_P = 918 * MiB;
constexpr size_t WS_YMIX = 1016 * MiB;
constexpr size_t WS_YMB = 1050 * MiB;
constexpr size_t WS_YGLA = 1067 * MiB;
constexpr size_t WS_CSM = 1084 * MiB;
constexpr size_t WS_CSG = 1118 * MiB;
constexpr size_t WS_QE = 1152 * MiB;
constexpr size_t WS_ACT = 1161 * MiB;
constexpr size_t WS_APERM = 1255 * MiB;
constexpr size_t WS_ACTM = 1327 * MiB;
constexpr size_t WS_DOUT = 1579 * MiB;
constexpr size_t WS_END = 1723 * MiB;
static_assert(WS_WIN + (size_t)2 * NP * D * 2 <= WS_WOUT && WS_WOUT + (size_t)2 * D * D * 2 <= WS_FUP && WS_FUP + (size_t)2 * FF * D * 2 <= WS_FDN && WS_FDN + (size_t)D * FF * 2 <= WS_MUP, "ws map 1");
static_assert(WS_MUP + (size_t)NE * 2 * FFE * D * 2 <= WS_MDN && WS_MDN + (size_t)NE * D * FFE * 2 <= WS_H && WS_H + (size_t)MR * D * 4 <= WS_XN && WS_XN + (size_t)MR * D * 2 <= WS_P, "ws map 2");
static_assert(WS_P + (size_t)MR * NP * 2 <= WS_YMIX && WS_YMIX + (size_t)MR * D * 2 <= WS_YMB && WS_YMB + (size_t)MR * 512 * 4 <= WS_YGLA && WS_YGLA + (size_t)MR * 512 * 4 <= WS_CSM, "ws map 3");
static_assert(WS_CSM + (size_t)BATCH * NCH_M * 2 * 8 * 64 * 128 * 4 <= WS_CSG && WS_CSG + (size_t)BATCH * NCH_G * 2 * 4 * 64 * 128 * 4 <= WS_QE && WS_QE + (size_t)MR * 512 * 2 <= WS_ACT && WS_ACT + (size_t)MR * FF * 2 <= WS_APERM, "ws map 4");
static_assert(WS_APERM + (size_t)MOE_ROWS * D * 2 <= WS_ACTM && WS_ACTM + (size_t)MOE_ROWS * FFE * 2 <= WS_DOUT && WS_DOUT + (size_t)MOE_ROWS * D * 4 <= WS_END, "ws map 5");
static_assert(WS_ADAP + (size_t)2 * 32 * 3 * ADAW * 4 <= WS_ALAST && WS_GLAST + (size_t)BATCH * NCH_G * 2 * 4 * 64 * 4 <= WS_EA && WS_EA + (size_t)MR * 16 * 4 <= WS_ROUTE && WS_ROUTE + (size_t)MR * 16 <= WS_CNT, "ws map 6");
constexpr int CW_TMO = 0, CW_BAR = 4096;

constexpr int RING_OFF = 0, RING_BYTES = 131072;
constexpr int LDSCTL_OFF = RING_BYTES, MISC_OFF = LDSCTL_OFF + 320;
constexpr int LDS_BYTES = 147456;

enum { I_X = 0, I_C, I_CTX, I_CCTX, I_WADA, I_BADA, I_GMIX, I_GFFN, I_WIN, I_WOUT, I_SCW, I_CMW, I_CMB, I_MBCW, I_MBCB, I_MBALOG, I_MBDTB, I_MBD, I_MBNG, I_GLAWG, I_GLABG, I_GLANG,
       I_FWG, I_FWU, I_FWD, I_MROUTER, I_MWG, I_MWU, I_MWD, I_GFINAL, N_IN };
#define GAS __attribute__((address_space(1)))
#define LAS __attribute__((address_space(3)))
typedef unsigned short bf16;
typedef unsigned v4u __attribute__((ext_vector_type(4)));
typedef float f32x4 __attribute__((ext_vector_type(4)));
typedef short bf16x8 __attribute__((ext_vector_type(8)));
typedef GAS unsigned gu32;
typedef GAS unsigned long long gu64;
#define RLX_AGENT __ATOMIC_RELAXED, __HIP_MEMORY_SCOPE_AGENT
#define LDS_WAIT() asm volatile("s_waitcnt lgkmcnt(0)" ::: "memory")
#define VM_WAIT() asm volatile("s_waitcnt vmcnt(0)" ::: "memory")
__device__ __forceinline__ unsigned long long rt() { return __builtin_amdgcn_s_memrealtime(); }
__device__ __forceinline__ unsigned f2bf(float f) { unsigned u = __builtin_bit_cast(unsigned, f); return (u + 0x7fffu + ((u >> 16) & 1u)) >> 16; }
__device__ __forceinline__ unsigned pk2(float lo, float hi) { return f2bf(lo) | (f2bf(hi) << 16); }

#define XB_TMO      128
#define XB_XCNT(j)  (256  + 64 * (j))
#define XB_XSUB(j)  (1280 + 64 * (j))
#define XB_XGEN(j)  (2304 + 64 * (j))
#define XB_TOP      3328
#define XB_TOPGEN   3392
#define XCD_BAR_WORDS 3456
#define XB_SPIN_CAP (1u << 18)

__device__ __forceinline__ unsigned xb_ld(unsigned* p)              { return __hip_atomic_load(p, __ATOMIC_RELAXED, __HIP_MEMORY_SCOPE_AGENT); }
__device__ __forceinline__ unsigned xb_add(unsigned* p, unsigned v) { return __hip_atomic_fetch_add(p, v, __ATOMIC_RELAXED, __HIP_MEMORY_SCOPE_AGENT); }
__device__ __forceinline__ unsigned xb_xcc_id() { return (unsigned)__builtin_amdgcn_s_getreg((3 << 11) | 20) & 0xFu; }
#define XB_SPIN(cond, bar) do { unsigned _sp = 0; while (cond) { __builtin_amdgcn_s_sleep(1); \
    if ((++_sp & 255u) == 0u) { if (xb_ld(&(bar)[XB_TMO])) break; if (_sp > XB_SPIN_CAP) { atomicAdd(&(bar)[XB_TMO], 1u); break; } } } } while (0)

struct XcdBarrier {
    unsigned* bar; unsigned x;
    volatile LAS unsigned* st;
};

__device__ __forceinline__ XcdBarrier xcd_barrier_post(unsigned* bar, volatile LAS unsigned* st) {
    XcdBarrier b; b.bar = bar; b.x = xb_xcc_id(); b.st = st;
    if (threadIdx.x == 0) (void)xb_add(&bar[XB_XCNT(b.x)], 1u);
    return b;
}
__device__ __forceinline__ void xcd_barrier_complete(unsigned* bar, unsigned x, unsigned& nloc, unsigned& nx) {
    const unsigned G = gridDim.x * gridDim.y * gridDim.z;
    unsigned sum, cnt, mine, sp = 0u;
    for (;;) {
        sum = 0u; cnt = 0u; mine = 0u;
#pragma unroll
        for (unsigned j = 0; j < 16; ++j) { const unsigned c = xb_ld(&bar[XB_XCNT(j)]); sum += c; cnt += (c > 0u) ? 1u : 0u; mine = (j == x) ? c : mine; }
        if (sum == G) break;
        __builtin_amdgcn_s_sleep(1);
        if ((++sp & 255u) == 0u) { if (xb_ld(&bar[XB_TMO])) break; if (sp > XB_SPIN_CAP) { atomicAdd(&bar[XB_TMO], 1u); break; } }
    }
    nloc = mine > 0u ? mine : 1u; nx = cnt > 0u ? cnt : 1u;
}

__device__ __forceinline__ void xcd_barrier(const XcdBarrier& b) {
    asm volatile("s_waitcnt vmcnt(0)" ::: "memory");
    __syncthreads();
    if (threadIdx.x == 0) {
        unsigned* bar = b.bar;
        __builtin_amdgcn_s_waitcnt(0);
        unsigned nloc = b.st[0], nx = b.st[1];
        if (nloc == 0u) { xcd_barrier_complete(bar, b.x, nloc, nx); b.st[0] = nloc; b.st[1] = nx; }
        const unsigned old = xb_add(&bar[XB_XSUB(b.x)], 1u);
        const unsigned gen = old / nloc;
        if (old + 1u == (gen + 1u) * nloc) {
            __builtin_amdgcn_fence(__ATOMIC_RELEASE, "agent");
            asm volatile("s_waitcnt vmcnt(0)" ::: "memory");
            const unsigned og = xb_add(&bar[XB_TOP], 1u);
            const unsigned tg = og / nx;
            if (og + 1u == (tg + 1u) * nx) xb_add(&bar[XB_TOPGEN], 1u);
            else XB_SPIN(xb_ld(&bar[XB_TOPGEN]) == tg, bar);
            __builtin_amdgcn_fence(__ATOMIC_ACQUIRE, "agent");
            xb_add(&bar[XB_XGEN(b.x)], 1u);
            asm volatile("s_waitcnt vmcnt(0)" ::: "memory");
        } else {
            XB_SPIN(xb_ld(&bar[XB_XGEN(b.x)]) == gen, bar);
            __builtin_amdgcn_fence(__ATOMIC_ACQUIRE, "agent");
            asm volatile("s_waitcnt vmcnt(0)" ::: "memory");
        }
    }
    __syncthreads();
}

struct Args { const float* in[N_IN]; float* out; unsigned char* ws; int ph_lo, ph_hi; };
typedef LAS unsigned short lbf16;
typedef const __attribute__((address_space(4))) Args* KA;
__device__ __forceinline__ KA ka_get() { KA p = (KA)__builtin_amdgcn_kernarg_segment_ptr(); asm volatile("" : "+s"(p)); return p; }
__device__ __forceinline__ float bf2f(unsigned short v) { return __uint_as_float((unsigned)v << 16); }
__device__ __forceinline__ void unpack8(const v4u v, float (&f)[8]) {
    f[0] = __uint_as_float(v.x << 16); f[1] = __uint_as_float(v.x & 0xffff0000u); f[2] = __uint_as_float(v.y << 16); f[3] = __uint_as_float(v.y & 0xffff0000u);
    f[4] = __uint_as_float(v.z << 16); f[5] = __uint_as_float(v.z & 0xffff0000u); f[6] = __uint_as_float(v.w << 16); f[7] = __uint_as_float(v.w & 0xffff0000u); }
__device__ __forceinline__ v4u pack8(const float (&f)[8]) { v4u o; o.x = pg8::cvt_pk_bf16(f[0], f[1]); o.y = pg8::cvt_pk_bf16(f[2], f[3]); o.z = pg8::cvt_pk_bf16(f[4], f[5]); o.w = pg8::cvt_pk_bf16(f[6], f[7]); return o; }
__device__ __forceinline__ float silu_f(float x) { return x / (1.f + __expf(-x)); }
__device__ __forceinline__ float softplus_f(float x) { return x > 20.f ? x : log1pf(__expf(x)); }
__device__ __forceinline__ float logsig_f(float x) { return fminf(x, 0.f) - log1pf(__expf(-fabsf(x))); }
__device__ __forceinline__ float gelu_tanh(float x) { const float u = 0.7978845608028654f * (x + 0.044715f * x * x * x); const float t = 1.f - 2.f / (1.f + __expf(2.f * u)); return 0.5f * x * (1.f + t); }
__device__ __forceinline__ float wave_sum(float v) {
#pragma unroll
    for (int o = 1; o < 64; o <<= 1) v += __shfl_xor(v, o);
    return v;
}
struct Acc32 { f32x4 v[2][2]; };
__device__ __forceinline__ void acc_zero(Acc32& a) { a.v[0][0] = a.v[0][1] = a.v[1][0] = a.v[1][1] = (f32x4){0.f, 0.f, 0.f, 0.f}; }
__device__ __forceinline__ void wave_mma32(Acc32& acc, const lbf16* A, int lda, const lbf16* Bt, int ldb, int m0, int n0, int K, int lane) {
    const int l16 = lane & 15, q = lane >> 4;
    const lbf16* a0 = A + (m0 + l16) * lda + 8 * q; const lbf16* a1 = a0 + 16 * lda;
    const lbf16* b0 = Bt + (n0 + l16) * ldb + 8 * q; const lbf16* b1 = b0 + 16 * ldb;
    for (int k = 0; k < K; k += 32) {
        const bf16x8 fa0 = *(const LAS bf16x8*)(a0 + k), fa1 = *(const LAS bf16x8*)(a1 + k), fb0 = *(const LAS bf16x8*)(b0 + k), fb1 = *(const LAS bf16x8*)(b1 + k);
        acc.v[0][0] = __builtin_amdgcn_mfma_f32_16x16x32_bf16(fa0, fb0, acc.v[0][0], 0, 0, 0);
        acc.v[0][1] = __builtin_amdgcn_mfma_f32_16x16x32_bf16(fa0, fb1, acc.v[0][1], 0, 0, 0);
        acc.v[1][0] = __builtin_amdgcn_mfma_f32_16x16x32_bf16(fa1, fb0, acc.v[1][0], 0, 0, 0);
        acc.v[1][1] = __builtin_amdgcn_mfma_f32_16x16x32_bf16(fa1, fb1, acc.v[1][1], 0, 0, 0);
    }
}

namespace pg8 {
struct EpiP {
    static constexpr bool PERM = true, AFTER_DRAIN = false; bf16_t* O;
    __device__ __forceinline__ void operator()(const f32x4 (&acc)[2][2][4][2], const Unit& u, int wr, int wc, int fr, int fq) const {
        const int row0 = u.pm * BM + wr * 64 + fr, col0 = u.pn * BM + wc * 32 + 8 * fq;
#pragma unroll
        for (int ai = 0; ai < 2; ++ai)
#pragma unroll
            for (int m = 0; m < 4; ++m) { bf16_t* rowp = O + (size_t)(row0 + ai * HALF + m * 16) * NP + col0;
#pragma unroll
                for (int bj = 0; bj < 2; ++bj) { const f32x4 v0 = acc[ai][bj][m][0], v1 = acc[ai][bj][m][1];
                    u32x4 w; w.x = cvt_pk_bf16(v0[0], v0[1]); w.y = cvt_pk_bf16(v0[2], v0[3]); w.z = cvt_pk_bf16(v1[0], v1[1]); w.w = cvt_pk_bf16(v1[2], v1[3]);
                    *(u32x4*)(rowp + bj * HALF) = w; } }
    }
};
struct EpiRes {
    static constexpr bool PERM = false, AFTER_DRAIN = false;
    const float* x; const float* ctx; float* H; const float* modl; int gate_idx; int from_inputs;
    __device__ __forceinline__ void operator()(const f32x4 (&acc)[2][2][4][2], const Unit& u, int wr, int wc, int fr, int fq) const {
        const int b = u.pm / 17, j = u.pm % 17; const bool isctx = (j == 0);
        const float* base = from_inputs ? (isctx ? ctx + (size_t)(b * CTXL) * D : x + (size_t)(b * SEQ + (j - 1) * 256) * D) : H + (size_t)u.pm * 256 * D;
        float* out = H + (size_t)u.pm * 256 * D;
        const float* gate = modl + (size_t)(isctx ? 2 : b) * ADAW + gate_idx * D;
        const int r0 = wr * 64 + fr, col0 = u.pn * BM + wc * 32 + 4 * fq;
#pragma unroll
        for (int bj = 0; bj < 2; ++bj)
#pragma unroll
            for (int n = 0; n < 2; ++n) { const f32x4 gv = *(const f32x4*)(gate + col0 + bj * HALF + n * 16);
#pragma unroll
                for (int ai = 0; ai < 2; ++ai) {
#pragma unroll
                    for (int m = 0; m < 4; ++m) { const size_t off = (size_t)(r0 + ai * HALF + m * 16) * D + col0 + bj * HALF + n * 16;
                        const f32x4 bs = *(const f32x4*)(base + off); *(f32x4*)(out + off) = bs + gv * acc[ai][bj][m][n]; }
                    asm volatile("" ::: "memory"); } }
    }
};
struct EpiSwiglu {
    static constexpr bool PERM = true, AFTER_DRAIN = false; bf16_t* O; int ldc; int nt;
    __device__ __forceinline__ void operator()(const f32x4 (&acc)[2][2][4][2], const Unit& u, int wr, int wc, int fr, int fq) const {
        const int pl = u.pn % nt; const int row0 = u.pm * BM + wr * 64 + fr, col0 = pl * HALF + wc * 32 + 8 * fq;
#pragma unroll
        for (int ai = 0; ai < 2; ++ai)
#pragma unroll
            for (int m = 0; m < 4; ++m) { bf16_t* rowp = O + (size_t)(row0 + ai * HALF + m * 16) * ldc + col0;
                float a[8];
#pragma unroll
                for (int n = 0; n < 2; ++n)
#pragma unroll
                    for (int e = 0; e < 4; ++e) { const float g = acc[ai][0][m][n][e], up = acc[ai][1][m][n][e]; a[4 * n + e] = g / (1.f + __expf(-g)) * up; }
                u32x4 w; w.x = cvt_pk_bf16(a[0], a[1]); w.y = cvt_pk_bf16(a[2], a[3]); w.z = cvt_pk_bf16(a[4], a[5]); w.w = cvt_pk_bf16(a[6], a[7]);
                *(u32x4*)rowp = w; }
    }
};
struct EpiF32g {
    static constexpr bool PERM = false, AFTER_DRAIN = false; float* C; int ldc; int nt;
    __device__ __forceinline__ void operator()(const f32x4 (&acc)[2][2][4][2], const Unit& u, int wr, int wc, int fr, int fq) const {
        const int pl = u.pn % nt; const int row0 = u.pm * BM + wr * 64 + fr, col0 = pl * BM + wc * 32 + 4 * fq;
#pragma unroll
        for (int ai = 0; ai < 2; ++ai)
#pragma unroll
            for (int m = 0; m < 4; ++m) { float* rowp = C + (size_t)(row0 + ai * HALF + m * 16) * ldc + col0;
#pragma unroll
                for (int bj = 0; bj < 2; ++bj)
#pragma unroll
                    for (int n = 0; n < 2; ++n) *(f32x4*)(rowp + bj * HALF + n * 16) = acc[ai][bj][m][n]; }
    }
};
}

struct RmOff { int off; __device__ __forceinline__ int operator()(int n) const { return off + n; } };
struct RmWin { __device__ __forceinline__ int operator()(int c) const { return c < 4096 ? c : (c < 4112 ? c + 1536 : (c < 5648 ? c - 16 : c)); } };
struct RmGU { int half; __device__ __forceinline__ int operator()(int n) const { return 256 * (n >> 7) + 128 * half + (n & 127); } };
template <class RowMap>
__device__ __forceinline__ void transpose_item(const float* W, int K, int N, bf16* WT, const RowMap rm, LAS float* scr, int item, int lane) {
    const int nblk = (N + 31) >> 5, kb = item / nblk, nb = item - kb * nblk, k0 = 64 * kb, n0 = 32 * nb;
    const int nc = n0 + (lane & 31); const bool nv = nc < N;
#pragma unroll 8
    for (int i = 0; i < 32; ++i) { const int kk = 2 * i + (lane >> 5); scr[kk * 33 + (lane & 31)] = nv ? W[(size_t)(k0 + kk) * N + nc] : 0.f; }
    LDS_WAIT(); asm volatile("" ::: "memory");
    const int c = lane & 7;
#pragma unroll
    for (int j = 0; j < 4; ++j) { const int n = (lane >> 3) + 8 * j; const LAS float* s = scr + (8 * c) * 33 + n;
        v4u o; o.x = pg8::cvt_pk_bf16(s[0 * 33], s[1 * 33]); o.y = pg8::cvt_pk_bf16(s[2 * 33], s[3 * 33]); o.z = pg8::cvt_pk_bf16(s[4 * 33], s[5 * 33]); o.w = pg8::cvt_pk_bf16(s[6 * 33], s[7 * 33]);
        if (n0 + n < N) *(GAS v4u*)(WT + (size_t)rm(n0 + n) * K + k0 + 8 * c) = o; }
    LDS_WAIT(); asm volatile("" ::: "memory");
}
__device__ __forceinline__ void ada_item(const float* wada, float* adap, const LAS float* S, int it, int lane) {
    const int l = it / 1536, rem = it - l * 1536, cg = rem >> 5, ks = rem & 31; const int k0 = ks * 64, col = cg * 256 + 4 * lane;
    const float* w = wada + ((size_t)l * D + k0) * ADAW + col;
    f32x4 a0 = {0.f, 0.f, 0.f, 0.f}, a1 = a0, a2 = a0;
#pragma unroll 8
    for (int kk = 0; kk < 64; ++kk) { const f32x4 v = *(const GAS f32x4*)(w + (size_t)kk * ADAW); const float s0 = S[k0 + kk], s1 = S[2048 + k0 + kk], s2 = S[4096 + k0 + kk];
        a0 += v * s0; a1 += v * s1; a2 += v * s2; }
    float* o = adap + (((size_t)l * 32 + ks) * 3) * ADAW + col;
    *(GAS f32x4*)o = a0; *(GAS f32x4*)(o + ADAW) = a1; *(GAS f32x4*)(o + 2 * ADAW) = a2;
}
__device__ __forceinline__ void p0a_phase(KA A, LAS unsigned char* lds, int tid, int wave, int lane, int bid, int G) {
    unsigned char* ws = A->ws;
    LAS float* S = (LAS float*)(lds + 73728);
    for (int i = tid; i < 3 * D; i += NTHR) { const float v = i < 2 * D ? A->in[I_C][i] : A->in[I_CCTX][i - 2 * D]; S[i] = silu_f(v); }
    __syncthreads();
    LAS float* scr = (LAS float*)(lds + wave * 8448);
    const int gw = bid * NWAVES + wave, NGW = G * NWAVES;
    constexpr int N_ADA = 3072, N_PAD = 2 * (NP - PSRC);
    constexpr int IW_IN = 32 * 178, IW_OUT = 32 * 64, IW_FG = 32 * 176, IW_FD = 88 * 64, IW_MG = 32 * 224, IW_MD = 112 * 64;
    constexpr int NITEMS = N_ADA + N_PAD + 2 * IW_IN + 2 * IW_OUT + 2 * IW_FG + IW_FD + 16 * IW_MG + 8 * IW_MD;
    bf16* win_t = (bf16*)(ws + WS_WIN); bf16* wout_t = (bf16*)(ws + WS_WOUT); bf16* fup_t = (bf16*)(ws + WS_FUP); bf16* fdn_t = (bf16*)(ws + WS_FDN); bf16* mup_t = (bf16*)(ws + WS_MUP); bf16* mdn_t = (bf16*)(ws + WS_MDN);
    for (int it = gw; it < NITEMS; it += NGW) {
        int r = it;
        if (r < N_ADA) { ada_item(A->in[I_WADA], (float*)(ws + WS_ADAP), S, r, lane); continue; } r -= N_ADA;
        if (r < N_PAD) { const int l = r / (NP - PSRC), row = PSRC + r % (NP - PSRC); GAS v4u* o = (GAS v4u*)(win_t + ((size_t)l * NP + row) * D);
#pragma unroll
            for (int j = 0; j < 4; ++j) o[lane + 64 * j] = (v4u){0u, 0u, 0u, 0u};
            continue; } r -= N_PAD;
        if (r < 2 * IW_IN) { const int l = r / IW_IN; transpose_item(A->in[I_WIN] + (size_t)l * D * PSRC, D, PSRC, win_t + (size_t)l * NP * D, RmWin{}, scr, r % IW_IN, lane); continue; } r -= 2 * IW_IN;
        if (r < 2 * IW_OUT) { const int l = r / IW_OUT; transpose_item(A->in[I_WOUT] + (size_t)l * D * D, D, D, wout_t + (size_t)l * D * D, RmOff{0}, scr, r % IW_OUT, lane); continue; } r -= 2 * IW_OUT;
        if (r < IW_FG) { transpose_item(A->in[I_FWG], D, FF, fup_t, RmGU{0}, scr, r, lane); continue; } r -= IW_FG;
        if (r < IW_FG) { transpose_item(A->in[I_FWU], D, FF, fup_t, RmGU{1}, scr, r, lane); continue; } r -= IW_FG;
        if (r < IW_FD) { transpose_item(A->in[I_FWD], FF, D, fdn_t, RmOff{0}, scr, r, lane); continue; } r -= IW_FD;
        if (r < 8 * IW_MG) { const int e = r / IW_MG; transpose_item(A->in[I_MWG] + (size_t)e * D * FFE, D, FFE, mup_t + (size_t)e * 2 * FFE * D, RmGU{0}, scr, r % IW_MG, lane); continue; } r -= 8 * IW_MG;
        if (r < 8 * IW_MG) { const int e = r / IW_MG; transpose_item(A->in[I_MWU] + (size_t)e * D * FFE, D, FFE, mup_t + (size_t)e * 2 * FFE * D, RmGU{1}, scr, r % IW_MG, lane); continue; } r -= 8 * IW_MG;
        { const int e = r / IW_MD; transpose_item(A->in[I_MWD] + (size_t)e * FFE * D, FFE, D, mdn_t + (size_t)e * D * FFE, RmOff{0}, scr, r % IW_MD, lane); }
    }
}
__device__ __forceinline__ void p0b_phase(KA A, int tid, int bid, int G) {
    const float* adap = (const float*)(A->ws + WS_ADAP); float* modf = (float*)(A->ws + WS_MODF);
    constexpr int NV = 2 * 3 * ADAW / 4;
    for (int v = bid * NTHR + tid; v < NV; v += G * NTHR) {
        const int l = v / (3 * ADAW / 4), rem = v % (3 * ADAW / 4), r = rem / (ADAW / 4), c4 = rem % (ADAW / 4);
        f32x4 s = *(const GAS f32x4*)(A->in[I_BADA] + (size_t)l * ADAW + 4 * c4);
        for (int ks = 0; ks < 32; ++ks) s += *(const GAS f32x4*)(adap + (((size_t)l * 32 + ks) * 3 + r) * ADAW + 4 * c4);
        *(GAS f32x4*)(modf + ((size_t)l * 3 + r) * ADAW + 4 * c4) = s;
    }
}

template <bool ROUTER>
__device__ __forceinline__ void norm_phase(KA A, LAS unsigned char* lds, int l, int which, int tid, int wave, int lane, int bid) {
    unsigned char* ws = A->ws;
    const float* modl = (const float*)(ws + WS_MODF) + (size_t)l * 3 * ADAW;
    const float* gvec = (which ? A->in[I_GFFN] : A->in[I_GMIX]) + (size_t)l * D;
    const int b = bid >> 7;
    LAS float* cA = (LAS float*)lds;
    LAS float* cB = cA + 2 * D;
    LAS float* wrT = (LAS float*)(lds + 32768);
    LAS int* rt = (LAS int*)(lds + 98304);
    for (int i = tid; i < 2 * D; i += NTHR) { const int t = i >> 11, col = i & (D - 1); const float* m = modl + (size_t)(t ? 2 : b) * ADAW;
        cA[i] = gvec[col] * (1.f + m[(which ? 4 : 1) * D + col]); cB[i] = m[(which ? 3 : 0) * D + col]; }
    if (ROUTER) { const float* wr = A->in[I_MROUTER]; for (int i = tid; i < D * NE; i += NTHR) wrT[(i & 7) * D + (i >> 3)] = wr[i]; }
    __syncthreads();
    bf16* XN = (bf16*)(ws + WS_XN); const float* H = (const float*)(ws + WS_H);
    for (int rl = wave; rl < 34; rl += NWAVES) {
        const int row = 34 * bid + rl, s = row % TB; const bool isctx = s < CTXL;
        const float* src = (l == 0 && which == 0) ? (isctx ? A->in[I_CTX] + (size_t)(b * CTXL + s) * D : A->in[I_X] + (size_t)(b * SEQ + s - CTXL) * D) : H + (size_t)row * D;
        const GAS f32x4* xr = (const GAS f32x4*)src + lane;
        f32x4 v[8]; float ss = 0.f;
#pragma unroll
        for (int j = 0; j < 8; ++j) { v[j] = xr[64 * j]; ss += (v[j].x * v[j].x + v[j].y * v[j].y) + (v[j].z * v[j].z + v[j].w * v[j].w); }
        const float rstd = 1.0f / sqrtf(wave_sum(ss) * (1.f / D) + EPS);
        const LAS f32x4* ca = (const LAS f32x4*)(cA + (isctx ? D : 0)) + lane; const LAS f32x4* cb = (const LAS f32x4*)(cB + (isctx ? D : 0)) + lane;
        GAS unsigned long long* o8 = (GAS unsigned long long*)(XN + (size_t)row * D) + lane;
#pragma unroll
        for (int j = 0; j < 8; ++j) { v[j] = v[j] * rstd * ca[64 * j] + cb[64 * j];
            o8[64 * j] = (unsigned long long)pg8::cvt_pk_bf16(v[j].x, v[j].y) | ((unsigned long long)pg8::cvt_pk_bf16(v[j].z, v[j].w) << 32); }
        if (ROUTER) {
            float lg[8];
#pragma unroll
            for (int e = 0; e < 8; ++e) { const LAS f32x4* wv = (const LAS f32x4*)(wrT + e * D) + lane; float a = 0.f;
#pragma unroll
                for (int j = 0; j < 8; ++j) { const f32x4 w = wv[64 * j]; a += (v[j].x * w.x + v[j].y * w.y) + (v[j].z * w.z + v[j].w * w.w); }
                lg[e] = wave_sum(a); }
            int e1 = 0; float v1 = lg[0];
#pragma unroll
            for (int e = 1; e < 8; ++e) if (lg[e] > v1) { v1 = lg[e]; e1 = e; }
            int e2 = -1; float v2 = -3.0e38f;
#pragma unroll
            for (int e = 0; e < 8; ++e) if (e != e1 && lg[e] > v2) { v2 = lg[e]; e2 = e; }
            const float ex = __expf(v2 - v1), w1 = 1.f / (1.f + ex), w2 = ex * w1;
            if (lane == 0) { rt[rl * 4 + 0] = isctx ? -1 : e1; rt[rl * 4 + 1] = e2; rt[rl * 4 + 2] = __float_as_int(w1); rt[rl * 4 + 3] = __float_as_int(w2); }
        }
    }
    if (ROUTER) {
        __syncthreads();
        LAS int* cnt = rt + 34 * 4;
        if (tid < 8) cnt[tid] = 0;
        __syncthreads();
        if (tid == 0) {
            int4* route = (int4*)(ws + WS_ROUTE);
            for (int rl = 0; rl < 34; ++rl) { const int e1 = rt[rl * 4]; if (e1 < 0) continue; const int e2 = rt[rl * 4 + 1];
                const int r1 = cnt[e1]; cnt[e1] = r1 + 1; const int r2 = cnt[e2]; cnt[e2] = r2 + 1;
                route[34 * bid + rl] = make_int4(e1 | (e2 << 4) | (r1 << 8) | (r2 << 16), rt[rl * 4 + 2], rt[rl * 4 + 3], 0); }
            int* gc = (int*)(ws + WS_CNT) + bid * 8;
            for (int e = 0; e < 8; ++e) gc[e] = cnt[e];
        }
    }
    __syncthreads();
}

__device__ __forceinline__ void seg_flags(int row, bool& hl, bool& hr) { const int s = row % TB; if (s < CTXL) { hl = s != 0; hr = s != CTXL - 1; } else { const int t = (s - CTXL) & 63; hl = t != 0; hr = t != 63; } }
__device__ __forceinline__ void conv8(const bf16* P, const float* cw, const float* cb, int row, int pcol, int xc, float (&o)[8]) {
    bool hl, hr; seg_flags(row, hl, hr);
    const bf16* p = P + (size_t)row * NP + pcol; const v4u z = {0u, 0u, 0u, 0u};
    const v4u vc = *(const GAS v4u*)p, vl = hl ? *(const GAS v4u*)(p - NP) : z, vr = hr ? *(const GAS v4u*)(p + NP) : z;
    float c[8], lf[8], rg[8]; unpack8(vc, c); unpack8(vl, lf); unpack8(vr, rg);
    const f32x4 w0a = *(const GAS f32x4*)(cw + xc), w0b = *(const GAS f32x4*)(cw + xc + 4), w1a = *(const GAS f32x4*)(cw + 1024 + xc), w1b = *(const GAS f32x4*)(cw + 1024 + xc + 4),
                w2a = *(const GAS f32x4*)(cw + 2048 + xc), w2b = *(const GAS f32x4*)(cw + 2048 + xc + 4), ba = *(const GAS f32x4*)(cb + xc), bb = *(const GAS f32x4*)(cb + xc + 4);
#pragma unroll
    for (int e = 0; e < 4; ++e) { o[e] = silu_f(w0a[e] * lf[e] + w1a[e] * c[e] + w2a[e] * rg[e] + ba[e]); o[4 + e] = silu_f(w0b[e] * lf[4 + e] + w1b[e] * c[4 + e] + w2b[e] * rg[4 + e] + bb[e]); }
}

__device__ __forceinline__ void m1_sccm_item(KA A, LAS unsigned char* lds, int l, int item, int tid, int wave, int lane) {
    unsigned char* ws = A->ws; const bf16* P = (const bf16*)(ws + WS_P); bf16* YM = (bf16*)(ws + WS_YMIX);
    const int cc = item >> 2, g = item & 3; const int b = cc / NCH_M, c = cc % NCH_M, row0 = b * TB + c * 128;
    const float* scw = A->in[I_SCW] + (size_t)l * 3 * 512;
    for (int task = tid; task < 2048; task += NTHR) { const int t = task >> 4, v = task & 15, ch = 128 * g + 8 * v, row = row0 + t;
        bool hl, hr; seg_flags(row, hl, hr);
        const bf16* p = P + (size_t)row * NP; const v4u z = {0u, 0u, 0u, 0u};
        float bg[8], u0[8], u1[8], u2[8], t0[8], t1[8];
        unpack8(*(const GAS v4u*)(p + C_BG + ch), bg);
        unpack8(*(const GAS v4u*)(p + C_CG + ch), t0); unpack8(*(const GAS v4u*)(p + C_XA + ch), t1);
#pragma unroll
        for (int e = 0; e < 8; ++e) u1[e] = t0[e] * t1[e];
        unpack8(hl ? *(const GAS v4u*)(p - NP + C_CG + ch) : z, t0); unpack8(hl ? *(const GAS v4u*)(p - NP + C_XA + ch) : z, t1);
#pragma unroll
        for (int e = 0; e < 8; ++e) u0[e] = t0[e] * t1[e];
        unpack8(hr ? *(const GAS v4u*)(p + NP + C_CG + ch) : z, t0); unpack8(hr ? *(const GAS v4u*)(p + NP + C_XA + ch) : z, t1);
#pragma unroll
        for (int e = 0; e < 8; ++e) u2[e] = t0[e] * t1[e];
        float o[8];
#pragma unroll
        for (int e = 0; e < 8; ++e) o[e] = bg[e] * (scw[ch + e] * u0[e] + scw[512 + ch + e] * u1[e] + scw[1024 + ch + e] * u2[e]);
        *(GAS v4u*)(YM + (size_t)row * D + ch) = pack8(o);
    }
    lbf16* Ws = (lbf16*)lds; lbf16* Vt = (lbf16*)(lds + 34816);
    const float* wsrc = A->in[I_CMW] + ((size_t)l * 4 + g) * 128 * 128;
    for (int task = tid; task < 4096; task += NTHR) { const int i = task >> 5, j4 = task & 31; const f32x4 w = *(const GAS f32x4*)(wsrc + i * 128 + 4 * j4);
        *(LAS unsigned long long*)(Ws + i * 136 + 4 * j4) = (unsigned long long)pg8::cvt_pk_bf16(w.x, w.y) | ((unsigned long long)pg8::cvt_pk_bf16(w.z, w.w) << 32); }
    for (int task = tid; task < 2048; task += NTHR) { const int j = task >> 4, v = task & 15; float f[8]; unpack8(*(const GAS v4u*)(P + (size_t)(row0 + j) * NP + C_CMV + 128 * g + 8 * v), f);
#pragma unroll
        for (int e = 0; e < 8; ++e) Vt[(8 * v + e) * 136 + j] = (unsigned short)f2bf(gelu_tanh(f[e])); }
    __syncthreads();
    const float* bsrc = A->in[I_CMB] + ((size_t)l * 4 + g) * 128;
    for (int blk = wave; blk < 16; blk += NWAVES) { const int m0 = 32 * (blk >> 2), n0 = 32 * (blk & 3);
        Acc32 acc; acc_zero(acc); wave_mma32(acc, Vt, 136, Ws, 136, m0, n0, 128, lane);
#pragma unroll
        for (int a = 0; a < 2; ++a)
#pragma unroll
            for (int bq = 0; bq < 2; ++bq) { const int d = m0 + 16 * a + 4 * (lane >> 4), i = n0 + 16 * bq + (lane & 15); const float bias = bsrc[i];
                const size_t prow = (size_t)(row0 + i);
                const unsigned long long uu = *(const GAS unsigned long long*)(P + prow * NP + C_CMU + 128 * g + d);
                const float u0 = gelu_tanh(__uint_as_float((unsigned)uu << 16)), u1 = gelu_tanh(__uint_as_float((unsigned)uu & 0xffff0000u)), u2 = gelu_tanh(__uint_as_float((unsigned)(uu >> 32) << 16)), u3 = gelu_tanh(__uint_as_float((unsigned)(uu >> 32) & 0xffff0000u));
                const f32x4 sv = acc.v[a][bq];
                *(GAS unsigned long long*)(YM + prow * D + 512 + 128 * g + d) = (unsigned long long)pg8::cvt_pk_bf16(u0 * (sv[0] + bias), u1 * (sv[1] + bias)) | ((unsigned long long)pg8::cvt_pk_bf16(u2 * (sv[2] + bias), u3 * (sv[3] + bias)) << 32); }
    }
    __syncthreads();
}

__device__ __forceinline__ void m1_mamba_item(KA A, LAS unsigned char* lds, int l, int item, int tid, int wave, int lane) {
    unsigned char* ws = A->ws; const bf16* P = (const bf16*)(ws + WS_P);
    const int cc = item >> 3, h = item & 7, g = h >> 2; const int b = cc / NCH_M, c = cc % NCH_M, row0 = b * TB + c * 128;
    const float* cw = A->in[I_MBCW] + (size_t)l * 3 * 1024; const float* cb = A->in[I_MBCB] + (size_t)l * 1024;
    lbf16* Cm = (lbf16*)lds; lbf16* Bm = (lbf16*)(lds + 34816); lbf16* BmT = (lbf16*)(lds + 69632); lbf16* Xt = (lbf16*)(lds + 104448);
    LAS float* sm = (LAS float*)(lds + 121856);
    for (int task = tid; task < 5120; task += NTHR) {
        int kind, t, v; if (task < 1024) { kind = 0; t = task >> 3; v = task & 7; } else if (task < 3072) { kind = 1; t = (task - 1024) >> 4; v = (task - 1024) & 15; } else { kind = 2; t = (task - 3072) >> 4; v = (task - 3072) & 15; }
        const int pcol = kind == 0 ? C_XS + 64 * h + 8 * v : (kind == 1 ? C_BM + 128 * g + 8 * v : C_CM + 128 * g + 8 * v);
        float o[8]; conv8(P, cw, cb, row0 + t, pcol, pcol - C_XS, o);
        if (kind == 0) {
#pragma unroll
            for (int e = 0; e < 8; ++e) Xt[(8 * v + e) * 136 + t] = (unsigned short)f2bf(o[e]);
        } else if (kind == 1) { *(LAS v4u*)(Bm + t * 136 + 8 * v) = pack8(o);
#pragma unroll
            for (int e = 0; e < 8; ++e) BmT[(8 * v + e) * 136 + t] = (unsigned short)f2bf(o[e]);
        } else *(LAS v4u*)(Cm + t * 136 + 8 * v) = pack8(o);
    }
    if (tid < 256) { const int d = tid >> 7, t = tid & 127; const float x = bf2f(P[(size_t)(row0 + t) * NP + C_DT + d * 8 + h]) + A->in[I_MBDTB][(l * 2 + d) * 8 + h]; sm[d * 128 + t] = softplus_f(x); }
    __syncthreads();
    const float an0 = -__expf(A->in[I_MBALOG][(l * 2 + 0) * 8 + h]), an1 = -__expf(A->in[I_MBALOG][(l * 2 + 1) * 8 + h]);
    if (tid < 128) { float s = 0.f; for (int r = 0; r <= tid; ++r) s += sm[r] * an0; sm[256 + tid] = s; }
    else if (tid < 256) { const int t = tid - 128; float s = 0.f; for (int r = 127; r >= t; --r) s += sm[128 + r] * an1; sm[384 + t] = s; }
    __syncthreads();
    const LAS float* dt0 = sm; const LAS float* dt1 = sm + 128; const LAS float* ac0 = sm + 256; const LAS float* ac1 = sm + 384;
    Acc32 cbv[2];
#pragma unroll
    for (int q2 = 0; q2 < 2; ++q2) { const int blk = wave + 8 * q2; acc_zero(cbv[q2]); wave_mma32(cbv[q2], Cm, 136, Bm, 136, 32 * (blk >> 2), 32 * (blk & 3), 128, lane); }
#pragma unroll
    for (int q2 = 0; q2 < 2; ++q2) { const int blk = wave + 8 * q2;
#pragma unroll
        for (int a = 0; a < 2; ++a)
#pragma unroll
            for (int bq = 0; bq < 2; ++bq) { const int jj = 32 * (blk & 3) + 16 * bq + (lane & 15); const float a0j = ac0[jj], a1j = ac1[jj], d0j = dt0[jj], d1j = dt1[jj];
#pragma unroll
                for (int j = 0; j < 4; ++j) { const int i = 32 * (blk >> 2) + 16 * a + 4 * (lane >> 4) + j; float f = 0.f;
                    if (jj <= i) f += __expf(ac0[i] - a0j) * d0j;
                    if (jj >= i) f += __expf(ac1[i] - a1j) * d1j;
                    cbv[q2].v[a][bq][j] *= f; } }
    }
    __syncthreads();
    lbf16* Wl = Cm; lbf16* XwT = Bm;
#pragma unroll
    for (int q2 = 0; q2 < 2; ++q2) { const int blk = wave + 8 * q2;
#pragma unroll
        for (int a = 0; a < 2; ++a)
#pragma unroll
            for (int bq = 0; bq < 2; ++bq) { const int jj = 32 * (blk & 3) + 16 * bq + (lane & 15);
#pragma unroll
                for (int j = 0; j < 4; ++j) { const int i = 32 * (blk >> 2) + 16 * a + 4 * (lane >> 4) + j; Wl[i * 136 + jj] = (unsigned short)f2bf(cbv[q2].v[a][bq][j]); } }
    }
    const float al0 = ac0[127], al1 = ac1[0];
    for (int task = tid; task < 2048; task += NTHR) { const int d = task >> 10, p = (task >> 4) & 63, v = task & 15; float f[8]; unpack8(*(const LAS v4u*)(Xt + p * 136 + 8 * v), f);
#pragma unroll
        for (int e = 0; e < 8; ++e) { const int j = 8 * v + e; f[e] *= d ? __expf(al1 - ac1[j]) * dt1[j] : __expf(al0 - ac0[j]) * dt0[j]; }
        *(LAS v4u*)(XwT + d * 8704 + p * 136 + 8 * v) = pack8(f); }
    __syncthreads();
    {
        const int m0 = 32 * (wave >> 2), n0 = 32 * (wave & 3); Acc32 y; acc_zero(y); wave_mma32(y, Xt, 136, Wl, 136, m0, n0, 128, lane);
        const float dsum = A->in[I_MBD][(l * 2 + 0) * 8 + h] + A->in[I_MBD][(l * 2 + 1) * 8 + h];
        float* YMB = (float*)(ws + WS_YMB);
#pragma unroll
        for (int a = 0; a < 2; ++a)
#pragma unroll
            for (int bq = 0; bq < 2; ++bq) { const int p = m0 + 16 * a + 4 * (lane >> 4), i = n0 + 16 * bq + (lane & 15); f32x4 o = y.v[a][bq];
#pragma unroll
                for (int j = 0; j < 4; ++j) o[j] += bf2f(Xt[(p + j) * 136 + i]) * dsum;
                *(GAS f32x4*)(YMB + (size_t)(row0 + i) * 512 + 64 * h + p) = o; }
    }
    float* CSM = (float*)(ws + WS_CSM);
#pragma unroll
    for (int d = 0; d < 2; ++d) {
        const int m0 = 32 * (wave >> 1), n0 = 32 * (wave & 1); Acc32 s; acc_zero(s); wave_mma32(s, BmT, 136, XwT + d * 8704, 136, m0, n0, 128, lane);
        float* cs = CSM + ((((size_t)b * NCH_M + c) * 2 + d) * 8 + h) * 8192;
#pragma unroll
        for (int a = 0; a < 2; ++a)
#pragma unroll
            for (int bq = 0; bq < 2; ++bq) { const int n = m0 + 16 * a + 4 * (lane >> 4), p = n0 + 16 * bq + (lane & 15); *(GAS f32x4*)(cs + p * 128 + n) = s.v[a][bq]; }
    }
    if (tid < 256) { const int d = tid >> 7, t = tid & 127; ((float*)(ws + WS_EA))[(size_t)(row0 + t) * 16 + d * 8 + h] = __expf(sm[256 + d * 128 + t]); }
    if (tid < 2) ((float*)(ws + WS_ALAST))[(((size_t)b * NCH_M + c) * 2 + tid) * 8 + h] = tid ? al1 : al0;
    __syncthreads();
}

__device__ __forceinline__ void m1_gla_item(KA A, LAS unsigned char* lds, int l, int item, int tid, int wave, int lane) {
    unsigned char* ws = A->ws; const bf16* P = (const bf16*)(ws + WS_P);
    const int cgi = item >> 2, h = item & 3; const int b = cgi / NCH_G, c = cgi % NCH_G, row0 = b * TB + c * 64;
    LAS float* G = (LAS float*)lds;
    LAS float* wgs = (LAS float*)(lds + 32768);
    LAS float* bgs = (LAS float*)(lds + 40960);
    lbf16* Qs = (lbf16*)(lds + 41984); lbf16* Ks = (lbf16*)(lds + 60416); lbf16* KsT = (lbf16*)(lds + 78848); lbf16* Vt = (lbf16*)(lds + 97280); lbf16* Att = (lbf16*)(lds + 115712);
    for (int i = tid; i < 2048; i += NTHR) { const int d = i >> 10, r = (i >> 6) & 15, k = i & 63; wgs[i] = A->in[I_GLAWG][(((size_t)l * 2 + d) * 16 + r) * 256 + 64 * h + k]; }
    if (tid < 128) bgs[tid] = A->in[I_GLABG][((size_t)l * 2 + (tid >> 6)) * 256 + 64 * h + (tid & 63)];
    __syncthreads();
    {   const int d = tid >> 8, t = (tid >> 2) & 63, kq = tid & 3;
        float gl[16]; { float f[8]; const bf16* p = P + (size_t)(row0 + t) * NP + C_GLR + d * 16; unpack8(*(const GAS v4u*)p, f);
#pragma unroll
            for (int e = 0; e < 8; ++e) gl[e] = f[e];
            unpack8(*(const GAS v4u*)(p + 8), f);
#pragma unroll
            for (int e = 0; e < 8; ++e) gl[8 + e] = f[e]; }
        f32x4 acc[4] = {{0.f, 0.f, 0.f, 0.f}, {0.f, 0.f, 0.f, 0.f}, {0.f, 0.f, 0.f, 0.f}, {0.f, 0.f, 0.f, 0.f}};
#pragma unroll
        for (int r = 0; r < 16; ++r) { const LAS f32x4* w = (const LAS f32x4*)(wgs + (d * 16 + r) * 64 + kq * 16);
#pragma unroll
            for (int q = 0; q < 4; ++q) acc[q] += w[q] * gl[r]; }
#pragma unroll
        for (int q = 0; q < 4; ++q)
#pragma unroll
            for (int e = 0; e < 4; ++e) { const int k = kq * 16 + 4 * q + e; G[(d * 64 + t) * 64 + k] = logsig_f(acc[q][e] + bgs[d * 64 + k]) * (1.f / 16.f); }
    }
    __syncthreads();
    if (tid < 64) { float s = 0.f; for (int t = 0; t < 64; ++t) { s += G[t * 64 + tid]; G[t * 64 + tid] = s; } }
    else if (tid < 128) { const int k = tid - 64; float s = 0.f; for (int t = 63; t >= 0; --t) { s += G[(64 + t) * 64 + k]; G[(64 + t) * 64 + k] = s; } }
    __syncthreads();
    {   const int t = tid >> 3, kv = tid & 7; float qf[8], kf[8];
        unpack8(*(const GAS v4u*)(P + (size_t)(row0 + t) * NP + C_Q + 64 * h + 8 * kv), qf); unpack8(*(const GAS v4u*)(P + (size_t)(row0 + t) * NP + C_K + 64 * h + 8 * kv), kf);
        bf16* QE = (bf16*)(ws + WS_QE);
#pragma unroll
        for (int d = 0; d < 2; ++d) { float qs[8], ks[8], qe[8];
#pragma unroll
            for (int e = 0; e < 8; ++e) { const int k = 8 * kv + e; const float gv = G[(d * 64 + t) * 64 + k], gref = G[(d * 64 + (d ? 31 : 32)) * 64 + k], glast = G[(d * 64 + (d ? 0 : 63)) * 64 + k];
                const float q = qf[e] * 0.125f; qs[e] = q * __expf(gv - gref); ks[e] = kf[e] * __expf(gref - gv); qe[e] = q * __expf(gv);
                KsT[d * 4608 + k * 72 + t] = (unsigned short)f2bf(kf[e] * __expf(glast - gv)); }
            *(LAS v4u*)(Qs + d * 4608 + t * 72 + 8 * kv) = pack8(qs); *(LAS v4u*)(Ks + d * 4608 + t * 72 + 8 * kv) = pack8(ks);
            *(GAS v4u*)(QE + (size_t)(row0 + t) * 512 + d * 256 + 64 * h + 8 * kv) = pack8(qe); }
    }
    for (int task = tid; task < 1024; task += NTHR) { const int t = task >> 4, vv = task & 15; float f[8]; unpack8(*(const GAS v4u*)(P + (size_t)(row0 + t) * NP + C_V + 128 * h + 8 * vv), f);
#pragma unroll
        for (int e = 0; e < 8; ++e) Vt[(8 * vv + e) * 72 + t] = (unsigned short)f2bf(f[e]); }
    if (tid < 128) { const int d = tid >> 6, k = tid & 63; ((float*)(ws + WS_GLAST))[((((size_t)b * NCH_G + c) * 2 + d) * 4 + h) * 64 + k] = G[(d * 64 + (d ? 0 : 63)) * 64 + k]; }
    __syncthreads();
    if (wave < 4) { const int m0 = 32 * (wave >> 1), n0 = 32 * (wave & 1); Acc32 a0, a1; acc_zero(a0); acc_zero(a1);
        wave_mma32(a0, Qs, 72, Ks, 72, m0, n0, 64, lane); wave_mma32(a1, Qs + 4608, 72, Ks + 4608, 72, m0, n0, 64, lane);
#pragma unroll
        for (int a = 0; a < 2; ++a)
#pragma unroll
            for (int bq = 0; bq < 2; ++bq) { const int jj = n0 + 16 * bq + (lane & 15);
#pragma unroll
                for (int j = 0; j < 4; ++j) { const int i = m0 + 16 * a + 4 * (lane >> 4) + j; const float val = (jj <= i ? a0.v[a][bq][j] : 0.f) + (jj >= i ? a1.v[a][bq][j] : 0.f); Att[i * 72 + jj] = (unsigned short)f2bf(val); } }
    }
    __syncthreads();
    const int m0 = 32 * (wave >> 1), n0 = 32 * (wave & 1);
    {   Acc32 o; acc_zero(o); wave_mma32(o, Vt, 72, Att, 72, m0, n0, 64, lane);
        float* YG = (float*)(ws + WS_YGLA);
#pragma unroll
        for (int a = 0; a < 2; ++a)
#pragma unroll
            for (int bq = 0; bq < 2; ++bq) { const int v = m0 + 16 * a + 4 * (lane >> 4), i = n0 + 16 * bq + (lane & 15); *(GAS f32x4*)(YG + (size_t)(row0 + i) * 512 + 128 * h + v) = o.v[a][bq]; }
    }
    float* CSG = (float*)(ws + WS_CSG);
#pragma unroll
    for (int d = 0; d < 2; ++d) { Acc32 s; acc_zero(s); wave_mma32(s, Vt, 72, KsT + d * 4608, 72, m0, n0, 64, lane);
        float* cs = CSG + ((((size_t)b * NCH_G + c) * 2 + d) * 4 + h) * 8192;
#pragma unroll
        for (int a = 0; a < 2; ++a)
#pragma unroll
            for (int bq = 0; bq < 2; ++bq) { const int v = m0 + 16 * a + 4 * (lane >> 4), k = n0 + 16 * bq + (lane & 15); *(GAS f32x4*)(cs + k * 128 + v) = s.v[a][bq]; }
    }
    __syncthreads();
}

__device__ __forceinline__ void m2_phase(KA A, int wave, int lane, int bid, int G) {
    unsigned char* ws = A->ws; const int gw = bid * NWAVES + wave, NGW = G * NWAVES;
    float* CSM = (float*)(ws + WS_CSM); const float* AL = (const float*)(ws + WS_ALAST);
    for (int line = gw; line < BATCH * 2 * 8 * 64; line += NGW) {
        const int p = line & 63, h = (line >> 6) & 7, d = (line >> 9) & 1, b = line >> 10;
        float s0 = 0.f, s1 = 0.f;
        for (int i = 0; i < NCH_M; ++i) { const int c = d == 0 ? i : (i < 2 ? 1 - i : NCH_M + 1 - i);
            float* cs = CSM + (((((size_t)b * NCH_M + c) * 2 + d) * 8 + h) * 64 + p) * 128;
            const float dec = __expf(AL[(((size_t)b * NCH_M + c) * 2 + d) * 8 + h]);
            const float c0 = cs[lane], c1 = cs[lane + 64]; cs[lane] = s0; cs[lane + 64] = s1; s0 = dec * s0 + c0; s1 = dec * s1 + c1; }
    }
    float* CSG = (float*)(ws + WS_CSG); const float* GL = (const float*)(ws + WS_GLAST);
    for (int line = gw; line < BATCH * 2 * 4 * 64; line += NGW) {
        const int k = line & 63, h = (line >> 6) & 3, d = (line >> 8) & 1, b = line >> 9;
        float s0 = 0.f, s1 = 0.f;
        for (int i = 0; i < NCH_G; ++i) { const int c = d == 0 ? i : (i < 4 ? 3 - i : NCH_G + 3 - i);
            float* cs = CSG + (((((size_t)b * NCH_G + c) * 2 + d) * 4 + h) * 64 + k) * 128;
            const float dec = __expf(GL[((((size_t)b * NCH_G + c) * 2 + d) * 4 + h) * 64 + k]);
            const float c0 = cs[lane], c1 = cs[lane + 64]; cs[lane] = s0; cs[lane + 64] = s1; s0 = dec * s0 + c0; s1 = dec * s1 + c1; }
    }
}

__device__ __forceinline__ void m3_mamba_item(KA A, LAS unsigned char* lds, int l, int item, int tid, int wave, int lane) {
    unsigned char* ws = A->ws; const bf16* P = (const bf16*)(ws + WS_P);
    const int cc = item >> 3, h = item & 7, g = h >> 2; const int b = cc / NCH_M, c = cc % NCH_M, row0 = b * TB + c * 128;
    const float* cw = A->in[I_MBCW] + (size_t)l * 3 * 1024; const float* cb = A->in[I_MBCB] + (size_t)l * 1024;
    lbf16* Sc = (lbf16*)lds; lbf16* Cc = (lbf16*)(lds + 33792);
    const float* CSM = (const float*)(ws + WS_CSM); const float* EA = (const float*)(ws + WS_EA);
    for (int task = tid; task < 4096; task += NTHR) { const int d = task >> 11, p = (task >> 5) & 63, n4 = task & 31;
        const f32x4 s = *(const GAS f32x4*)(CSM + (((((size_t)b * NCH_M + c) * 2 + d) * 8 + h) * 64 + p) * 128 + 4 * n4);
        *(LAS unsigned long long*)(Sc + p * 264 + d * 128 + 4 * n4) = (unsigned long long)pg8::cvt_pk_bf16(s.x, s.y) | ((unsigned long long)pg8::cvt_pk_bf16(s.z, s.w) << 32); }
    for (int task = tid; task < 2048; task += NTHR) { const int i = task >> 4, v = task & 15; float o[8], o1[8];
        conv8(P, cw, cb, row0 + i, C_CM + 128 * g + 8 * v, 768 + 128 * g + 8 * v, o);
        const float e0 = EA[(size_t)(row0 + i) * 16 + h], e1 = EA[(size_t)(row0 + i) * 16 + 8 + h];
#pragma unroll
        for (int e = 0; e < 8; ++e) { o1[e] = o[e] * e1; o[e] *= e0; }
        *(LAS v4u*)(Cc + i * 264 + 8 * v) = pack8(o); *(LAS v4u*)(Cc + i * 264 + 128 + 8 * v) = pack8(o1); }
    __syncthreads();
    {   const int m0 = 32 * (wave >> 2), n0 = 32 * (wave & 3); Acc32 y; acc_zero(y); wave_mma32(y, Sc, 264, Cc, 264, m0, n0, 256, lane);
        float* YMB = (float*)(ws + WS_YMB);
#pragma unroll
        for (int a = 0; a < 2; ++a)
#pragma unroll
            for (int bq = 0; bq < 2; ++bq) { const int p = m0 + 16 * a + 4 * (lane >> 4), i = n0 + 16 * bq + (lane & 15); GAS f32x4* o = (GAS f32x4*)(YMB + (size_t)(row0 + i) * 512 + 64 * h + p); *o = *o + y.v[a][bq]; }
    }
    __syncthreads();
}
__device__ __forceinline__ void m3_gla_item(KA A, LAS unsigned char* lds, int item, int tid, int wave, int lane) {
    unsigned char* ws = A->ws;
    const int cgi = item >> 2, h = item & 3; const int b = cgi / NCH_G, c = cgi % NCH_G, row0 = b * TB + c * 64;
    lbf16* St = (lbf16*)lds; lbf16* Qc = (lbf16*)(lds + 34816);
    const float* CSG = (const float*)(ws + WS_CSG); const bf16* QE = (const bf16*)(ws + WS_QE);
    for (int task = tid; task < 4096; task += NTHR) { const int d = task >> 11, k = (task >> 5) & 63, v4 = task & 31;
        const f32x4 s = *(const GAS f32x4*)(CSG + (((((size_t)b * NCH_G + c) * 2 + d) * 4 + h) * 64 + k) * 128 + 4 * v4);
#pragma unroll
        for (int e = 0; e < 4; ++e) St[(4 * v4 + e) * 136 + d * 64 + k] = (unsigned short)f2bf(s[e]); }
    for (int task = tid; task < 1024; task += NTHR) { const int i = task >> 4, d = (task >> 3) & 1, kv = task & 7;
        *(LAS v4u*)(Qc + i * 136 + d * 64 + 8 * kv) = *(const GAS v4u*)(QE + (size_t)(row0 + i) * 512 + d * 256 + 64 * h + 8 * kv); }
    __syncthreads();
    {   const int m0 = 32 * (wave >> 1), n0 = 32 * (wave & 1); Acc32 o; acc_zero(o); wave_mma32(o, St, 136, Qc, 136, m0, n0, 128, lane);
        float* YG = (float*)(ws + WS_YGLA);
#pragma unroll
        for (int a = 0; a < 2; ++a)
#pragma unroll
            for (int bq = 0; bq < 2; ++bq) { const int v = m0 + 16 * a + 4 * (lane >> 4), i = n0 + 16 * bq + (lane & 15); GAS f32x4* op = (GAS f32x4*)(YG + (size_t)(row0 + i) * 512 + 128 * h + v); *op = *op + o.v[a][bq]; }
    }
    __syncthreads();
}

__device__ __forceinline__ void m4_phase(KA A, int l, int wave, int lane, int bid, int G) {
    unsigned char* ws = A->ws; const bf16* P = (const bf16*)(ws + WS_P); bf16* YM = (bf16*)(ws + WS_YMIX);
    const float* YMB = (const float*)(ws + WS_YMB); const float* YG = (const float*)(ws + WS_YGLA);
    const float* mng = A->in[I_MBNG] + (size_t)l * 512; const float* gng = A->in[I_GLANG] + (size_t)l * 128;
    for (int row = bid * NWAVES + wave; row < MR; row += G * NWAVES) {
        const bf16* p = P + (size_t)row * NP;
        f32x4 y[2]; float ss = 0.f;
#pragma unroll
        for (int j = 0; j < 2; ++j) { const int idx = 4 * lane + 256 * j; y[j] = *(const GAS f32x4*)(YMB + (size_t)row * 512 + idx);
            const unsigned long long zz = *(const GAS unsigned long long*)(p + C_Z + idx);
            y[j].x *= silu_f(__uint_as_float((unsigned)zz << 16)); y[j].y *= silu_f(__uint_as_float((unsigned)zz & 0xffff0000u)); y[j].z *= silu_f(__uint_as_float((unsigned)(zz >> 32) << 16)); y[j].w *= silu_f(__uint_as_float((unsigned)(zz >> 32) & 0xffff0000u));
            ss += (y[j].x * y[j].x + y[j].y * y[j].y) + (y[j].z * y[j].z + y[j].w * y[j].w); }
        const float r = 1.0f / sqrtf(wave_sum(ss) * (1.f / 512.f) + EPS);
#pragma unroll
        for (int j = 0; j < 2; ++j) { const int idx = 4 * lane + 256 * j; const f32x4 gg = *(const GAS f32x4*)(mng + idx); const f32x4 o = y[j] * r * gg;
            *(GAS unsigned long long*)(YM + (size_t)row * D + 1024 + idx) = (unsigned long long)pg8::cvt_pk_bf16(o.x, o.y) | ((unsigned long long)pg8::cvt_pk_bf16(o.z, o.w) << 32); }
#pragma unroll
        for (int j = 0; j < 2; ++j) { const int idx = 4 * lane + 256 * j; const f32x4 o = *(const GAS f32x4*)(YG + (size_t)row * 512 + idx);
            float q = (o.x * o.x + o.y * o.y) + (o.z * o.z + o.w * o.w);
#pragma unroll
            for (int sft = 1; sft < 32; sft <<= 1) q += __shfl_xor(q, sft);
            const float rr = 1.0f / sqrtf(q * (1.f / 128.f) + EPS);
            const f32x4 gn = *(const GAS f32x4*)(gng + (idx & 127));
            const unsigned long long gz = *(const GAS unsigned long long*)(p + C_G + idx);
            const float g0 = silu_f(__uint_as_float((unsigned)gz << 16)), g1 = silu_f(__uint_as_float((unsigned)gz & 0xffff0000u)), g2 = silu_f(__uint_as_float((unsigned)(gz >> 32) << 16)), g3 = silu_f(__uint_as_float((unsigned)(gz >> 32) & 0xffff0000u));
            *(GAS unsigned long long*)(YM + (size_t)row * D + 1536 + idx) = (unsigned long long)pg8::cvt_pk_bf16(o.x * rr * gn.x * g0, o.y * rr * gn.y * g1) | ((unsigned long long)pg8::cvt_pk_bf16(o.z * rr * gn.z * g2, o.w * rr * gn.w * g3) << 32); }
    }
}

__device__ __forceinline__ void dispatch_phase(KA A, LAS unsigned char* lds, int tid, int wave, int lane, int bid) {
    unsigned char* ws = A->ws;
    LAS int* cnt = (LAS int*)lds;
    LAS int* tab = cnt + 2048;
    const int* gc = (const int*)(ws + WS_CNT);
    for (int i = tid; i < 2048; i += NTHR) cnt[i] = gc[i];
    __syncthreads();
    if (tid < 8) { int tot = 0, pre = 0; for (int w = 0; w < 256; ++w) { const int v = cnt[w * 8 + tid]; if (w < bid) pre += v; tot += v; } tab[8 + tid] = pre; tab[32 + tid] = (tot + 255) >> 8; }
    __syncthreads();
    if (tid == 0) { int tb = 0; for (int e = 0; e < 8; ++e) { tab[16 + e] = tb; tab[e] = tb * 256; tb += tab[32 + e]; } tab[24] = tb;
        if (bid == 0) { int* mi = (int*)(ws + WS_MOEINFO); for (int e = 0; e < 9; ++e) mi[e] = tab[16 + e]; } }
    __syncthreads();
    const int4* route = (const int4*)(ws + WS_ROUTE); int* tokpos = (int*)(ws + WS_TOKPOS);
    const bf16* XN = (const bf16*)(ws + WS_XN); bf16* AP = (bf16*)(ws + WS_APERM);
    for (int rl = wave; rl < 34; rl += NWAVES) { const int row = 34 * bid + rl; if ((row % TB) < CTXL) continue;
        const int4 r = route[row]; const int e1 = r.x & 15, e2 = (r.x >> 4) & 15, r1 = (r.x >> 8) & 255, r2 = (r.x >> 16) & 255;
        const int p1 = tab[e1] + tab[8 + e1] + r1, p2 = tab[e2] + tab[8 + e2] + r2;
        if (lane == 0) { tokpos[row * 2] = p1; tokpos[row * 2 + 1] = p2; }
        const GAS v4u* src = (const GAS v4u*)(XN + (size_t)row * D); GAS v4u* d1 = (GAS v4u*)(AP + (size_t)p1 * D); GAS v4u* d2 = (GAS v4u*)(AP + (size_t)p2 * D);
#pragma unroll
        for (int j = 0; j < 4; ++j) { const v4u v = src[lane + 64 * j]; d1[lane + 64 * j] = v; d2[lane + 64 * j] = v; }
    }
    __syncthreads();
}

__device__ __forceinline__ void combine_phase(KA A, int l, int wave, int lane, int bid, int G) {
    unsigned char* ws = A->ws; const float* H = (const float*)(ws + WS_H); const float* DO = (const float*)(ws + WS_DOUT);
    const int4* route = (const int4*)(ws + WS_ROUTE); const int* tokpos = (const int*)(ws + WS_TOKPOS);
    const float* modl = (const float*)(ws + WS_MODF) + (size_t)l * 3 * ADAW; const float* gf = A->in[I_GFINAL];
    for (int row = bid * NWAVES + wave; row < MR; row += G * NWAVES) { const int b = row / TB, s = row % TB; if (s < CTXL) continue;
        const int4 r = route[row]; const float w1 = __int_as_float(r.y), w2 = __int_as_float(r.z); const int p1 = tokpos[row * 2], p2 = tokpos[row * 2 + 1];
        const GAS f32x4* hr = (const GAS f32x4*)(H + (size_t)row * D) + lane; const GAS f32x4* a1 = (const GAS f32x4*)(DO + (size_t)p1 * D) + lane; const GAS f32x4* a2 = (const GAS f32x4*)(DO + (size_t)p2 * D) + lane;
        const GAS f32x4* gt = (const GAS f32x4*)(modl + (size_t)b * ADAW + 5 * D) + lane;
        f32x4 v[8]; float ss = 0.f;
#pragma unroll
        for (int j = 0; j < 8; ++j) { v[j] = hr[64 * j] + gt[64 * j] * (a1[64 * j] * w1 + a2[64 * j] * w2); ss += (v[j].x * v[j].x + v[j].y * v[j].y) + (v[j].z * v[j].z + v[j].w * v[j].w); }
        const float rstd = 1.0f / sqrtf(wave_sum(ss) * (1.f / D) + EPS);
        GAS f32x4* o = (GAS f32x4*)(A->out + (size_t)(b * SEQ + s - CTXL) * D) + lane; const GAS f32x4* gfv = (const GAS f32x4*)gf + lane;
#pragma unroll
        for (int j = 0; j < 8; ++j) o[64 * j] = v[j] * rstd * gfv[64 * j];
    }
}

__device__ __forceinline__ void ph_inproj(LAS unsigned char* lds, unsigned char* ws, int l, int bid, int G, int tid) {
    pg8::Gemm g{(const pg8::bf16_t*)(ws + WS_XN), (const pg8::bf16_t*)(ws + WS_WIN) + (size_t)l * NP * D, MR, NP, D};
    pg8::StaticOrder S; S.init(NMT, NP / 256, G, bid, 0);
    pg8::EpiP E{(pg8::bf16_t*)(ws + WS_P)};
    pg8::gemm_phase<pg8::EpiP, pg8::StaticOrder, true, true>(lds + RING_OFF, g, S, E, tid);
}
__device__ __forceinline__ void ph_outproj(LAS unsigned char* lds, unsigned char* ws, const float* x, const float* ctx, int l, int bid, int G, int tid) {
    pg8::Gemm g{(const pg8::bf16_t*)(ws + WS_YMIX), (const pg8::bf16_t*)(ws + WS_WOUT) + (size_t)l * D * D, MR, D, D};
    pg8::StaticOrder S; S.init(l ? 32 : NMT, D / 256, G, bid, l);
    pg8::EpiRes E{x, ctx, (float*)(ws + WS_H), (const float*)(ws + WS_MODF) + (size_t)l * 3 * ADAW, 2, l == 0 ? 1 : 0};
    pg8::gemm_phase<pg8::EpiRes, pg8::StaticOrder, true, true>(lds + RING_OFF, g, S, E, tid);
}
__device__ __forceinline__ void ph_ffnup(LAS unsigned char* lds, unsigned char* ws, int bid, int G, int tid) {
    pg8::Gemm g{(const pg8::bf16_t*)(ws + WS_XN), (const pg8::bf16_t*)(ws + WS_FUP), MR, 2 * FF, D};
    pg8::StaticOrder S; S.init(NMT, 2 * FF / 256, G, bid, 0);
    pg8::EpiSwiglu E{(pg8::bf16_t*)(ws + WS_ACT), FF, 2 * FF / 256};
    pg8::gemm_phase<pg8::EpiSwiglu, pg8::StaticOrder, true, true>(lds + RING_OFF, g, S, E, tid);
}
__device__ __forceinline__ void ph_ffndn(LAS unsigned char* lds, unsigned char* ws, int bid, int G, int tid) {
    pg8::Gemm g{(const pg8::bf16_t*)(ws + WS_ACT), (const pg8::bf16_t*)(ws + WS_FDN), MR, D, FF};
    pg8::StaticOrder S; S.init(NMT, D / 256, G, bid, 0);
    pg8::EpiRes E{nullptr, nullptr, (float*)(ws + WS_H), (const float*)(ws + WS_MODF), 5, 0};
    pg8::gemm_phase<pg8::EpiRes, pg8::StaticOrder, true, true>(lds + RING_OFF, g, S, E, tid);
}
__device__ __forceinline__ void ph_moeup(LAS unsigned char* lds, unsigned char* ws, int bid, int G, int tid) {
    const int* mi = (const int*)(ws + WS_MOEINFO);
    pg8::Gemm g{(const pg8::bf16_t*)(ws + WS_APERM), (const pg8::bf16_t*)(ws + WS_MUP), 0, 0, D};
    pg8::MoeOrder S{mi[8], 2 * FFE / 256, G, bid, mi[1], mi[2], mi[3], mi[4], mi[5], mi[6], mi[7]};
    pg8::EpiSwiglu E{(pg8::bf16_t*)(ws + WS_ACTM), FFE, 2 * FFE / 256};
    pg8::gemm_phase<pg8::EpiSwiglu, pg8::MoeOrder, true, true>(lds + RING_OFF, g, S, E, tid);
}
__device__ __forceinline__ void ph_moedn(LAS unsigned char* lds, unsigned char* ws, int bid, int G, int tid) {
    const int* mi = (const int*)(ws + WS_MOEINFO);
    pg8::Gemm g{(const pg8::bf16_t*)(ws + WS_ACTM), (const pg8::bf16_t*)(ws + WS_MDN), 0, 0, FFE};
    pg8::MoeOrder S{mi[8], D / 256, G, bid, mi[1], mi[2], mi[3], mi[4], mi[5], mi[6], mi[7]};
    pg8::EpiF32g E{(float*)(ws + WS_DOUT), D, D / 256};
    pg8::gemm_phase<pg8::EpiF32g, pg8::MoeOrder, true, true>(lds + RING_OFF, g, S, E, tid);
}

#ifndef MK_PER_PHASE
#define MK_PER_PHASE 0
#endif
constexpr int NPH = 24;
__global__ void __launch_bounds__(NTHR, 2) mk_fwd(Args args_unused) {
    extern __shared__ __attribute__((aligned(16))) unsigned char lds_raw[];
    LAS unsigned char* lds = (LAS unsigned char*)lds_raw;
    const int tid0 = threadIdx.x, bid0 = blockIdx.x, G0 = gridDim.x;
#define FRESH() int tid = tid0; asm volatile("" : "+v"(tid)); int bid = bid0, G = G0; asm volatile("" : "+s"(bid), "+s"(G)); const int lane = tid & 63, wave = __builtin_amdgcn_readfirstlane(tid >> 6); (void)lane; (void)wave; (void)bid; (void)G
    const int tid = tid0;
    volatile LAS unsigned* MISC = (volatile LAS unsigned*)(lds + MISC_OFF);
    for (int u = tid; u < (LDS_BYTES - LDSCTL_OFF) / 4; u += NTHR) ((LAS unsigned*)(lds + LDSCTL_OFF))[u] = 0u;
    __syncthreads();
    int lo, hi;
    XcdBarrier bar;
    { FRESH(); KA A = ka_get(); lo = A->ph_lo; hi = A->ph_hi; gu32* ctl = (gu32*)(A->ws + WS_CTL);
      bar.bar = (unsigned*)(ctl + CW_BAR); bar.x = 0; bar.st = nullptr;
      if (!MK_PER_PHASE) bar = xcd_barrier_post((unsigned*)(ctl + CW_BAR), MISC + 8); }
#define IN(k) (lo <= (k) && (k) < hi)
#define SEAM(k) do { if (!MK_PER_PHASE && IN(k) && IN((k) + 1)) xcd_barrier(bar); } while (0)

    if (IN(0)) { FRESH(); KA A = ka_get(); p0a_phase(A, lds, tid, wave, lane, bid, G); SEAM(0); }
    if (IN(1)) { FRESH(); KA A = ka_get(); p0b_phase(A, tid, bid, G); SEAM(1); }

    for (int l = 0; l < 2; ++l) {
        const int pb = 2 + 10 * l;
        if (IN(pb + 0)) { FRESH(); KA A = ka_get(); norm_phase<false>(A, lds, l, 0, tid, wave, lane, bid); SEAM(pb + 0); }
        if (IN(pb + 1)) { FRESH(); KA A = ka_get(); ph_inproj(lds, A->ws, l, bid, G, tid); SEAM(pb + 1); }
        if (IN(pb + 2)) {
            { FRESH(); KA A = ka_get(); for (int it = bid; it < 68 * 4; it += G) m1_sccm_item(A, lds, l, it, tid, wave, lane); }
            { FRESH(); KA A = ka_get(); for (int it = bid; it < 68 * 8; it += G) m1_mamba_item(A, lds, l, it, tid, wave, lane); }
            { FRESH(); KA A = ka_get(); for (int it = bid; it < 136 * 4; it += G) m1_gla_item(A, lds, l, it, tid, wave, lane); }
            SEAM(pb + 2);
        }
        if (IN(pb + 3)) { FRESH(); KA A = ka_get(); m2_phase(A, wave, lane, bid, G); SEAM(pb + 3); }
        if (IN(pb + 4)) {
            { FRESH(); KA A = ka_get(); for (int it = bid; it < 68 * 8; it += G) m3_mamba_item(A, lds, l, it, tid, wave, lane); }
            { FRESH(); KA A = ka_get(); for (int it = bid; it < 136 * 4; it += G) m3_gla_item(A, lds, it, tid, wave, lane); }
            SEAM(pb + 4);
        }
        if (IN(pb + 5)) { FRESH(); KA A = ka_get(); m4_phase(A, l, wave, lane, bid, G); SEAM(pb + 5); }
        if (IN(pb + 6)) { FRESH(); KA A = ka_get(); ph_outproj(lds, A->ws, A->in[I_X], A->in[I_CTX], l, bid, G, tid); SEAM(pb + 6); }
        if (l == 0) {
            if (IN(9)) { FRESH(); KA A = ka_get(); norm_phase<false>(A, lds, 0, 1, tid, wave, lane, bid); SEAM(9); }
            if (IN(10)) { FRESH(); KA A = ka_get(); ph_ffnup(lds, A->ws, bid, G, tid); SEAM(10); }
            if (IN(11)) { FRESH(); KA A = ka_get(); ph_ffndn(lds, A->ws, bid, G, tid); SEAM(11); }
        } else {
            if (IN(19)) { FRESH(); KA A = ka_get(); norm_phase<true>(A, lds, 1, 1, tid, wave, lane, bid); SEAM(19); }
            if (IN(20)) { FRESH(); KA A = ka_get(); dispatch_phase(A, lds, tid, wave, lane, bid); SEAM(20); }
            if (IN(21)) { FRESH(); KA A = ka_get(); ph_moeup(lds, A->ws, bid, G, tid); SEAM(21); }
            if (IN(22)) { FRESH(); KA A = ka_get(); ph_moedn(lds, A->ws, bid, G, tid); SEAM(22); }
            if (IN(23)) { FRESH(); KA A = ka_get(); combine_phase(A, 1, wave, lane, bid, G); }
        }
    }
#undef IN
#undef SEAM
}

extern "C" void kernel_launch(void* const* d_in, const int* in_sizes, int n_in, void* d_out, int out_size, void* d_ws, size_t ws_size, hipStream_t stream) {
    static int grid = 0;
    if (grid == 0) {
        if (n_in != N_IN || out_size != BATCH * SEQ * D || ws_size < WS_END) { fprintf(stderr, "kernel_launch: unexpected shapes: n_in %d out %d ws %zu (need %zu)\n", n_in, out_size, ws_size, (size_t)WS_END); grid = -1; return; }
        int dev = 0, cus = 0, per_cu = 0;
        if (hipGetDevice(&dev) != hipSuccess || hipDeviceGetAttribute(&cus, hipDeviceAttributeMultiprocessorCount, dev) != hipSuccess) { grid = -1; return; }
        if (hipFuncSetAttribute((const void*)mk_fwd, hipFuncAttributeMaxDynamicSharedMemorySize, LDS_BYTES) != hipSuccess) { fprintf(stderr, "kernel_launch: hipFuncSetAttribute failed\n"); grid = -1; return; }
        if (hipOccupancyMaxActiveBlocksPerMultiprocessor(&per_cu, (const void*)mk_fwd, NTHR, LDS_BYTES) != hipSuccess || per_cu < 1) fprintf(stderr, "kernel_launch: occupancy query says %d\n", per_cu);
        (void)hipGetLastError();
        grid = cus;
        if (grid != 256) { fprintf(stderr, "kernel_launch: built for 256 CUs, device has %d\n", grid); grid = -1; return; }
    }
    if (grid < 0) return;
    if (hipMemsetAsync((char*)d_ws + WS_CTL, 0, CTL_ZERO_BYTES, stream) != hipSuccess) return;
    Args a{};
    for (int i = 0; i < N_IN; ++i) a.in[i] = (const float*)d_in[i];
    a.out = (float*)d_out; a.ws = (unsigned char*)d_ws;
#if MK_PER_PHASE
    for (int p = 0; p < NPH; ++p) { a.ph_lo = p; a.ph_hi = p + 1; hipLaunchKernelGGL(mk_fwd, dim3(grid), dim3(NTHR), LDS_BYTES, stream, a); }
#else
    a.ph_lo = 0; a.ph_hi = NPH; hipLaunchKernelGGL(mk_fwd, dim3(grid), dim3(NTHR), LDS_BYTES, stream, a);
#endif
    const hipError_t le = hipPeekAtLastError();
    if (le != hipSuccess) fprintf(stderr, "kernel_launch: launch failed: %s\n", hipGetErrorName(le));
}
```

```cpp
#include <hip/hip_runtime.h>
#include <cstdio>
#include <cstdint>
namespace pg8 {
#define PG8_LAS __attribute__((address_space(3)))
typedef unsigned short bf16_t;
typedef short bf16x8 __attribute__((ext_vector_type(8)));
typedef float f32x4 __attribute__((ext_vector_type(4)));
typedef unsigned u32x4 __attribute__((ext_vector_type(4)));
constexpr int BM = 256, BK = 64, HALF = 128, HTB = HALF * BK * 2  , STAGE_BYTES = 8 * HTB, NXCD = 8, WGM = 8;

__host__ __device__ __forceinline__ int lds_byte(int r, int c) { const int st = (r >> 4) * 2 + (c >> 5), rr = r & 15, cc = c & 31, ob = rr * 64 + cc * 2; return st * 1024 + (ob ^ (((ob >> 9) & 1) << 5)); }
__host__ __device__ __forceinline__ void stage_rc(int b, int& R, int& C) { const int st = b / 1024, sb = b % 1024, swz = sb ^ (((sb >> 9) & 1) << 5); R = (st >> 1) * 16 + swz / 64; C = (st & 1) * 32 + (swz % 64) / 2; }
__host__ __device__ __forceinline__ int perm32(int rho) { const int n = rho >> 4, i = rho & 15; return 8 * (i >> 2) + 4 * n + (i & 3); }

struct Unit { int pm, pn, k0, nt, dst, tt; };
struct Gemm { const bf16_t* A; const bf16_t* Bt; int M, N, K; };
struct ConvHook { int t0, t1, trig; };
template <int NSLOT, bool MOE> __device__ __forceinline__ void conv_burst(const ConvHook& h, int bid, PG8_LAS unsigned char* T, int tid);

typedef __bf16 bf16n2 __attribute__((ext_vector_type(2)));
typedef float f32n2 __attribute__((ext_vector_type(2)));
__device__ __forceinline__ unsigned cvt_pk_bf16(float lo, float hi) { const f32n2 v = {lo, hi}; return __builtin_bit_cast(unsigned, __builtin_convertvector(v, bf16n2)); }
typedef float f32x2 __attribute__((ext_vector_type(2)));
constexpr int GRID = 256;
template <int NN, int NTF, int PPU, int PK, int XCOLS, int XPN0, bool HOOK = false>
struct MixOrder {
    int nM, c, skipctx, nx; ConvHook cv;
    __device__ bool next(int i, Unit& u) const {
        const int L = i * GRID + c, nwg = nM * NN;
        if (L >= nwg) { const int idx = L - nwg; if (idx >= nx * PPU) return false;
            const int piece = idx % PPU, un = idx / PPU; u.pm = (un / XCOLS) ? 17 : 0; u.pn = XPN0 + un % XCOLS; u.k0 = piece * PK; u.nt = PK / BK; return true; }
        int wgid = L; { const int q = nwg / NXCD, r = nwg % NXCD, xcd = wgid % NXCD, off = wgid / NXCD; wgid = (xcd < r ? xcd * (q + 1) : r * (q + 1) + (xcd - r) * q) + off; }
        const int nig = WGM * NN, gid = wgid / nig, fm = gid * WGM, gsz = (nM - fm) < WGM ? (nM - fm) : WGM;
        int pm = fm + ((wgid % nig) % gsz); u.pn = (wgid % nig) / gsz;
        if (skipctx) pm = pm + 1 + (pm >= 16 ? 1 : 0);
        u.pm = pm; u.k0 = 0; u.nt = NTF; return true;
    }
    __device__ __forceinline__ void a_ready(const Unit&) const {}
    __device__ __forceinline__ void done(const Unit&, int ui, PG8_LAS unsigned char* lds, int tid) const { if constexpr (HOOK) { if (ui == cv.trig) conv_burst<4, true>(cv, c, lds + 131072, tid); } }
};
template <int NT, int KS, int PK, int KT, bool HOOK = false>
struct MoeOrder {
    int mi[9]; int c; ConvHook cv;
    __device__ __forceinline__ MoeOrder(const int* p, int c_) : c(c_), cv{} {
#pragma unroll
        for (int j = 0; j < 9; ++j) mi[j] = __builtin_amdgcn_readfirstlane(p[j]); }
    __device__ bool next(int i, Unit& u) const {
        const int U = mi[8] * NT * KS, x = c & 7, q = U >> 3, r = U & 7;
        const int start = x * q + (x < r ? x : r), len = q + (x < r ? 1 : 0), j = c >> 3;
        int k = i * 32 + j, sub = 0, S = 1, slot = 0;
        if constexpr (KS == 2) {
            const int full = len & ~31, tl = len - full;
            if (i * 32 >= full) {
                if (i * 32 > full || tl == 0) return false;
                S = tl <= 8 ? 4 : (tl <= 16 ? 2 : 1);
                if (j >= tl * S) return false;
                const int ju = j % tl; k = full + ju; sub = j / tl; slot = x * 16 + ju; }
        } else { if (k >= len) return false; }
        const int L = start + k;
        int t0 = mi[0], t1 = mi[1], e = 0;
#pragma unroll
        for (int j = 1; j < 8; ++j) { const bool ge = L >= mi[j] * NT * KS; t0 = ge ? mi[j] : t0; t1 = ge ? mi[j + 1] : t1; e += ge ? 1 : 0; }
        const int me = t1 - t0, local = L - t0 * NT * KS;
        const int m = local % me, rest = local / me, n = rest % NT, piece = rest / NT;
        int kt0 = 0, ntk = PK / KT;
        if constexpr (KS == 2) { static_assert(PK / KT == 28, "tail split assumes 28 K-tiles per piece");
            if (S == 4) { kt0 = (sub >> 1) * 14 + (sub & 1) * 8; ntk = (sub & 1) ? 6 : 8; } else if (S == 2) { kt0 = 14 * sub; ntk = 14; } }
        u.pm = t0 + m; u.pn = e * NT + n; u.k0 = piece * PK + kt0 * KT; u.nt = ntk;
        u.dst = sub == 0 ? piece : 2 + slot * 3 + (sub - 1); u.tt = (S > 1 && sub == 0) ? ((slot << 3) | S) : 0; return true;
    }
    __device__ __forceinline__ void a_ready(const Unit&) const {}
    __device__ __forceinline__ void done(const Unit&, int ui, PG8_LAS unsigned char* lds, int tid) const { if constexpr (HOOK) { if (ui == cv.trig) conv_burst<4, true>(cv, c, lds + 131072, tid); } }
};
template <class Epi, class Sched, bool ALIGN_EPI = false, bool SP2 = false>
__device__ __forceinline__ void gemm_phase(PG8_LAS unsigned char* lds, const Gemm g, const Sched& S, const Epi& E, const int tid) {
    const int wid = __builtin_amdgcn_readfirstlane(tid >> 6), lane = tid & 63, wr = wid >> 2, wc = wid & 3, fr = lane & 15, fq = lane >> 4;
    const int K = g.K; int nt;
    unsigned voffA[2], voffB[2];
#pragma unroll
    for (int i = 0; i < 2; ++i) { int R, C; stage_rc(tid * 16 + i * 8192, R, C); const int Rb = Epi::PERM ? ((R & ~31) + perm32(R & 31)) : R;
        voffA[i] = (unsigned)(R * K + C) * 2u; voffB[i] = (unsigned)(Rb * K + C) * 2u; }
    const size_t kstep = (size_t)(BK * 2);
    const size_t hstep = (size_t)HALF * K * 2;
    const size_t tstep = 2 * hstep;
    const unsigned ldsw = (unsigned)wid * 1024u;
    const int aoff = lds_byte(wr * 64 + fr, fq * 8), boff = lds_byte(wc * 32 + fr, fq * 8);
#define PG8_SA(b, h) (((b) * 2 + (h)) * HTB)
#define PG8_SB(b, h) ((4 + (b) * 2 + (h)) * HTB)
#define PG8_STAGE(bufoff, gbase, voff) do { _Pragma("unroll") for (int _i = 0; _i < 2; ++_i) \
        __builtin_amdgcn_global_load_lds((const unsigned*)((const char*)(gbase) + (voff)[_i]), (PG8_LAS unsigned*)(lds + (bufoff) + ldsw + _i * 8192), 16, 0, 0); } while (0)
#define PG8_LDA(dst, b, h) do { _Pragma("unroll") for (int m = 0; m < 4; ++m) _Pragma("unroll") for (int k = 0; k < 2; ++k) dst[m][k] = *(const PG8_LAS bf16x8*)(lds + PG8_SA(b, h) + aoff + m * 2048 + k * 1024); } while (0)
#define PG8_LDB(dst, b, h) do { _Pragma("unroll") for (int n = 0; n < 2; ++n) _Pragma("unroll") for (int k = 0; k < 2; ++k) dst[n][k] = *(const PG8_LAS bf16x8*)(lds + PG8_SB(b, h) + boff + n * 2048 + k * 1024); } while (0)
#define PG8_MMA(ai, bj, At, Bt) do { __builtin_amdgcn_s_setprio(1); _Pragma("unroll") for (int m = 0; m < 4; ++m) _Pragma("unroll") for (int n = 0; n < 2; ++n) _Pragma("unroll") for (int k = 0; k < 2; ++k) \
        acc[ai][bj][m][n] = __builtin_amdgcn_mfma_f32_16x16x32_bf16(Bt[n][k], At[m][k], acc[ai][bj][m][n], 0, 0, 0); __builtin_amdgcn_s_setprio(0); } while (0)
#define PG8_WAIT_V(n) asm volatile("s_waitcnt vmcnt(" #n ")" ::: "memory")
#define PG8_WAIT_L(n) asm volatile("s_waitcnt lgkmcnt(" #n ")" ::: "memory")
#define PG8_BAR __builtin_amdgcn_s_barrier()
#define PG8_SCHED __builtin_amdgcn_sched_barrier(0)
    Unit cur, nxt; int ui = 0;
    if (!S.next(0, cur)) return;
    f32x4 acc[2][2][4][2];
#pragma unroll
    for (int a = 0; a < 2; ++a)
#pragma unroll
        for (int b = 0; b < 2; ++b)
#pragma unroll
            for (int m = 0; m < 4; ++m)
#pragma unroll
                for (int n = 0; n < 2; ++n) acc[a][b][m][n] = (f32x4){0.f, 0.f, 0.f, 0.f};
    bf16x8 At[4][2], B0[2][2], B1[2][2];
    const char* cA = (const char*)g.A + (size_t)cur.pm * tstep + (size_t)cur.k0 * 2; const char* cB = (const char*)g.Bt + (size_t)cur.pn * tstep + (size_t)cur.k0 * 2; nt = cur.nt;
    S.a_ready(cur);
    if constexpr (SP2) {
        PG8_STAGE(PG8_SB(0, 0), cB, voffB); PG8_STAGE(PG8_SB(0, 1), cB + hstep, voffB); PG8_STAGE(PG8_SA(0, 0), cA, voffA); PG8_STAGE(PG8_SA(0, 1), cA + hstep, voffA);
        if (wr == 1) PG8_BAR;
        PG8_WAIT_V(2); PG8_BAR;
        PG8_STAGE(PG8_SB(1, 0), cB + kstep, voffB); PG8_STAGE(PG8_SA(1, 0), cA + kstep, voffA); PG8_STAGE(PG8_SB(1, 1), cB + hstep + kstep, voffB);
        PG8_WAIT_V(6); PG8_BAR;
    } else {
        PG8_STAGE(PG8_SB(0, 0), cB, voffB); PG8_STAGE(PG8_SA(0, 0), cA, voffA); PG8_STAGE(PG8_SB(0, 1), cB + hstep, voffB); PG8_STAGE(PG8_SA(0, 1), cA + hstep, voffA);
        if (wr == 1) PG8_BAR;
        PG8_WAIT_V(4); PG8_BAR;
        PG8_STAGE(PG8_SB(1, 0), cB + kstep, voffB); PG8_STAGE(PG8_SA(1, 0), cA + kstep, voffA); PG8_STAGE(PG8_SB(1, 1), cB + hstep + kstep, voffB);
        PG8_WAIT_V(6); PG8_BAR;
    }
    for (;;) {
        const bool has_next = S.next(ui + 1, nxt);
        const char* nA = has_next ? (const char*)g.A + (size_t)nxt.pm * tstep + (size_t)nxt.k0 * 2 : cA; const char* nB = has_next ? (const char*)g.Bt + (size_t)nxt.pn * tstep + (size_t)nxt.k0 * 2 : cB;
        for (int t = 0; t < nt; t += 2) {
            const bool last = (t == nt - 2);
            const char* a1 = cA + (size_t)(t + 1) * kstep;
            const char* a2 = last ? nA : cA + (size_t)(t + 2) * kstep; const char* b2 = last ? nB : cB + (size_t)(t + 2) * kstep;
            const char* a3 = a2 + kstep; const char* b3 = b2 + kstep;
            if (last && has_next) S.a_ready(nxt);
            if constexpr (SP2) {
            PG8_LDB(B0, 0, 0); PG8_LDB(B1, 0, 1); PG8_SCHED; PG8_LDA(At, 0, 0); PG8_STAGE(PG8_SA(1, 1), a1 + hstep, voffA);
            PG8_WAIT_V(8); PG8_WAIT_L(0); PG8_BAR; PG8_MMA(0, 0, At, B0); PG8_MMA(0, 1, At, B1); PG8_BAR; PG8_SCHED;
            PG8_LDA(At, 0, 1); PG8_STAGE(PG8_SB(0, 0), b2, voffB); PG8_STAGE(PG8_SB(0, 1), b2 + hstep, voffB); PG8_STAGE(PG8_SA(0, 0), a2, voffA);
            PG8_WAIT_V(8); PG8_WAIT_L(0); PG8_BAR; PG8_MMA(1, 0, At, B0); PG8_MMA(1, 1, At, B1); PG8_BAR; PG8_SCHED;
            PG8_LDB(B0, 1, 0); PG8_LDB(B1, 1, 1); PG8_SCHED; PG8_LDA(At, 1, 0); PG8_STAGE(PG8_SA(0, 1), a2 + hstep, voffA);
            PG8_WAIT_V(8); PG8_WAIT_L(0); PG8_BAR; PG8_MMA(0, 0, At, B0); PG8_MMA(0, 1, At, B1); PG8_BAR; PG8_SCHED;
            PG8_LDA(At, 1, 1); PG8_STAGE(PG8_SB(1, 0), b3, voffB); PG8_STAGE(PG8_SB(1, 1), b3 + hstep, voffB); PG8_STAGE(PG8_SA(1, 0), a3, voffA);
            PG8_WAIT_V(8); PG8_WAIT_L(0); PG8_BAR; PG8_MMA(1, 0, At, B0); PG8_MMA(1, 1, At, B1); PG8_BAR; PG8_SCHED;
            } else {
            PG8_LDB(B0, 0, 0); PG8_SCHED; PG8_LDA(At, 0, 0); PG8_STAGE(PG8_SA(1, 1), a1 + hstep, voffA);
            PG8_WAIT_L(8); PG8_BAR; PG8_WAIT_L(0); PG8_MMA(0, 0, At, B0); PG8_BAR; PG8_SCHED;
            PG8_LDB(B1, 0, 1); PG8_STAGE(PG8_SB(0, 0), b2, voffB);
            PG8_BAR; PG8_WAIT_L(0); PG8_MMA(0, 1, At, B1); PG8_BAR;
            PG8_LDA(At, 0, 1); PG8_STAGE(PG8_SA(0, 0), a2, voffA);
            PG8_BAR; PG8_WAIT_L(0); PG8_MMA(1, 0, At, B0); PG8_BAR; PG8_SCHED;
            PG8_STAGE(PG8_SB(0, 1), b2 + hstep, voffB);
            PG8_WAIT_V(6); PG8_BAR; PG8_MMA(1, 1, At, B1); PG8_BAR;
            PG8_LDB(B0, 1, 0); PG8_SCHED; PG8_LDA(At, 1, 0); PG8_STAGE(PG8_SA(0, 1), a2 + hstep, voffA);
            PG8_WAIT_L(8); PG8_BAR; PG8_WAIT_L(0); PG8_MMA(0, 0, At, B0); PG8_BAR; PG8_SCHED;
            PG8_LDB(B1, 1, 1); PG8_STAGE(PG8_SB(1, 0), b3, voffB);
            PG8_BAR; PG8_WAIT_L(0); PG8_MMA(0, 1, At, B1); PG8_BAR;
            PG8_LDA(At, 1, 1); PG8_STAGE(PG8_SA(1, 0), a3, voffA);
            PG8_BAR; PG8_WAIT_L(0); PG8_MMA(1, 0, At, B0); PG8_BAR; PG8_SCHED;
            PG8_STAGE(PG8_SB(1, 1), b3 + hstep, voffB);
            PG8_WAIT_V(6); PG8_BAR; PG8_MMA(1, 1, At, B1); PG8_BAR;
            }
        }
        if constexpr (ALIGN_EPI) { if (wr == 0) PG8_BAR; }
        if constexpr (!Epi::AFTER_DRAIN) { E(acc, cur, wr, wc, fr, fq); S.done(cur, ui, lds, tid); }
        if (!has_next) break;
#pragma unroll
        for (int a = 0; a < 2; ++a)
#pragma unroll
            for (int b = 0; b < 2; ++b)
#pragma unroll
                for (int m = 0; m < 4; ++m)
#pragma unroll
                    for (int n = 0; n < 2; ++n) acc[a][b][m][n] = (f32x4){0.f, 0.f, 0.f, 0.f};
        cur = nxt; cA = nA; cB = nB; ++ui; nt = cur.nt;
        if constexpr (ALIGN_EPI) { if (wr == 1) PG8_BAR; }
    }
    PG8_WAIT_V(0);
    if constexpr (!ALIGN_EPI) { if (wr == 0) PG8_BAR; }
    PG8_BAR;
    if constexpr (Epi::AFTER_DRAIN) { E.fused(acc, cur, wr, wc, fr, fq, lds, wid, lane); S.done(cur, ui, lds, tid); }
#undef PG8_SA
#undef PG8_SB
#undef PG8_STAGE
#undef PG8_LDA
#undef PG8_LDB
#undef PG8_MMA
#undef PG8_WAIT_V
#undef PG8_WAIT_L
#undef PG8_BAR
#undef PG8_SCHED
}

typedef int v8i __attribute__((ext_vector_type(8)));
typedef float f32x16 __attribute__((ext_vector_type(16)));
typedef float f32x2 __attribute__((ext_vector_type(2)));
__device__ __forceinline__ v8i cat8(bf16x8 lo, bf16x8 hi) { typedef int i4v __attribute__((ext_vector_type(4))); const i4v a = __builtin_bit_cast(i4v, lo), b = __builtin_bit_cast(i4v, hi); return __builtin_shufflevector(a, b, 0, 1, 2, 3, 4, 5, 6, 7); }
__host__ __device__ __forceinline__ int f8swz(int R) { return (R >> 1) & 7; }
__host__ __device__ __forceinline__ int permf8(int rho) { return 16 * ((rho >> 2) & 1) + 4 * (rho >> 3) + (rho & 3); }
template <class Epi, class Sched, int SCW, int SCX, int SCW1 = SCW>
__device__ __forceinline__ void gemm_phase_f8(PG8_LAS unsigned char* lds, const Gemm g, const Sched& S, const Epi& E, const int tid) {
    const int wid = __builtin_amdgcn_readfirstlane(tid >> 6), lane = tid & 63, wr = wid >> 2, wc = wid & 3, r32 = lane & 31, kh = lane >> 5;
    const int K = g.K; int nt;
    unsigned voffA[2], voffB[2];
#pragma unroll
    for (int i = 0; i < 2; ++i) { const int bb = tid * 16 + i * 8192, R = bb >> 7, C = 16 * (((bb >> 4) & 7) ^ f8swz(R)); const int Rb = Epi::PERM ? ((R & ~31) + permf8(R & 31)) : R;
        voffA[i] = (unsigned)(R * K + C); voffB[i] = (unsigned)(Rb * 128 + C); }
    const size_t kstep = 128, hstep = (size_t)HALF * K, tstep = 2 * hstep, kstepB = 32768, hstepB = 16384;
    const unsigned ldsw = (unsigned)wid * 1024u;
    int aoffk[2][2], boffk[2][2];
#pragma unroll
    for (int s = 0; s < 2; ++s)
#pragma unroll
        for (int h2 = 0; h2 < 2; ++h2) { const int ch = 16 * ((4 * s + 2 * kh + h2) ^ f8swz(r32)); aoffk[s][h2] = (wr * 64 + r32) * 128 + ch; boffk[s][h2] = (wc * 32 + r32) * 128 + ch; }
#define PG8_SA(b, h) (((b) * 2 + (h)) * HTB)
#define PG8_SB(b, h) ((4 + (b) * 2 + (h)) * HTB)
#define PG8_STAGE(bufoff, gbase, voff) do { _Pragma("unroll") for (int _i = 0; _i < 2; ++_i) \
        __builtin_amdgcn_global_load_lds((const unsigned*)((const char*)(gbase) + (voff)[_i]), (PG8_LAS unsigned*)(lds + (bufoff) + ldsw + _i * 8192), 16, 0, 0); } while (0)
#define PG8_LDA(dst, b, h) do { _Pragma("unroll") for (int mb = 0; mb < 2; ++mb) _Pragma("unroll") for (int s = 0; s < 2; ++s) \
        dst[mb][s] = cat8(*(const PG8_LAS bf16x8*)(lds + PG8_SA(b, h) + aoffk[s][0] + mb * 4096), *(const PG8_LAS bf16x8*)(lds + PG8_SA(b, h) + aoffk[s][1] + mb * 4096)); } while (0)
#define PG8_LDB(dst, b, h) do { _Pragma("unroll") for (int s = 0; s < 2; ++s) \
        dst[s] = cat8(*(const PG8_LAS bf16x8*)(lds + PG8_SB(b, h) + boffk[s][0]), *(const PG8_LAS bf16x8*)(lds + PG8_SB(b, h) + boffk[s][1])); } while (0)
#define PG8_MMA(ai, bj, At, Bt) do { __builtin_amdgcn_s_setprio(1); _Pragma("unroll") for (int mb = 0; mb < 2; ++mb) _Pragma("unroll") for (int s = 0; s < 2; ++s) \
        acc[ai][bj][mb] = __builtin_amdgcn_mfma_scale_f32_32x32x64_f8f6f4(Bt[s], At[mb][s], acc[ai][bj][mb], 0, 0, 0, (bj) ? SCW1 : SCW, 0, SCX); __builtin_amdgcn_s_setprio(0); } while (0)
#define PG8_WAIT_V(n) asm volatile("s_waitcnt vmcnt(" #n ")" ::: "memory")
#define PG8_WAIT_L(n) asm volatile("s_waitcnt lgkmcnt(" #n ")" ::: "memory")
#define PG8_BAR __builtin_amdgcn_s_barrier()
#define PG8_SCHED __builtin_amdgcn_sched_barrier(0)
#define PG8_ZERO() do { _Pragma("unroll") for (int a = 0; a < 2; ++a) _Pragma("unroll") for (int b = 0; b < 2; ++b) _Pragma("unroll") for (int m = 0; m < 2; ++m) _Pragma("unroll") for (int e = 0; e < 16; ++e) acc[a][b][m][e] = 0.f; } while (0)
    Unit cur, nxt; int ui = 0;
    if (!S.next(0, cur)) return;
    f32x16 acc[2][2][2]; PG8_ZERO();
    v8i At[2][2], B0[2], B1[2];
    const char* cA = (const char*)g.A + (size_t)cur.pm * tstep + (size_t)cur.k0; const char* cB = (const char*)g.Bt + (size_t)cur.pn * tstep + (size_t)cur.k0 * 256; nt = cur.nt;
    S.a_ready(cur);
    PG8_STAGE(PG8_SB(0, 0), cB, voffB); PG8_STAGE(PG8_SB(0, 1), cB + hstepB, voffB); PG8_STAGE(PG8_SA(0, 0), cA, voffA); PG8_STAGE(PG8_SA(0, 1), cA + hstep, voffA);
    if (wr == 1) PG8_BAR;
    PG8_WAIT_V(2); PG8_BAR;
    PG8_STAGE(PG8_SB(1, 0), cB + kstepB, voffB); PG8_STAGE(PG8_SA(1, 0), cA + kstep, voffA); PG8_STAGE(PG8_SB(1, 1), cB + hstepB + kstepB, voffB);
    PG8_WAIT_V(6); PG8_BAR;
    for (;;) {
        const bool has_next = S.next(ui + 1, nxt);
        const char* nA = has_next ? (const char*)g.A + (size_t)nxt.pm * tstep + (size_t)nxt.k0 : cA; const char* nB = has_next ? (const char*)g.Bt + (size_t)nxt.pn * tstep + (size_t)nxt.k0 * 256 : cB;
        for (int t = 0; t < nt; t += 2) {
            const bool last = (t == nt - 2);
            const char* a1 = cA + (size_t)(t + 1) * kstep;
            const char* a2 = last ? nA : cA + (size_t)(t + 2) * kstep; const char* b2 = last ? nB : cB + (size_t)(t + 2) * kstepB;
            const char* a3 = a2 + kstep; const char* b3 = b2 + kstepB;
            if (last && has_next) S.a_ready(nxt);
            PG8_LDB(B0, 0, 0); PG8_LDB(B1, 0, 1); PG8_SCHED; PG8_LDA(At, 0, 0); PG8_STAGE(PG8_SA(1, 1), a1 + hstep, voffA);
            PG8_WAIT_V(8); PG8_WAIT_L(0); PG8_BAR; PG8_MMA(0, 0, At, B0); PG8_MMA(0, 1, At, B1); PG8_BAR; PG8_SCHED;
            PG8_LDA(At, 0, 1); PG8_STAGE(PG8_SB(0, 0), b2, voffB); PG8_STAGE(PG8_SB(0, 1), b2 + hstepB, voffB); PG8_STAGE(PG8_SA(0, 0), a2, voffA);
            PG8_WAIT_V(8); PG8_WAIT_L(0); PG8_BAR; PG8_MMA(1, 0, At, B0); PG8_MMA(1, 1, At, B1); PG8_BAR; PG8_SCHED;
            PG8_LDB(B0, 1, 0); PG8_LDB(B1, 1, 1); PG8_SCHED; PG8_LDA(At, 1, 0); PG8_STAGE(PG8_SA(0, 1), a2 + hstep, voffA);
            PG8_WAIT_V(8); PG8_WAIT_L(0); PG8_BAR; PG8_MMA(0, 0, At, B0); PG8_MMA(0, 1, At, B1); PG8_BAR; PG8_SCHED;
            PG8_LDA(At, 1, 1); PG8_STAGE(PG8_SB(1, 0), b3, voffB); PG8_STAGE(PG8_SB(1, 1), b3 + hstepB, voffB); PG8_STAGE(PG8_SA(1, 0), a3, voffA);
            PG8_WAIT_V(8); PG8_WAIT_L(0); PG8_BAR; PG8_MMA(1, 0, At, B0); PG8_MMA(1, 1, At, B1); PG8_BAR; PG8_SCHED;
        }
        if (wr == 0) PG8_BAR;
        E(acc, cur, wr, wc, r32, kh); S.done(cur, ui, lds, tid);
        if (!has_next) break;
        PG8_ZERO();
        cur = nxt; cA = nA; cB = nB; ++ui; nt = cur.nt;
        if (wr == 1) PG8_BAR;
    }
    PG8_WAIT_V(0);
    PG8_BAR;
#undef PG8_SA
#undef PG8_SB
#undef PG8_STAGE
#undef PG8_LDA
#undef PG8_LDB
#undef PG8_MMA
#undef PG8_WAIT_V
#undef PG8_WAIT_L
#undef PG8_BAR
#undef PG8_SCHED
#undef PG8_ZERO
}
}

constexpr int NWAVES = 8, NTHR = 512;
constexpr int D = 2048, BATCH = 2, SEQ = 4096, CTXL = 256, TB = CTXL + SEQ  , MR = BATCH * TB  ;
constexpr int NMT = MR / 256;
constexpr int PSRC = 5680, NP = 5632, NSM = 48;
constexpr int FF = 5632, FFE = 7168, NE = 8;
constexpr int NMOD = 6, ADAW = NMOD * D;
constexpr int MOE_TILES = 72, MOE_ROWS = MOE_TILES * 256;
constexpr float EPS = 1e-6f;
constexpr int C_BG = 0, C_CG = 512, C_XA = 1024, C_CMU = 1536, C_CMV = 2048, C_Z = 2560, C_XS = 3072, C_BM = 3584, C_CM = 3840, C_Q = 4096, C_K = 4352, C_V = 4608, C_G = 5120;
constexpr int NCH_M = TB / 128  , NCH_G = TB / 64  ;

constexpr size_t MiB = 1u << 20;
constexpr size_t WS_CTL = 0, CTL_ZERO_BYTES = 1 * MiB;
constexpr size_t WS_MODF = 1 * MiB;
constexpr size_t WS_ADAP = 2 * MiB;
constexpr size_t WS_ALAST = 12 * MiB;
constexpr size_t WS_GLAST = 12 * MiB + 65536;
constexpr size_t WS_EA = 13 * MiB;
constexpr size_t WS_ROUTE = 14 * MiB;
constexpr size_t WS_CNT = 14 * MiB + 512 * 1024;
constexpr size_t WS_TOKPOS = 14 * MiB + 768 * 1024;
constexpr size_t WS_MOEINFO = 15 * MiB;
constexpr size_t WS_WSM = 15 * MiB + 65536;
constexpr size_t WS_PS = 1012 * MiB;
constexpr size_t WS_PART = 1579 * MiB;
constexpr size_t WS_DOUT2 = 918 * MiB;
constexpr size_t WS_WIN = 16 * MiB;
constexpr size_t WS_WOUT = 62 * MiB;
constexpr size_t WS_FUP = 78 * MiB;
constexpr size_t WS_FDN = 122 * MiB;
constexpr size_t WS_MUP = 144 * MiB;
constexpr size_t WS_MDN = 592 * MiB;
constexpr size_t WS_H = 816 * MiB;
constexpr size_t WS_XN = 884 * MiB;
constexpr size_t WS_P = 918 * MiB;
constexpr size_t WS_YMIX = 1016 * MiB;
constexpr size_t WS_YMB = 1050 * MiB;
constexpr size_t WS_YGLA = 1067 * MiB;
constexpr size_t WS_CSM = 1084 * MiB;
constexpr size_t WS_CSG = 1118 * MiB;
constexpr size_t WS_QE = 1152 * MiB;
constexpr size_t WS_ACT = 1161 * MiB;
constexpr size_t WS_APERM = 1255 * MiB;
constexpr size_t WS_ACTM = 1327 * MiB;
constexpr size_t WS_DOUT = 1579 * MiB;
constexpr size_t WS_END = 1723 * MiB;
constexpr size_t WS_SSM = 1161 * MiB, WS_SSG = 1180 * MiB;
constexpr size_t WS_XT = 1016 * MiB;
constexpr size_t WS_TT = WS_CTL + 512 * 1024;
static_assert(WS_WIN + (size_t)2 * NP * D * 2 <= WS_WOUT && WS_WOUT + (size_t)2 * D * D * 2 <= WS_FUP && WS_FUP + (size_t)2 * FF * D * 2 <= WS_FDN && WS_FDN + (size_t)D * FF * 2 <= WS_MUP, "ws map 1");
static_assert(WS_MUP + (size_t)NE * 2 * FFE * D * 2 <= WS_MDN && WS_MDN + (size_t)NE * D * FFE * 2 <= WS_H && WS_H + (size_t)MR * D * 4 <= WS_XN && WS_XN + (size_t)MR * D * 2 <= WS_P, "ws map 2");
static_assert(WS_P + (size_t)MR * NP * 2 <= WS_YMIX && WS_YMIX + (size_t)MR * D * 2 <= WS_YMB && WS_YMB + (size_t)MR * 512 * 4 <= WS_YGLA && WS_YGLA + (size_t)MR * 512 * 4 <= WS_CSM, "ws map 3");
static_assert(WS_CSM + (size_t)BATCH * NCH_M * 2 * 8 * 64 * 128 * 4 <= WS_CSG && WS_CSG + (size_t)BATCH * NCH_G * 2 * 4 * 64 * 128 * 4 <= WS_QE && WS_QE + (size_t)MR * 512 * 2 <= WS_ACT && WS_ACT + (size_t)MR * FF * 2 <= WS_APERM, "ws map 4");
static_assert(WS_APERM + (size_t)MOE_ROWS * D * 2 <= WS_ACTM && WS_ACTM + (size_t)MOE_ROWS * FFE * 2 <= WS_DOUT && WS_DOUT + (size_t)MOE_ROWS * D * 4 <= WS_END, "ws map 5");
static_assert(WS_ADAP + (size_t)2 * 32 * 3 * ADAW * 4 <= WS_ALAST && WS_GLAST + (size_t)BATCH * NCH_G * 2 * 4 * 64 * 4 <= WS_EA && WS_EA + (size_t)MR * 16 * 4 <= WS_ROUTE && WS_ROUTE + (size_t)MR * 16 <= WS_CNT, "ws map 6");
constexpr int CW_TMO = 0, CW_BAR = 4096;

constexpr int RING_OFF = 0, RING_BYTES = 131072;
constexpr int CONV_OFF = RING_BYTES, CONV_BYTES = 16384;
constexpr int LDSCTL_OFF = CONV_OFF + CONV_BYTES, MISC_OFF = LDSCTL_OFF + 320;
constexpr int LDS_BYTES = 163840;

enum { I_X = 0, I_C, I_CTX, I_CCTX, I_WADA, I_BADA, I_GMIX, I_GFFN, I_WIN, I_WOUT, I_SCW, I_CMW, I_CMB, I_MBCW, I_MBCB, I_MBALOG, I_MBDTB, I_MBD, I_MBNG, I_GLAWG, I_GLABG, I_GLANG,
       I_FWG, I_FWU, I_FWD, I_MROUTER, I_MWG, I_MWU, I_MWD, I_GFINAL, N_IN };
#define GAS __attribute__((address_space(1)))
#define LAS __attribute__((address_space(3)))
typedef unsigned short bf16;
typedef unsigned v4u __attribute__((ext_vector_type(4)));
typedef float f32x4 __attribute__((ext_vector_type(4)));
typedef short bf16x8 __attribute__((ext_vector_type(8)));
typedef GAS unsigned gu32;
typedef GAS unsigned long long gu64;
#define RLX_AGENT __ATOMIC_RELAXED, __HIP_MEMORY_SCOPE_AGENT
#define LDS_WAIT() asm volatile("s_waitcnt lgkmcnt(0)" ::: "memory")
#define VM_WAIT() asm volatile("s_waitcnt vmcnt(0)" ::: "memory")
__device__ __forceinline__ unsigned long long rt() { return __builtin_amdgcn_s_memrealtime(); }
__device__ __forceinline__ unsigned f2bf(float f) { return (unsigned)__builtin_bit_cast(unsigned short, (__bf16)f); }
__device__ __forceinline__ unsigned pk2(float lo, float hi) { return pg8::cvt_pk_bf16(lo, hi); }

#define XB_TMO      128
#define XB_XCNT(j)  (256  + 64 * (j))
#define XB_XSUB(j)  (1280 + 64 * (j))
#define XB_XGEN(j)  (2304 + 64 * (j))
#define XB_TOP      3328
#define XB_TOPGEN   3392
#define XCD_BAR_WORDS 3456
#define XB_SPIN_CAP (1u << 18)

__device__ __forceinline__ unsigned xb_ld(unsigned* p)              { return __hip_atomic_load(p, __ATOMIC_RELAXED, __HIP_MEMORY_SCOPE_AGENT); }
__device__ __forceinline__ unsigned xb_add(unsigned* p, unsigned v) { return __hip_atomic_fetch_add(p, v, __ATOMIC_RELAXED, __HIP_MEMORY_SCOPE_AGENT); }
__device__ __forceinline__ unsigned xb_xcc_id() { return (unsigned)__builtin_amdgcn_s_getreg((3 << 11) | 20) & 0xFu; }
#define XB_SPIN(cond, bar) do { unsigned _sp = 0; while (cond) { __builtin_amdgcn_s_sleep(1); \
    if ((++_sp & 255u) == 0u) { if (xb_ld(&(bar)[XB_TMO])) break; if (_sp > XB_SPIN_CAP) { atomicAdd(&(bar)[XB_TMO], 1u); break; } } } } while (0)

struct XcdBarrier {
    unsigned* bar; unsigned x;
    volatile LAS unsigned* st;
};

__device__ __forceinline__ XcdBarrier xcd_barrier_post(unsigned* bar, volatile LAS unsigned* st) {
    XcdBarrier b; b.bar = bar; b.x = xb_xcc_id(); b.st = st;
    if (threadIdx.x == 0) (void)xb_add(&bar[XB_XCNT(b.x)], 1u);
    return b;
}
__device__ __forceinline__ void xcd_barrier_complete(unsigned* bar, unsigned x, unsigned& nloc, unsigned& nx) {
    const unsigned G = gridDim.x * gridDim.y * gridDim.z;
    unsigned sum, cnt, mine, sp = 0u;
    for (;;) {
        sum = 0u; cnt = 0u; mine = 0u;
#pragma unroll
        for (unsigned j = 0; j < 16; ++j) { const unsigned c = xb_ld(&bar[XB_XCNT(j)]); sum += c; cnt += (c > 0u) ? 1u : 0u; mine = (j == x) ? c : mine; }
        if (sum == G) break;
        __builtin_amdgcn_s_sleep(1);
        if ((++sp & 255u) == 0u) { if (xb_ld(&bar[XB_TMO])) break; if (sp > XB_SPIN_CAP) { atomicAdd(&bar[XB_TMO], 1u); break; } }
    }
    nloc = mine > 0u ? mine : 1u; nx = cnt > 0u ? cnt : 1u;
}

__device__ __forceinline__ void xcd_barrier(const XcdBarrier& b) {
    asm volatile("s_waitcnt vmcnt(0)" ::: "memory");
    __syncthreads();
    if (threadIdx.x == 0) {
        unsigned* bar = b.bar;
        __builtin_amdgcn_s_waitcnt(0);
        unsigned nloc = b.st[0], nx = b.st[1];
        if (nloc == 0u) { xcd_barrier_complete(bar, b.x, nloc, nx); b.st[0] = nloc; b.st[1] = nx; }
        const unsigned old = xb_add(&bar[XB_XSUB(b.x)], 1u);
        const unsigned gen = old / nloc;
        if (old + 1u == (gen + 1u) * nloc) {
            __builtin_amdgcn_fence(__ATOMIC_RELEASE, "agent");
            asm volatile("s_waitcnt vmcnt(0)" ::: "memory");
            const unsigned og = xb_add(&bar[XB_TOP], 1u);
            const unsigned tg = og / nx;
            if (og + 1u == (tg + 1u) * nx) xb_add(&bar[XB_TOPGEN], 1u);
            else XB_SPIN(xb_ld(&bar[XB_TOPGEN]) == tg, bar);
            __builtin_amdgcn_fence(__ATOMIC_ACQUIRE, "agent");
            xb_add(&bar[XB_XGEN(b.x)], 1u);
            asm volatile("s_waitcnt vmcnt(0)" ::: "memory");
        } else {
            XB_SPIN(xb_ld(&bar[XB_XGEN(b.x)]) == gen, bar);
            __builtin_amdgcn_fence(__ATOMIC_ACQUIRE, "agent");
            asm volatile("s_waitcnt vmcnt(0)" ::: "memory");
        }
    }
    __syncthreads();
}

struct Args { const float* in[N_IN]; float* out; unsigned char* ws; int ph_lo, ph_hi; };
typedef LAS unsigned short lbf16;
typedef const __attribute__((address_space(4))) Args* KA;
__device__ __forceinline__ KA ka_get() { KA p = (KA)__builtin_amdgcn_kernarg_segment_ptr(); asm volatile("" : "+s"(p)); return p; }
__device__ __forceinline__ float bf2f(unsigned short v) { return __uint_as_float((unsigned)v << 16); }
__device__ __forceinline__ void unpack8(const v4u v, float (&f)[8]) {
    f[0] = __uint_as_float(v.x << 16); f[1] = __uint_as_float(v.x & 0xffff0000u); f[2] = __uint_as_float(v.y << 16); f[3] = __uint_as_float(v.y & 0xffff0000u);
    f[4] = __uint_as_float(v.z << 16); f[5] = __uint_as_float(v.z & 0xffff0000u); f[6] = __uint_as_float(v.w << 16); f[7] = __uint_as_float(v.w & 0xffff0000u); }
__device__ __forceinline__ v4u pack8(const float (&f)[8]) { v4u o; o.x = pg8::cvt_pk_bf16(f[0], f[1]); o.y = pg8::cvt_pk_bf16(f[2], f[3]); o.z = pg8::cvt_pk_bf16(f[4], f[5]); o.w = pg8::cvt_pk_bf16(f[6], f[7]); return o; }
__device__ __forceinline__ float silu_f(float x) { return x * __builtin_amdgcn_rcpf(1.f + __expf(-x)); }
__device__ __forceinline__ float softplus_f(float x) { return x > 20.f ? x : log1pf(__expf(x)); }
__device__ __forceinline__ float logsig_f(float x) { return fminf(x, 0.f) - __logf(1.f + __expf(-fabsf(x))); }
__device__ __forceinline__ float gelu_tanh(float x) { const float u = 0.7978845608028654f * (x + 0.044715f * x * x * x); const float t = 1.f - 2.f * __builtin_amdgcn_rcpf(1.f + __expf(2.f * u)); return 0.5f * x * (1.f + t); }
template <int CTRL, int ROWMASK> __device__ __forceinline__ float dpp_f(float v) { return __int_as_float(__builtin_amdgcn_update_dpp(0, __float_as_int(v), CTRL, ROWMASK, 0xF, false)); }
__device__ __forceinline__ float row16_sum(float v) { v += dpp_f<0xB1, 0xF>(v); v += dpp_f<0x4E, 0xF>(v); v += dpp_f<0x141, 0xF>(v); v += dpp_f<0x140, 0xF>(v); return v; }
__device__ __forceinline__ float wave_sum(float v) {
    v = row16_sum(v); v += dpp_f<0x142, 0xA>(v); v += dpp_f<0x143, 0xC>(v);
    return __int_as_float(__builtin_amdgcn_readlane(__float_as_int(v), 63));
}
__device__ __forceinline__ float half_sum(float v, int lane) {
    v = row16_sum(v); v += dpp_f<0x142, 0xA>(v);
    const float lo = __int_as_float(__builtin_amdgcn_readlane(__float_as_int(v), 31)), hi = __int_as_float(__builtin_amdgcn_readlane(__float_as_int(v), 63)); return lane < 32 ? lo : hi;
}
struct Acc32 { f32x4 v[2][2]; };
__device__ __forceinline__ void acc_zero(Acc32& a) { a.v[0][0] = a.v[0][1] = a.v[1][0] = a.v[1][1] = (f32x4){0.f, 0.f, 0.f, 0.f}; }
template <int MASK> __device__ __forceinline__ int tswz(int row, int col) { return (((col >> 3) ^ ((row >> 3) & MASK)) << 3) | (col & 7); }
template <int MA = -1, int MB = -1>
__device__ __forceinline__ void wave_mma32(Acc32& acc, const lbf16* A, int lda, const lbf16* Bt, int ldb, int m0, int n0, int K, int lane) {
    const int l16 = lane & 15, q = lane >> 4;
    const lbf16* a0 = A + (m0 + l16) * lda; const lbf16* a1 = a0 + 16 * lda;
    const lbf16* b0 = Bt + (n0 + l16) * ldb; const lbf16* b1 = b0 + 16 * ldb;
    const int fa0 = MA >= 0 ? ((m0 + l16) >> 3) & MA : 0, fa1 = MA >= 0 ? ((m0 + l16 + 16) >> 3) & MA : 0, fb0 = MB >= 0 ? ((n0 + l16) >> 3) & MB : 0, fb1 = MB >= 0 ? ((n0 + l16 + 16) >> 3) & MB : 0;
    for (int k = 0; k < K; k += 32) { const int c = (k >> 3) + q;
        const bf16x8 fa0v = *(const LAS bf16x8*)(a0 + 8 * (c ^ fa0)), fa1v = *(const LAS bf16x8*)(a1 + 8 * (c ^ fa1)), fb0v = *(const LAS bf16x8*)(b0 + 8 * (c ^ fb0)), fb1v = *(const LAS bf16x8*)(b1 + 8 * (c ^ fb1));
        acc.v[0][0] = __builtin_amdgcn_mfma_f32_16x16x32_bf16(fa0v, fb0v, acc.v[0][0], 0, 0, 0);
        acc.v[0][1] = __builtin_amdgcn_mfma_f32_16x16x32_bf16(fa0v, fb1v, acc.v[0][1], 0, 0, 0);
        acc.v[1][0] = __builtin_amdgcn_mfma_f32_16x16x32_bf16(fa1v, fb0v, acc.v[1][0], 0, 0, 0);
        acc.v[1][1] = __builtin_amdgcn_mfma_f32_16x16x32_bf16(fa1v, fb1v, acc.v[1][1], 0, 0, 0);
    }
}

__device__ __forceinline__ unsigned pk4_fp8(float a, float b, float c, float d) {
    a = __builtin_amdgcn_fmed3f(a, -448.f, 448.f); b = __builtin_amdgcn_fmed3f(b, -448.f, 448.f); c = __builtin_amdgcn_fmed3f(c, -448.f, 448.f); d = __builtin_amdgcn_fmed3f(d, -448.f, 448.f);
    int w = 0; w = __builtin_amdgcn_cvt_pk_fp8_f32(a, b, w, false); w = __builtin_amdgcn_cvt_pk_fp8_f32(c, d, w, true); return (unsigned)w; }
constexpr float XN8_SCALE = 16.f, ACT8_SCALE = 4.f, W8_SCALE = 64.f;
constexpr int SC_W8UP = 0x7b7b7b7b  , SC_W8 = 0x79797979  , SC_XN8 = 0x7b7b7b7b  , SC_ACT8 = 0x7d7d7d7d  ;
namespace pg8 {
struct EpiP {
    static constexpr bool PERM = true, AFTER_DRAIN = false; unsigned char* ws;
    __device__ __forceinline__ void operator()(const f32x4 (&acc)[2][2][4][2], const Unit& u, int wr, int wc, int fr, int fq) const {
        bf16_t* O = (bf16_t*)(ws + WS_P); const int row0 = u.pm * BM + wr * 64 + fr, col0 = u.pn * BM + wc * 32 + 8 * fq;
#pragma unroll
        for (int ai = 0; ai < 2; ++ai)
#pragma unroll
            for (int m = 0; m < 4; ++m) { bf16_t* rowp = O + (size_t)(row0 + ai * HALF + m * 16) * NP + col0;
#pragma unroll
                for (int bj = 0; bj < 2; ++bj) { const f32x4 v0 = acc[ai][bj][m][0], v1 = acc[ai][bj][m][1];
                    u32x4 w; w.x = cvt_pk_bf16(v0[0], v0[1]); w.y = cvt_pk_bf16(v0[2], v0[3]); w.z = cvt_pk_bf16(v1[0], v1[1]); w.w = cvt_pk_bf16(v1[2], v1[3]);
                    *(u32x4*)(rowp + bj * HALF) = w; } }
    }
};
struct EpiRes {
    static constexpr bool PERM = false, AFTER_DRAIN = false;
    unsigned char* ws; const float* x; int l; int gate_idx;
    __device__ __forceinline__ void operator()(const f32x4 (&acc)[2][2][4][2], const Unit& u, int wr, int wc, int fr, int fq) const {
        const int b = u.pm / 17, j = u.pm % 17;
        const int col0 = u.pn * BM + wc * 32 + 4 * fq;
        if (j == 0) {
            float* out = (float*)(ws + WS_PART) + ((size_t)(u.k0 >> 9) * 512 + b * 256) * D + col0;
#pragma unroll
            for (int ai = 0; ai < 2; ++ai)
#pragma unroll
                for (int m = 0; m < 4; ++m) { int r = wr * 64 + fr + ai * HALF + m * 16; asm volatile("" : "+v"(r)); float* o = out + (size_t)(unsigned)(r * D);
#pragma unroll
                    for (int bj = 0; bj < 2; ++bj)
#pragma unroll
                        for (int n = 0; n < 2; ++n) *(f32x4*)(o + bj * HALF + n * 16) = acc[ai][bj][m][n];
                    asm volatile("" ::: "memory"); }
            return; }
        const float* base = x ? x + (size_t)(b * SEQ + (j - 1) * 256) * D : nullptr;
        bf16_t* out = (bf16_t*)(ws + WS_H) + (size_t)u.pm * 256 * D;
        const float* gate = (const float*)(ws + WS_MODF) + ((size_t)l * 3 + b) * ADAW + gate_idx * D + col0;
        f32x4 gv[2][2];
#pragma unroll
        for (int bj = 0; bj < 2; ++bj)
#pragma unroll
            for (int n = 0; n < 2; ++n) gv[bj][n] = *(const f32x4*)(gate + bj * HALF + n * 16);
#pragma unroll
        for (int ai = 0; ai < 2; ++ai)
#pragma unroll
            for (int m = 0; m < 4; ++m) { int r = wr * 64 + fr + ai * HALF + m * 16; asm volatile("" : "+v"(r)); const unsigned off = (unsigned)(r * D) + col0;
                f32x4 bs[2][2];
                if (base) {
#pragma unroll
                    for (int bj = 0; bj < 2; ++bj)
#pragma unroll
                        for (int n = 0; n < 2; ++n) bs[bj][n] = *(const f32x4*)(base + off + bj * HALF + n * 16);
                } else {
#pragma unroll
                    for (int bj = 0; bj < 2; ++bj)
#pragma unroll
                        for (int n = 0; n < 2; ++n) { const unsigned long long q = *(const unsigned long long*)(out + off + bj * HALF + n * 16);
                            bs[bj][n] = (f32x4){__uint_as_float((unsigned)q << 16), __uint_as_float((unsigned)q & 0xffff0000u), __uint_as_float((unsigned)(q >> 32) << 16), __uint_as_float((unsigned)(q >> 32) & 0xffff0000u)}; }
                }
#pragma unroll
                for (int bj = 0; bj < 2; ++bj)
#pragma unroll
                    for (int n = 0; n < 2; ++n) { const f32x4 r4 = bs[bj][n] + gv[bj][n] * acc[ai][bj][m][n];
                        *(unsigned long long*)(out + off + bj * HALF + n * 16) = (unsigned long long)cvt_pk_bf16(r4[0], r4[1]) | ((unsigned long long)cvt_pk_bf16(r4[2], r4[3]) << 32); }
                asm volatile("" ::: "memory"); }
    }
};
struct EpiSwiglu {
    static constexpr bool PERM = true, AFTER_DRAIN = false; bf16_t* O; int ldc; int nt;
    __device__ __forceinline__ void operator()(const f32x4 (&acc)[2][2][4][2], const Unit& u, int wr, int wc, int fr, int fq) const {
        const int pl = u.pn % nt; const int row0 = u.pm * BM + wr * 64 + fr, col0 = pl * HALF + wc * 32 + 8 * fq;
#pragma unroll
        for (int ai = 0; ai < 2; ++ai)
#pragma unroll
            for (int m = 0; m < 4; ++m) { bf16_t* rowp = O + (size_t)(row0 + ai * HALF + m * 16) * ldc + col0;
                float a[8];
#pragma unroll
                for (int n = 0; n < 2; ++n)
#pragma unroll
                    for (int e = 0; e < 4; e += 2) { typedef float f32x2 __attribute__((ext_vector_type(2)));
                        const f32x2 g = {acc[ai][0][m][n][e], acc[ai][0][m][n][e + 1]}, up = {acc[ai][1][m][n][e], acc[ai][1][m][n][e + 1]};
                        const f32x2 x = g * (f32x2){-1.44269504f, -1.44269504f};
                        const f32x2 d = (f32x2){__builtin_amdgcn_exp2f(x.x), __builtin_amdgcn_exp2f(x.y)} + (f32x2){1.f, 1.f};
                        const f32x2 o = (g * up) * (f32x2){__builtin_amdgcn_rcpf(d.x), __builtin_amdgcn_rcpf(d.y)};
                        a[4 * n + e] = o.x; a[4 * n + e + 1] = o.y; }
                u32x4 w; w.x = cvt_pk_bf16(a[0], a[1]); w.y = cvt_pk_bf16(a[2], a[3]); w.z = cvt_pk_bf16(a[4], a[5]); w.w = cvt_pk_bf16(a[6], a[7]);
                *(u32x4*)rowp = w; }
    }
};
struct EpiSwiglu8 {
    static constexpr bool PERM = true; unsigned char* O; int ldc; int nt;
    __device__ __forceinline__ void operator()(const f32x16 (&acc)[2][2][2], const Unit& u, int wr, int wc, int c32, int h) const {
        const int pl = u.pn % nt; const int row0 = u.pm * BM + wr * 64 + c32, col0 = pl * HALF + wc * 32 + 16 * h;
#pragma unroll
        for (int ai = 0; ai < 2; ++ai)
#pragma unroll
            for (int mb = 0; mb < 2; ++mb) { unsigned char* rowp = O + (size_t)(row0 + ai * HALF + mb * 32) * ldc + col0;
                float a[16];
#pragma unroll
                for (int r = 0; r < 16; r += 2) {
                    const f32x2 g = {acc[ai][0][mb][r], acc[ai][0][mb][r + 1]}, up = {acc[ai][1][mb][r], acc[ai][1][mb][r + 1]};
                    const f32x2 x = g * (f32x2){-1.44269504f, -1.44269504f};
                    const f32x2 d = (f32x2){__builtin_amdgcn_exp2f(x.x), __builtin_amdgcn_exp2f(x.y)} + (f32x2){1.f, 1.f};
                    const f32x2 o = (g * up) * (f32x2){__builtin_amdgcn_rcpf(d.x), __builtin_amdgcn_rcpf(d.y)};
                    a[r] = o.x; a[r + 1] = o.y; }
                u32x4 w; w.x = pk4_fp8(a[0], a[1], a[2], a[3]); w.y = pk4_fp8(a[4], a[5], a[6], a[7]); w.z = pk4_fp8(a[8], a[9], a[10], a[11]); w.w = pk4_fp8(a[12], a[13], a[14], a[15]);
                *(u32x4*)rowp = w; }
    }
};
struct EpiBf16g8 {
    static constexpr bool PERM = true; bf16_t* C0; bf16_t* C1; bf16_t* XT; int* TT; int ldc; int nt;
    __device__ __forceinline__ void operator()(const f32x16 (&acc)[2][2][2], const Unit& u, int wr, int wc, int c32, int h) const {
        const int pl = u.pn % nt; const bool tail = u.dst >= 2;
        const int row0 = (tail ? 0 : u.pm * BM) + wr * 64 + c32, col0 = (tail ? 0 : pl * BM) + wc * 32 + 16 * h, ld = tail ? 256 : ldc;
        bf16_t* C = tail ? XT + (size_t)(u.dst - 2) * 65536 : (u.dst ? C1 : C0);
        if (u.tt != 0 && (wr | wc | c32 | h) == 0) TT[(u.pm * 8 + pl) * 2 + u.dst] = u.tt;
#pragma unroll
        for (int ai = 0; ai < 2; ++ai)
#pragma unroll
            for (int mb = 0; mb < 2; ++mb) { bf16_t* rowp = C + (size_t)(row0 + ai * HALF + mb * 32) * ld + col0;
#pragma unroll
                for (int bj = 0; bj < 2; ++bj) { const f32x16 w = acc[ai][bj][mb]; u32x4 lo, hi;
                    lo.x = cvt_pk_bf16(w[0], w[1]); lo.y = cvt_pk_bf16(w[2], w[3]); lo.z = cvt_pk_bf16(w[4], w[5]); lo.w = cvt_pk_bf16(w[6], w[7]);
                    hi.x = cvt_pk_bf16(w[8], w[9]); hi.y = cvt_pk_bf16(w[10], w[11]); hi.z = cvt_pk_bf16(w[12], w[13]); hi.w = cvt_pk_bf16(w[14], w[15]);
                    *(u32x4*)(rowp + bj * HALF) = lo; *(u32x4*)(rowp + bj * HALF + 8) = hi; } }
    }
};
struct EpiF32g8 {
    static constexpr bool PERM = false; float* C0; float* C1; int ldc; int nt;
    __device__ __forceinline__ void operator()(const f32x16 (&acc)[2][2][2], const Unit& u, int wr, int wc, int c32, int h) const {
        const int pl = u.pn % nt; const int row0 = u.pm * BM + wr * 64 + c32, col0 = pl * BM + wc * 32 + 4 * h; float* C = u.k0 ? C1 : C0;
#pragma unroll
        for (int ai = 0; ai < 2; ++ai)
#pragma unroll
            for (int mb = 0; mb < 2; ++mb) { float* rowp = C + (size_t)(row0 + ai * HALF + mb * 32) * ldc + col0;
#pragma unroll
                for (int bj = 0; bj < 2; ++bj)
#pragma unroll
                    for (int gq = 0; gq < 4; ++gq) { const f32x16 w = acc[ai][bj][mb]; *(f32x4*)(rowp + bj * HALF + 8 * gq) = (f32x4){w[4 * gq], w[4 * gq + 1], w[4 * gq + 2], w[4 * gq + 3]}; } }
    }
};
struct EpiF32g {
    static constexpr bool PERM = false, AFTER_DRAIN = false; float* C0; float* C1; int ldc; int nt;
    __device__ __forceinline__ void operator()(const f32x4 (&acc)[2][2][4][2], const Unit& u, int wr, int wc, int fr, int fq) const {
        const int pl = u.pn % nt; const int row0 = u.pm * BM + wr * 64 + fr, col0 = pl * BM + wc * 32 + 4 * fq; float* C = u.k0 ? C1 : C0;
#pragma unroll
        for (int ai = 0; ai < 2; ++ai)
#pragma unroll
            for (int m = 0; m < 4; ++m) { float* rowp = C + (size_t)(row0 + ai * HALF + m * 16) * ldc + col0;
#pragma unroll
                for (int bj = 0; bj < 2; ++bj)
#pragma unroll
                    for (int n = 0; n < 2; ++n) *(f32x4*)(rowp + bj * HALF + n * 16) = acc[ai][bj][m][n]; }
    }
};
}

constexpr int CT_P0A_HI = 4096;
struct RmOff { int off; __device__ __forceinline__ int operator()(int n) const { return off + n; } };
struct RmWin { __device__ __forceinline__ int operator()(int c) const { return c < 4096 ? c : (c < 4112 ? -1 : (c < 5648 ? c - 16 : -1)); } };
struct RmGU { int half; __device__ __forceinline__ int operator()(int n) const { return 256 * (n >> 7) + 128 * half + (n & 127); } };
#define SCHED_FENCE() __builtin_amdgcn_sched_barrier(0)
#define LDS_BARRIER() do { asm volatile("s_waitcnt lgkmcnt(0)" ::: "memory"); __builtin_amdgcn_s_barrier(); asm volatile("" ::: "memory"); } while (0)
__device__ __forceinline__ void conv_load(const float* W, int N, int k0, int n0, int wave, int lane, f32x4 (&r)[8]) {
    const int n = n0 + 4 * lane; const bool ok = n < N;
    const float* p = W + (size_t)(k0 + 8 * wave) * N + n;
#pragma unroll
    for (int i = 0; i < 8; ++i) r[i] = ok ? __builtin_nontemporal_load((const GAS f32x4*)(p + (size_t)i * N)) : (f32x4){0.f, 0.f, 0.f, 0.f};
}
template <class RowMap>
__device__ __forceinline__ void conv_store_bf16(const f32x4 (&r)[8], unsigned char* WT, int Kbytes, int k0bytes, int n0, const RowMap rm, LAS unsigned char* T, int tid, int wave, int lane) {
    const int c = tid & 7, rr = tid >> 3;
#pragma unroll
    for (int p = 0; p < 2; ++p) {
        if ((lane >> 5) == p) {
#pragma unroll
            for (int j = 0; j < 4; ++j) { v4u o; o.x = pg8::cvt_pk_bf16(r[0][j], r[1][j]); o.y = pg8::cvt_pk_bf16(r[2][j], r[3][j]); o.z = pg8::cvt_pk_bf16(r[4][j], r[5][j]); o.w = pg8::cvt_pk_bf16(r[6][j], r[7][j]);
                *(LAS v4u*)(T + (4 * (lane & 31) + j) * 128 + 16 * (wave ^ (lane & 7))) = o; } }
        LDS_BARRIER();
#pragma unroll
        for (int q = 0; q < 2; ++q) { const int row = rr + 64 * q; const v4u v = *(const LAS v4u*)(T + row * 128 + 16 * (c ^ ((row >> 2) & 7)));
            const int dr = rm(n0 + 128 * p + row); if (dr >= 0) *(GAS v4u*)(WT + (size_t)dr * Kbytes + k0bytes + 16 * c) = v; }
        LDS_BARRIER();
    }
}
template <class RowMap>
__device__ __forceinline__ void conv_store_fp8(const f32x4 (&r)[8], unsigned char* WT, int Kbytes, int k0bytes, int n0, const RowMap rm, LAS unsigned char* T, int tid, int wave, int lane) {
    const int s = 2 * (lane & 3);
#pragma unroll
    for (int j = 0; j < 4; ++j) { const unsigned lo = pk4_fp8(r[0][j] * W8_SCALE, r[1][j] * W8_SCALE, r[2][j] * W8_SCALE, r[3][j] * W8_SCALE), hi = pk4_fp8(r[4][j] * W8_SCALE, r[5][j] * W8_SCALE, r[6][j] * W8_SCALE, r[7][j] * W8_SCALE);
        *(LAS unsigned long long*)(T + (4 * lane + j) * 64 + 8 * (wave ^ s)) = (unsigned long long)lo | ((unsigned long long)hi << 32); }
    LDS_BARRIER();
    const int c16 = tid & 3, rr = tid >> 2;
#pragma unroll
    for (int q = 0; q < 2; ++q) { const int row = rr + 128 * q; const v4u v = *(const LAS v4u*)(T + row * 64 + 16 * (c16 ^ ((row >> 2) & 3)));
        const int dr = rm(n0 + row); if (dr >= 0) *(GAS v4u*)(WT + (unsigned)((((dr >> 8) * (Kbytes >> 7) + (k0bytes >> 7)) << 15) + ((dr & 255) << 7) + (k0bytes & 127) + 16 * c16)) = v; }
    LDS_BARRIER();
}
struct ConvTile { const float* W; unsigned char* WT; int K, N, k0, n0, kind, f8; };
__device__ __forceinline__ bool conv_decode(KA A, int t, ConvTile& c) {
    unsigned char* ws = A->ws; c.f8 = 0;
    if (t >= 25600) return false;
    if (t < 1472) { const int l = t / 736, r = t % 736; c.W = A->in[I_WIN] + (size_t)l * D * PSRC; c.WT = ws + WS_WIN + (size_t)l * NP * D * 2; c.K = D; c.N = PSRC; c.k0 = 64 * (r / 23); c.n0 = 256 * (r % 23); c.kind = 1; return true; } t -= 1472;
    if (t < 512) { const int l = t >> 8, r = t & 255; c.W = A->in[I_WOUT] + (size_t)l * D * D; c.WT = ws + WS_WOUT + (size_t)l * D * D * 2; c.K = D; c.N = D; c.k0 = 64 * (r >> 3); c.n0 = 256 * (r & 7); c.kind = 0; return true; } t -= 512;
    if (t < 1408) { const int hf = t / 704, r = t % 704; c.W = hf ? A->in[I_FWU] : A->in[I_FWG]; c.WT = ws + WS_FUP; c.K = D; c.N = FF; c.k0 = 64 * (r / 22); c.n0 = 256 * (r % 22); c.kind = 2 + hf; return true; } t -= 1408;
    if (t < 704) { c.W = A->in[I_FWD]; c.WT = ws + WS_FDN; c.K = FF; c.N = D; c.k0 = 64 * (t >> 3); c.n0 = 256 * (t & 7); c.kind = 0; return true; } t -= 704;
    c.f8 = 1;
    if (t < 14336) { const int hf = t / 7168, r2 = t % 7168, e = r2 / 896, r = r2 % 896, hk = r & 1, q = r >> 1; c.W = (hf ? A->in[I_MWU] : A->in[I_MWG]) + (size_t)e * D * FFE; c.WT = ws + WS_MUP + (size_t)e * 2 * FFE * D; c.K = D; c.N = FFE; c.k0 = 128 * (q / 28) + 64 * hk; c.n0 = 256 * (q % 28); c.kind = 2 + hf; return true; } t -= 14336;
    { const int e = t / 896, r = t % 896, hk = r & 1, q = r >> 1; c.W = A->in[I_MWD] + (size_t)e * FFE * D; c.WT = ws + WS_MDN + (size_t)e * D * FFE; c.K = FFE; c.N = D; c.k0 = 128 * (q >> 3) + 64 * hk; c.n0 = 256 * (q & 7); c.kind = 0; return true; }
}
__device__ __forceinline__ bool conv_decode_moe(KA A, int t, ConvTile& c) {
    unsigned char* ws = A->ws; c.f8 = 1; c.K = D; c.N = FFE; t -= 4096;
    if (t < 14336) { const int hf = t / 7168, r2 = t % 7168, e = r2 / 896, r = r2 % 896, hk = r & 1, q = r >> 1; c.W = (hf ? A->in[I_MWU] : A->in[I_MWG]) + (size_t)e * D * FFE; c.WT = ws + WS_MUP + (size_t)e * 2 * FFE * D; c.k0 = 128 * (q / 28) + 64 * hk; c.n0 = 256 * (q % 28); c.kind = 2 + hf; return true; } t -= 14336;
    if (t >= 7168) return false;
    { const int e = t / 896, r = t % 896, hk = r & 1, q = r >> 1; c.W = A->in[I_MWD] + (size_t)e * FFE * D; c.WT = ws + WS_MDN + (size_t)e * D * FFE; c.K = FFE; c.N = D; c.k0 = 128 * (q >> 3) + 64 * hk; c.n0 = 256 * (q & 7); c.kind = 0; return true; }
}
__device__ __forceinline__ void conv_emit_moe(const ConvTile& c, const f32x4 (&r)[8], LAS unsigned char* T, int tid, int wave, int lane) {
    if (c.kind == 0) conv_store_fp8(r, c.WT, c.K, c.k0, c.n0, RmOff{0}, T, tid, wave, lane); else conv_store_fp8(r, c.WT, c.K, c.k0, c.n0, RmGU{c.kind - 2}, T, tid, wave, lane);
}
__device__ __forceinline__ void conv_emit(const ConvTile& c, const f32x4 (&r)[8], LAS unsigned char* T, int tid, int wave, int lane) {
    if (c.f8) { if (c.kind == 0) conv_store_fp8(r, c.WT, c.K, c.k0, c.n0, RmOff{0}, T, tid, wave, lane); else conv_store_fp8(r, c.WT, c.K, c.k0, c.n0, RmGU{c.kind - 2}, T, tid, wave, lane); }
    else if (c.kind == 0) conv_store_bf16(r, c.WT, c.K * 2, c.k0 * 2, c.n0, RmOff{0}, T, tid, wave, lane);
    else if (c.kind == 1) conv_store_bf16(r, c.WT, c.K * 2, c.k0 * 2, c.n0, RmWin{}, T, tid, wave, lane);
    else conv_store_bf16(r, c.WT, c.K * 2, c.k0 * 2, c.n0, RmGU{c.kind - 2}, T, tid, wave, lane);
}
namespace pg8 {
template <int NSLOT, bool MOE> __device__ __forceinline__ void conv_burst(const ConvHook& h, int bid, PG8_LAS unsigned char* T_, int tid) {
    KA A = ka_get(); const int lane = tid & 63, wave = __builtin_amdgcn_readfirstlane(tid >> 6); LAS unsigned char* T = (LAS unsigned char*)T_;
    const int p0 = (h.t0 >> 1) + bid, p1 = h.t1 >> 1;
#define CV_TILE(j) (2 * (p0 + 256 * ((j) >> 1)) + ((j) & 1))
#define CV_VALID(j) ((p0 + 256 * ((j) >> 1)) < p1)
#define CV_DEC(t, c) (MOE ? conv_decode_moe(A, (t), (c)) : conv_decode(A, (t), (c)))
#define CV_LOAD(j, R) do { ConvTile c_; if (CV_VALID(j) && CV_DEC(CV_TILE(j), c_)) conv_load(c_.W, c_.N, c_.k0, c_.n0, wave, lane, R); } while (0)
#define CV_PROC(j, R) { ConvTile c_; if (!CV_VALID(j) || !CV_DEC(CV_TILE(j), c_)) break; if constexpr (MOE) conv_emit_moe(c_, R, T, tid, wave, lane); else conv_emit(c_, R, T, tid, wave, lane); }
    if constexpr (NSLOT == 4) {
        f32x4 R0[8], R1[8], R2[8], R3[8];
        CV_LOAD(0, R0); CV_LOAD(1, R1); CV_LOAD(2, R2);
        for (int j = 0;; j += 4) {
            CV_LOAD(j + 3, R3); CV_PROC(j, R0)
            CV_LOAD(j + 4, R0); CV_PROC(j + 1, R1)
            CV_LOAD(j + 5, R1); CV_PROC(j + 2, R2)
            CV_LOAD(j + 6, R2); CV_PROC(j + 3, R3)
        }
    } else {
        f32x4 R0[8], R1[8], R2[8];
        CV_LOAD(0, R0); CV_LOAD(1, R1);
        for (int j = 0;; j += 3) {
            CV_LOAD(j + 2, R2); CV_PROC(j, R0)
            CV_LOAD(j + 3, R0); CV_PROC(j + 1, R1)
            CV_LOAD(j + 4, R1); CV_PROC(j + 2, R2)
        }
    }
#undef CV_TILE
#undef CV_VALID
#undef CV_LOAD
#undef CV_PROC
#undef CV_DEC
}
}
__device__ __forceinline__ void ada_item(const float* wada, float* adap, const LAS float* S, int it, int lane) {
    const int l = it / 1536, rem = it - l * 1536, cg = rem >> 5, ks = rem & 31; const int k0 = ks * 64, col = cg * 256 + 4 * lane;
    const float* w = wada + ((size_t)l * D + k0) * ADAW + col;
    f32x4 a0 = {0.f, 0.f, 0.f, 0.f}, a1 = a0, a2 = a0;
#pragma unroll 8
    for (int kk = 0; kk < 64; ++kk) { const f32x4 v = *(const GAS f32x4*)(w + (size_t)kk * ADAW); const float s0 = S[k0 + kk], s1 = S[2048 + k0 + kk], s2 = S[4096 + k0 + kk];
        a0 += v * s0; a1 += v * s1; a2 += v * s2; }
    float* o = adap + (((size_t)l * 32 + ks) * 3) * ADAW + col;
    *(GAS f32x4*)o = a0; *(GAS f32x4*)(o + ADAW) = a1; *(GAS f32x4*)(o + 2 * ADAW) = a2;
}
__device__ __forceinline__ void p0a_phase(KA A, LAS unsigned char* lds, int tid, int wave, int lane, int bid, int G) {
    unsigned char* ws = A->ws;
    LAS float* S = (LAS float*)(lds + 73728);
    { float cv[12];
#pragma unroll
      for (int it = 0; it < 12; ++it) { const int i = tid + it * NTHR; cv[it] = i < 2 * D ? A->in[I_C][i] : A->in[I_CCTX][i - 2 * D]; }
      SCHED_FENCE();
#pragma unroll
      for (int it = 0; it < 12; ++it) S[tid + it * NTHR] = silu_f(cv[it]); }
    __syncthreads();
    const int gw = bid * NWAVES + wave, NGW = G * NWAVES;
    for (int it = gw; it < 3072; it += NGW) ada_item(A->in[I_WADA], (float*)(ws + WS_ADAP), S, it, lane);
    { bf16* wsm = (bf16*)(ws + WS_WSM); const float* win = A->in[I_WIN];
      for (int idx = bid * NTHR + tid; idx < 2 * NSM * D; idx += G * NTHR) { const int l = idx / (NSM * D), j = (idx / D) % NSM, k = idx % D; const int col = j < 16 ? 4096 + j : 5648 + (j - 16);
          wsm[idx] = (unsigned short)f2bf(win[((size_t)l * D + k) * PSRC + col]); } }
    __syncthreads();
    pg8::conv_burst<4, false>(pg8::ConvHook{0, CT_P0A_HI, -1}, bid, lds + CONV_OFF, tid);
    __syncthreads();
}
__device__ __forceinline__ void p0b_phase(KA A, int tid, int bid, int G) {
    const float* adap = (const float*)(A->ws + WS_ADAP); float* modf = (float*)(A->ws + WS_MODF);
    constexpr int NV = 2 * 3 * ADAW / 4;
    for (int v = bid * NTHR + tid; v < NV; v += G * NTHR) {
        const int l = v / (3 * ADAW / 4), rem = v % (3 * ADAW / 4), r = rem / (ADAW / 4), c4 = rem % (ADAW / 4);
        f32x4 s = *(const GAS f32x4*)(A->in[I_BADA] + (size_t)l * ADAW + 4 * c4);
        for (int ks = 0; ks < 32; ++ks) s += *(const GAS f32x4*)(adap + (((size_t)l * 32 + ks) * 3 + r) * ADAW + 4 * c4);
        *(GAS f32x4*)(modf + ((size_t)l * 3 + r) * ADAW + 4 * c4) = s;
    }
}

__device__ __forceinline__ int wg_row(int bid, int rl) { if (rl < 32) return (bid >> 7) * TB + CTXL + 32 * (bid & 127) + rl; const int q = 2 * bid + (rl - 32); return (q >> 8) * TB + (q & 255); }
#define VIDX(j) (128 * ((j) >> 1) + ((j) & 1))
template <bool ROUTER, bool SMALLP>
__device__ __forceinline__ void norm_phase(KA A, LAS unsigned char* lds, int l, int which, int npart, const float* pgate, int tid, int wave, int lane, int bid) {
    unsigned char* ws = A->ws;
    const float* modl = (const float*)(ws + WS_MODF) + (size_t)l * 3 * ADAW;
    const float* gvec = (which ? A->in[I_GFFN] : A->in[I_GMIX]) + (size_t)l * D;
    const int bw = bid >> 7;
    LAS float* cA = (LAS float*)lds;
    LAS float* cB = cA + 2 * D;
    LAS float* wrT = (LAS float*)(lds + 32768);
    LAS int* rt = (LAS int*)(lds + 98304);
    {   float gv[8], m1[8], m0[8];
#pragma unroll
        for (int it = 0; it < 8; ++it) { const int i = tid + it * NTHR; const int t = i >> 11, col = i & (D - 1); const float* m = modl + (size_t)(t ? 2 : bw) * ADAW;
            gv[it] = gvec[col]; m1[it] = m[(which ? 4 : 1) * D + col]; m0[it] = m[(which ? 3 : 0) * D + col]; }
        SCHED_FENCE();
#pragma unroll
        for (int it = 0; it < 8; ++it) { const int i = tid + it * NTHR; cA[i] = gv[it] * (1.f + m1[it]); cB[i] = m0[it]; }
    }
    if (ROUTER) { const float* wr = A->in[I_MROUTER]; float w32[32];
#pragma unroll
        for (int it = 0; it < 32; ++it) w32[it] = wr[tid + it * NTHR];
        SCHED_FENCE();
#pragma unroll
        for (int it = 0; it < 32; ++it) { const int i = tid + it * NTHR; wrT[(i & 7) * D + (i >> 3)] = w32[it]; } }
    __syncthreads();
    bf16* XN = (bf16*)(ws + WS_XN); bf16* H = (bf16*)(ws + WS_H); const float* PART = (const float*)(ws + WS_PART);
#define NORM_LOAD(rl_) do { const int row_ = wg_row(bid, (rl_)), s_ = row_ % TB, b_ = row_ / TB; const bool isctx_ = s_ < CTXL; const bool from_in_ = (l == 0) && (which == 0 || (isctx_ && npart > 0)); nb = !from_in_; \
        if (from_in_) { const GAS f32x4* xr_ = (const GAS f32x4*)(isctx_ ? A->in[I_CTX] + (size_t)(b_ * CTXL + s_) * D : A->in[I_X] + (size_t)(b_ * SEQ + s_ - CTXL) * D) + 2 * lane; \
            _Pragma("unroll") for (int j = 0; j < 8; ++j) vnx[j] = xr_[VIDX(j)]; } \
        else { const GAS v4u* hr_ = (const GAS v4u*)(H + (size_t)row_ * D) + lane; _Pragma("unroll") for (int jj = 0; jj < 4; ++jj) vnb[jj] = hr_[64 * jj]; } } while (0)
    f32x4 vnx[8]; v4u vnb[4]; bool nb;
    NORM_LOAD(wave);
    for (int rl = wave; rl < 34; rl += NWAVES) {
        const int row = wg_row(bid, rl), s = row % TB; const bool isctx = s < CTXL; const int b = row / TB;
        f32x4 v[8]; float ss = 0.f;
        if (nb) {
#pragma unroll
            for (int jj = 0; jj < 4; ++jj) { float f[8]; unpack8(vnb[jj], f); v[2 * jj] = (f32x4){f[0], f[1], f[2], f[3]}; v[2 * jj + 1] = (f32x4){f[4], f[5], f[6], f[7]}; }
        } else {
#pragma unroll
            for (int j = 0; j < 8; ++j) v[j] = vnx[j];
        }
        if (rl + NWAVES < 34) NORM_LOAD(rl + NWAVES);
        if (isctx && npart > 0) {
            f32x4 acc[8];
#pragma unroll
            for (int j = 0; j < 8; ++j) acc[j] = (f32x4){0.f, 0.f, 0.f, 0.f};
            for (int p = 0; p < npart; ++p) { const GAS f32x4* pr = (const GAS f32x4*)(PART + ((size_t)p * 512 + b * CTXL + s) * D) + 2 * lane;
#pragma unroll
                for (int j = 0; j < 8; ++j) acc[j] += pr[VIDX(j)]; }
            const GAS f32x4* gp = (const GAS f32x4*)pgate + 2 * lane; GAS v4u* hw = (GAS v4u*)(H + (size_t)row * D) + lane;
#pragma unroll
            for (int j = 0; j < 8; ++j) v[j] += gp[VIDX(j)] * acc[j];
#pragma unroll
            for (int jj = 0; jj < 4; ++jj) { const float f[8] = {v[2 * jj].x, v[2 * jj].y, v[2 * jj].z, v[2 * jj].w, v[2 * jj + 1].x, v[2 * jj + 1].y, v[2 * jj + 1].z, v[2 * jj + 1].w}; hw[64 * jj] = pack8(f); }
        }
#pragma unroll
        for (int j = 0; j < 8; ++j) ss += (v[j].x * v[j].x + v[j].y * v[j].y) + (v[j].z * v[j].z + v[j].w * v[j].w);
        const float rstd = __builtin_amdgcn_rsqf(wave_sum(ss) * (1.f / D) + EPS);
        const LAS f32x4* ca = (const LAS f32x4*)(cA + (isctx ? D : 0)) + 2 * lane; const LAS f32x4* cb = (const LAS f32x4*)(cB + (isctx ? D : 0)) + 2 * lane;
        GAS v4u* o16 = (GAS v4u*)(XN + (size_t)row * D) + lane; GAS unsigned long long* o8 = (GAS unsigned long long*)((unsigned char*)XN + (size_t)row * D) + lane;
#pragma unroll
        for (int j = 0; j < 8; ++j) v[j] = v[j] * rstd * ca[VIDX(j)] + cb[VIDX(j)];
#pragma unroll
        for (int jj = 0; jj < 4; ++jj) { const f32x4 x0 = v[2 * jj], x1 = v[2 * jj + 1];
            if (ROUTER) o8[64 * jj] = (unsigned long long)pk4_fp8(x0.x * XN8_SCALE, x0.y * XN8_SCALE, x0.z * XN8_SCALE, x0.w * XN8_SCALE) | ((unsigned long long)pk4_fp8(x1.x * XN8_SCALE, x1.y * XN8_SCALE, x1.z * XN8_SCALE, x1.w * XN8_SCALE) << 32);
            else { v4u o; o.x = pg8::cvt_pk_bf16(x0.x, x0.y); o.y = pg8::cvt_pk_bf16(x0.z, x0.w); o.z = pg8::cvt_pk_bf16(x1.x, x1.y); o.w = pg8::cvt_pk_bf16(x1.z, x1.w); o16[64 * jj] = o; } }
        if (ROUTER) {
            float lg[8];
#pragma unroll
            for (int e = 0; e < 8; ++e) { const LAS f32x4* wv = (const LAS f32x4*)(wrT + e * D) + 2 * lane; float a = 0.f;
#pragma unroll
                for (int j = 0; j < 8; ++j) { const f32x4 w = wv[VIDX(j)]; a += (v[j].x * w.x + v[j].y * w.y) + (v[j].z * w.z + v[j].w * w.w); }
                lg[e] = wave_sum(a); }
            int e1 = 0; float v1 = lg[0];
#pragma unroll
            for (int e = 1; e < 8; ++e) if (lg[e] > v1) { v1 = lg[e]; e1 = e; }
            int e2 = -1; float v2 = -3.0e38f;
#pragma unroll
            for (int e = 0; e < 8; ++e) if (e != e1 && lg[e] > v2) { v2 = lg[e]; e2 = e; }
            const float ex = __expf(v2 - v1), w1 = 1.f / (1.f + ex), w2 = ex * w1;
            if (lane == 0) { rt[rl * 4 + 0] = isctx ? -1 : e1; rt[rl * 4 + 1] = e2; rt[rl * 4 + 2] = __float_as_int(w1); rt[rl * 4 + 3] = __float_as_int(w2); }
        }
    }
    if (ROUTER) {
        __syncthreads();
        LAS int* cnt = rt + 34 * 4;
        if (tid < 8) cnt[tid] = 0;
        __syncthreads();
        if (tid == 0) {
            int4* route = (int4*)(ws + WS_ROUTE);
            for (int rl = 0; rl < 34; ++rl) { const int e1 = rt[rl * 4]; if (e1 < 0) continue; const int e2 = rt[rl * 4 + 1];
                const int r1 = cnt[e1]; cnt[e1] = r1 + 1; const int r2 = cnt[e2]; cnt[e2] = r2 + 1;
                route[wg_row(bid, rl)] = make_int4(e1 | (e2 << 4) | (r1 << 8) | (r2 << 16), rt[rl * 4 + 2], rt[rl * 4 + 3], 0); }
            int* gc = (int*)(ws + WS_CNT) + bid * 8;
            for (int e = 0; e < 8; ++e) gc[e] = cnt[e];
        }
    }
    if (SMALLP) {
        asm volatile("s_waitcnt vmcnt(0)" ::: "memory"); __syncthreads();
        const bf16* wsm = (const bf16*)(ws + WS_WSM) + (size_t)l * NSM * D;
        const int l16 = lane & 15, q = lane >> 4;
        f32x4 acc[3][3];
#pragma unroll
        for (int a = 0; a < 3; ++a)
#pragma unroll
            for (int c = 0; c < 3; ++c) acc[a][c] = (f32x4){0.f, 0.f, 0.f, 0.f};
        const bf16* ap[3]; const bf16* bp[3];
#pragma unroll
        for (int a = 0; a < 3; ++a) { int r = 16 * a + l16; r = r < 34 ? r : 33; ap[a] = XN + (size_t)wg_row(bid, r) * D + 256 * wave + 8 * q; bp[a] = wsm + (size_t)(16 * a + l16) * D + 256 * wave + 8 * q; }
#pragma unroll
        for (int ks = 0; ks < 8; ++ks) { bf16x8 fa[3], fb[3];
#pragma unroll
            for (int a = 0; a < 3; ++a) { fa[a] = *(const GAS bf16x8*)(ap[a] + 32 * ks); fb[a] = *(const GAS bf16x8*)(bp[a] + 32 * ks); }
#pragma unroll
            for (int a = 0; a < 3; ++a)
#pragma unroll
                for (int c = 0; c < 3; ++c) acc[a][c] = __builtin_amdgcn_mfma_f32_16x16x32_bf16(fa[a], fb[c], acc[a][c], 0, 0, 0); }
        LAS float* red = (LAS float*)(lds + 32768);
#pragma unroll
        for (int a = 0; a < 3; ++a)
#pragma unroll
            for (int c = 0; c < 3; ++c)
#pragma unroll
                for (int j = 0; j < 4; ++j) red[(wave * 48 + 16 * a + 4 * q + j) * 48 + 16 * c + l16] = acc[a][c][j];
        __syncthreads();
        float* PS = (float*)(ws + WS_PS);
        for (int i = tid; i < 34 * 48; i += NTHR) { float s = 0.f;
#pragma unroll
            for (int w = 0; w < 8; ++w) s += red[w * 2304 + i];
            PS[(size_t)wg_row(bid, i / 48) * NSM + (i % 48)] = s; }
    }
    __syncthreads();
}

__device__ __forceinline__ void seg_flags(int row, bool& hl, bool& hr) { const int s = row % TB; if (s < CTXL) { hl = s != 0; hr = s != CTXL - 1; } else { const int t = (s - CTXL) & 63; hl = t != 0; hr = t != 63; } }
__device__ __forceinline__ void conv8(const bf16* P, const float* cw, const float* cb, int row, int pcol, int xc, float (&o)[8]) {
    bool hl, hr; seg_flags(row, hl, hr);
    const bf16* p = P + (size_t)row * NP + pcol; const v4u z = {0u, 0u, 0u, 0u};
    const v4u vc = *(const GAS v4u*)p, vl = hl ? *(const GAS v4u*)(p - NP) : z, vr = hr ? *(const GAS v4u*)(p + NP) : z;
    float c[8], lf[8], rg[8]; unpack8(vc, c); unpack8(vl, lf); unpack8(vr, rg);
    const f32x4 w0a = *(const GAS f32x4*)(cw + xc), w0b = *(const GAS f32x4*)(cw + xc + 4), w1a = *(const GAS f32x4*)(cw + 1024 + xc), w1b = *(const GAS f32x4*)(cw + 1024 + xc + 4),
                w2a = *(const GAS f32x4*)(cw + 2048 + xc), w2b = *(const GAS f32x4*)(cw + 2048 + xc + 4), ba = *(const GAS f32x4*)(cb + xc), bb = *(const GAS f32x4*)(cb + xc + 4);
#pragma unroll
    for (int e = 0; e < 4; ++e) { o[e] = silu_f(w0a[e] * lf[e] + w1a[e] * c[e] + w2a[e] * rg[e] + ba[e]); o[4 + e] = silu_f(w0b[e] * lf[4 + e] + w1b[e] * c[4 + e] + w2b[e] * rg[4 + e] + bb[e]); }
}

struct ConvW { f32x4 w0a, w0b, w1a, w1b, w2a, w2b, ba, bb; };
__device__ __forceinline__ void convw_load(ConvW& w, const float* cw, const float* cb, int xc) {
    w.w0a = *(const GAS f32x4*)(cw + xc); w.w0b = *(const GAS f32x4*)(cw + xc + 4); w.w1a = *(const GAS f32x4*)(cw + 1024 + xc); w.w1b = *(const GAS f32x4*)(cw + 1024 + xc + 4);
    w.w2a = *(const GAS f32x4*)(cw + 2048 + xc); w.w2b = *(const GAS f32x4*)(cw + 2048 + xc + 4); w.ba = *(const GAS f32x4*)(cb + xc); w.bb = *(const GAS f32x4*)(cb + xc + 4); }
struct ConvIn { v4u vc, vl, vr; };
__device__ __forceinline__ void convin_load(ConvIn& x, const bf16* P, int row, int pcol) {
    bool hl, hr; seg_flags(row, hl, hr); const bf16* p = P + (size_t)row * NP + pcol; const v4u z = {0u, 0u, 0u, 0u};
    x.vc = *(const GAS v4u*)p; x.vl = hl ? *(const GAS v4u*)(p - NP) : z; x.vr = hr ? *(const GAS v4u*)(p + NP) : z; }
__device__ __forceinline__ void conv8w(const ConvIn& x, const ConvW& w, float (&o)[8]) {
    float c[8], lf[8], rg[8]; unpack8(x.vc, c); unpack8(x.vl, lf); unpack8(x.vr, rg);
#pragma unroll
    for (int e = 0; e < 4; ++e) { o[e] = silu_f(w.w0a[e] * lf[e] + w.w1a[e] * c[e] + w.w2a[e] * rg[e] + w.ba[e]); o[4 + e] = silu_f(w.w0b[e] * lf[4 + e] + w.w1b[e] * c[4 + e] + w.w2b[e] * rg[4 + e] + w.bb[e]); }
}
__device__ __forceinline__ void m1_sccm_item(KA A, LAS unsigned char* lds, int l, int item, int tid, int wave, int lane) {
    unsigned char* ws = A->ws; const bf16* P = (const bf16*)(ws + WS_P); bf16* YM = (bf16*)(ws + WS_YMIX);
    const int cc = item >> 2, g = item & 3; const int b = cc / NCH_M, c = cc % NCH_M, row0 = b * TB + c * 128;
    const float* scw = A->in[I_SCW] + (size_t)l * 3 * 512;
    {   const int v = tid & 15, ch = 128 * g + 8 * v; const v4u z = {0u, 0u, 0u, 0u}; v4u in[4][7]; f32x4 sw[6];
#pragma unroll
        for (int it = 0; it < 4; ++it) { const int row = row0 + (tid >> 4) + 32 * it; bool hl, hr; seg_flags(row, hl, hr); const bf16* p = P + (size_t)row * NP;
            in[it][0] = *(const GAS v4u*)(p + C_BG + ch); in[it][1] = *(const GAS v4u*)(p + C_CG + ch); in[it][2] = *(const GAS v4u*)(p + C_XA + ch);
            in[it][3] = hl ? *(const GAS v4u*)(p - NP + C_CG + ch) : z; in[it][4] = hl ? *(const GAS v4u*)(p - NP + C_XA + ch) : z;
            in[it][5] = hr ? *(const GAS v4u*)(p + NP + C_CG + ch) : z; in[it][6] = hr ? *(const GAS v4u*)(p + NP + C_XA + ch) : z; }
#pragma unroll
        for (int k = 0; k < 3; ++k) { sw[2 * k] = *(const GAS f32x4*)(scw + 512 * k + ch); sw[2 * k + 1] = *(const GAS f32x4*)(scw + 512 * k + ch + 4); }
        SCHED_FENCE();
#pragma unroll
        for (int it = 0; it < 4; ++it) { const int row = row0 + (tid >> 4) + 32 * it; float bg[8], u0[8], u1[8], u2[8], t0[8], t1[8];
            unpack8(in[it][0], bg); unpack8(in[it][1], t0); unpack8(in[it][2], t1);
#pragma unroll
            for (int e = 0; e < 8; ++e) u1[e] = t0[e] * t1[e];
            unpack8(in[it][3], t0); unpack8(in[it][4], t1);
#pragma unroll
            for (int e = 0; e < 8; ++e) u0[e] = t0[e] * t1[e];
            unpack8(in[it][5], t0); unpack8(in[it][6], t1);
#pragma unroll
            for (int e = 0; e < 8; ++e) u2[e] = t0[e] * t1[e];
            float o[8];
#pragma unroll
            for (int e = 0; e < 8; ++e) o[e] = bg[e] * (sw[e >> 2][e & 3] * u0[e] + sw[2 + (e >> 2)][e & 3] * u1[e] + sw[4 + (e >> 2)][e & 3] * u2[e]);
            *(GAS v4u*)(YM + (size_t)row * D + ch) = pack8(o); }
    }
    lbf16* Ws = (lbf16*)lds; lbf16* Vt = (lbf16*)(lds + 34816);
    const float* wsrc = A->in[I_CMW] + ((size_t)l * 4 + g) * 128 * 128; const float* bsrc = A->in[I_CMB] + ((size_t)l * 4 + g) * 128;
    f32x4 wv[8]; v4u vin[4]; unsigned long long uu[2][2][2]; float bias[2][2];
#pragma unroll
    for (int it = 0; it < 8; ++it) { const int task = tid + it * NTHR; const int i = task >> 5, j4 = task & 31; wv[it] = *(const GAS f32x4*)(wsrc + i * 128 + 4 * j4); }
#pragma unroll
    for (int it = 0; it < 4; ++it) { const int task = tid + it * NTHR; const int j = task >> 4, v = task & 15; vin[it] = *(const GAS v4u*)(P + (size_t)(row0 + j) * NP + C_CMV + 128 * g + 8 * v); }
#pragma unroll
    for (int qb = 0; qb < 2; ++qb) { const int blk = wave + qb * NWAVES; const int m0 = 32 * (blk >> 2), n0 = 32 * (blk & 3);
#pragma unroll
        for (int bq = 0; bq < 2; ++bq) { const int i = n0 + 16 * bq + (lane & 15); bias[qb][bq] = bsrc[i];
#pragma unroll
            for (int a = 0; a < 2; ++a) { const int d = m0 + 16 * a + 4 * (lane >> 4); uu[qb][a][bq] = *(const GAS unsigned long long*)(P + (size_t)(row0 + i) * NP + C_CMU + 128 * g + d); } } }
    SCHED_FENCE();
#pragma unroll
    for (int it = 0; it < 8; ++it) { const int task = tid + it * NTHR; const int i = task >> 5, j4 = task & 31; const f32x4 w = wv[it];
        *(LAS unsigned long long*)(Ws + i * 136 + 4 * j4) = (unsigned long long)pg8::cvt_pk_bf16(w.x, w.y) | ((unsigned long long)pg8::cvt_pk_bf16(w.z, w.w) << 32); }
#pragma unroll
    for (int it = 0; it < 4; ++it) { const int task = tid + it * NTHR; const int j = task >> 4, v = task & 15; float f[8]; unpack8(vin[it], f);
#pragma unroll
        for (int e = 0; e < 8; ++e) Vt[(8 * v + e) * 136 + tswz<15>(8 * v + e, j)] = (unsigned short)f2bf(gelu_tanh(f[e])); }
    __syncthreads();
#pragma unroll
    for (int qb = 0; qb < 2; ++qb) { const int blk = wave + qb * NWAVES; const int m0 = 32 * (blk >> 2), n0 = 32 * (blk & 3);
        Acc32 acc; acc_zero(acc); wave_mma32<15, -1>(acc, Vt, 136, Ws, 136, m0, n0, 128, lane);
#pragma unroll
        for (int a = 0; a < 2; ++a)
#pragma unroll
            for (int bq = 0; bq < 2; ++bq) { const int d = m0 + 16 * a + 4 * (lane >> 4), i = n0 + 16 * bq + (lane & 15); const float bi = bias[qb][bq];
                const size_t prow = (size_t)(row0 + i); const unsigned long long u8 = uu[qb][a][bq];
                const float u0 = gelu_tanh(__uint_as_float((unsigned)u8 << 16)), u1 = gelu_tanh(__uint_as_float((unsigned)u8 & 0xffff0000u)), u2 = gelu_tanh(__uint_as_float((unsigned)(u8 >> 32) << 16)), u3 = gelu_tanh(__uint_as_float((unsigned)(u8 >> 32) & 0xffff0000u));
                const f32x4 sv = acc.v[a][bq];
                *(GAS unsigned long long*)(YM + prow * D + 512 + 128 * g + d) = (unsigned long long)pg8::cvt_pk_bf16(u0 * (sv[0] + bi), u1 * (sv[1] + bi)) | ((unsigned long long)pg8::cvt_pk_bf16(u2 * (sv[2] + bi), u3 * (sv[3] + bi)) << 32); }
    }
    __syncthreads();
}

__device__ __forceinline__ void m1_mamba_group(KA A, LAS unsigned char* lds, int l, int item, int tid, int wave, int lane) {
    unsigned char* ws = A->ws; const bf16* P = (const bf16*)(ws + WS_P);
    const int cc = item >> 1, g = item & 1; const int b = cc / NCH_M, c = cc % NCH_M, row0 = b * TB + c * 128;
    const float* cw = A->in[I_MBCW] + (size_t)l * 3 * 1024; const float* cb = A->in[I_MBCB] + (size_t)l * 1024;
    lbf16* Cm = (lbf16*)lds; lbf16* Bm = (lbf16*)(lds + 34816); lbf16* BmT = (lbf16*)(lds + 69632); lbf16* Xt = (lbf16*)(lds + 104448);
    LAS float* sm = (LAS float*)(lds + 121856);
    {
        const int v = tid & 15; ConvIn xb[4], xc[4]; ConvW wB, wC;
#pragma unroll
        for (int q = 0; q < 4; ++q) convin_load(xb[q], P, row0 + (tid >> 4) + 32 * q, C_BM + 128 * g + 8 * v);
#pragma unroll
        for (int q = 0; q < 4; ++q) convin_load(xc[q], P, row0 + (tid >> 4) + 32 * q, C_CM + 128 * g + 8 * v);
        convw_load(wB, cw, cb, 512 + 128 * g + 8 * v); convw_load(wC, cw, cb, 768 + 128 * g + 8 * v);
        SCHED_FENCE();
#pragma unroll
        for (int q = 0; q < 4; ++q) { const int t = (tid >> 4) + 32 * q; float o[8]; conv8w(xb[q], wB, o); *(LAS v4u*)(Bm + t * 136 + 8 * v) = pack8(o);
#pragma unroll
            for (int e = 0; e < 8; ++e) BmT[(8 * v + e) * 136 + tswz<15>(8 * v + e, t)] = (unsigned short)f2bf(o[e]); }
#pragma unroll
        for (int q = 0; q < 4; ++q) { const int t = (tid >> 4) + 32 * q; float o[8]; conv8w(xc[q], wC, o); *(LAS v4u*)(Cm + t * 136 + 8 * v) = pack8(o); }
    }
    __syncthreads();
    Acc32 cbraw[2];
#pragma unroll
    for (int q2 = 0; q2 < 2; ++q2) { const int blk = wave + 8 * q2; acc_zero(cbraw[q2]); wave_mma32(cbraw[q2], Cm, 136, Bm, 136, 32 * (blk >> 2), 32 * (blk & 3), 128, lane); }
    __syncthreads();
    lbf16* Wl = Cm; lbf16* XwT = Bm;
    ConvIn xn[2]; ConvW wn; float dtn = 0.f;
#define MG_ISSUE(hx) do { const int v_ = tid & 7; _Pragma("unroll") for (int i = 0; i < 2; ++i) convin_load(xn[i], P, row0 + (tid >> 3) + 64 * i, C_XS + 64 * (hx) + 8 * v_); convw_load(wn, cw, cb, 64 * (hx) + 8 * v_); \
        if (tid < 256) dtn = ((const float*)(ws + WS_PS))[(size_t)(row0 + (tid & 127)) * NSM + (tid >> 7) * 8 + (hx)] + A->in[I_MBDTB][(l * 2 + (tid >> 7)) * 8 + (hx)]; } while (0)
    MG_ISSUE(4 * g);
#pragma unroll 1
    for (int hh = 0; hh < 4; ++hh) { const int h = 4 * g + hh;
    {
        const int v = tid & 7; const ConvW w = wn; const ConvIn x[2] = {xn[0], xn[1]}; const float dtx = dtn;
        asm volatile("" : "+v"(tid), "+v"(lane)); asm volatile("" : "+s"(wave));
        if (hh < 3) MG_ISSUE(h + 1);
        SCHED_FENCE();
#pragma unroll
        for (int i = 0; i < 2; ++i) { const int t = (tid >> 3) + 64 * i; float o[8]; conv8w(x[i], w, o);
#pragma unroll
            for (int e = 0; e < 8; ++e) Xt[(8 * v + e) * 136 + tswz<15>(8 * v + e, t)] = (unsigned short)f2bf(o[e]); }
        if (tid < 256) sm[(tid >> 7) * 128 + (tid & 127)] = softplus_f(dtx);
    }
    __syncthreads();
    const float an0 = -__expf(A->in[I_MBALOG][(l * 2 + 0) * 8 + h]), an1 = -__expf(A->in[I_MBALOG][(l * 2 + 1) * 8 + h]);
    if (wave == 0) {
        const float x0 = sm[2 * lane] * an0, x1 = sm[2 * lane + 1] * an0; float S = x0 + x1;
#pragma unroll
        for (int off = 1; off < 64; off <<= 1) { const float y = __shfl_up(S, off); if (lane >= off) S += y; }
        float E = __shfl_up(S, 1); if (lane == 0) E = 0.f;
        sm[256 + 2 * lane] = E + x0; sm[256 + 2 * lane + 1] = E + (x0 + x1);
    } else if (wave == 1) {
        const float x0 = sm[128 + 2 * lane] * an1, x1 = sm[128 + 2 * lane + 1] * an1; float S = x0 + x1;
#pragma unroll
        for (int off = 1; off < 64; off <<= 1) { const float y = __shfl_down(S, off); if (lane + off < 64) S += y; }
        float E = __shfl_down(S, 1); if (lane == 63) E = 0.f;
        sm[384 + 2 * lane + 1] = E + x1; sm[384 + 2 * lane] = E + (x1 + x0);
    }
    __syncthreads();
    const LAS float* dt0 = sm; const LAS float* dt1 = sm + 128; const LAS float* ac0 = sm + 256; const LAS float* ac1 = sm + 384;
#pragma unroll
    for (int q2 = 0; q2 < 2; ++q2) { const int blk = wave + 8 * q2;
#pragma unroll
        for (int a = 0; a < 2; ++a)
#pragma unroll
            for (int bq = 0; bq < 2; ++bq) { const int jj = 32 * (blk & 3) + 16 * bq + (lane & 15); const float a0j = ac0[jj], a1j = ac1[jj], d0j = dt0[jj], d1j = dt1[jj];
#pragma unroll
                for (int j = 0; j < 4; ++j) { const int i = 32 * (blk >> 2) + 16 * a + 4 * (lane >> 4) + j; float f = 0.f;
                    if (jj <= i) f += __expf(ac0[i] - a0j) * d0j;
                    if (jj >= i) f += __expf(ac1[i] - a1j) * d1j;
                    Wl[i * 136 + jj] = (unsigned short)f2bf(cbraw[q2].v[a][bq][j] * f); } }
    }
    const float al0 = ac0[127], al1 = ac1[0];
    for (int task = tid; task < 2048; task += NTHR) { const int d = task >> 10, p = (task >> 4) & 63, v = task & 15; float f[8]; unpack8(*(const LAS v4u*)(Xt + p * 136 + 8 * (v ^ ((p >> 3) & 15))), f);
#pragma unroll
        for (int e = 0; e < 8; ++e) { const int j = 8 * v + e; f[e] *= d ? __expf(al1 - ac1[j]) * dt1[j] : __expf(al0 - ac0[j]) * dt0[j]; }
        *(LAS v4u*)(XwT + d * 8704 + p * 136 + 8 * v) = pack8(f); }
    __syncthreads();
    {
        const int m0 = 32 * (wave >> 2), n0 = 32 * (wave & 3); Acc32 y; acc_zero(y); wave_mma32<15, -1>(y, Xt, 136, Wl, 136, m0, n0, 128, lane);
        const float dsum = A->in[I_MBD][(l * 2 + 0) * 8 + h] + A->in[I_MBD][(l * 2 + 1) * 8 + h];
        float* YMB = (float*)(ws + WS_YMB);
#pragma unroll
        for (int a = 0; a < 2; ++a)
#pragma unroll
            for (int bq = 0; bq < 2; ++bq) { const int p = m0 + 16 * a + 4 * (lane >> 4), i = n0 + 16 * bq + (lane & 15); f32x4 o = y.v[a][bq];
#pragma unroll
                for (int j = 0; j < 4; ++j) o[j] += bf2f(Xt[(p + j) * 136 + tswz<15>(p + j, i)]) * dsum;
                *(GAS f32x4*)(YMB + (size_t)(row0 + i) * 512 + 64 * h + p) = o; }
    }
    float* CSM = (float*)(ws + WS_CSM);
#pragma unroll
    for (int d = 0; d < 2; ++d) {
        const int m0 = 32 * (wave >> 1), n0 = 32 * (wave & 1); Acc32 s; acc_zero(s); wave_mma32<15, -1>(s, BmT, 136, XwT + d * 8704, 136, m0, n0, 128, lane);
        float* cs = CSM + ((((size_t)b * NCH_M + c) * 2 + d) * 8 + h) * 8192;
#pragma unroll
        for (int a = 0; a < 2; ++a)
#pragma unroll
            for (int bq = 0; bq < 2; ++bq) { const int n = m0 + 16 * a + 4 * (lane >> 4), p = n0 + 16 * bq + (lane & 15); *(GAS f32x4*)(cs + p * 128 + n) = s.v[a][bq]; }
    }
    if (tid < 256) { const int d = tid >> 7, t = tid & 127; ((float*)(ws + WS_EA))[(size_t)(row0 + t) * 16 + d * 8 + h] = __expf(sm[256 + d * 128 + t]); }
    if (tid < 2) ((float*)(ws + WS_ALAST))[(((size_t)b * NCH_M + c) * 2 + tid) * 8 + h] = tid ? al1 : al0;
    __syncthreads();
    }
#undef MG_ISSUE
}

__device__ __forceinline__ void m1_gla_item(KA A, LAS unsigned char* lds, int l, int item, int tid, int wave, int lane) {
    unsigned char* ws = A->ws; const bf16* P = (const bf16*)(ws + WS_P);
    const int cgi = item >> 2, h = item & 3; const int b = cgi / NCH_G, c = cgi % NCH_G, row0 = b * TB + c * 64;
    LAS float* G = (LAS float*)lds;
    LAS float* wgs = (LAS float*)(lds + 33280);
    LAS float* bgs = (LAS float*)(lds + 41472);
    lbf16* Qs = (lbf16*)(lds + 41984); lbf16* Ks = (lbf16*)(lds + 60416); lbf16* KsT = (lbf16*)(lds + 78848); lbf16* Vt = (lbf16*)(lds + 97280); lbf16* Att = (lbf16*)(lds + 115712);
    float wg4[4]; float bg1 = 0.f; f32x4 glv[4]; v4u qv, kv8, vv2[2];
#pragma unroll
    for (int it = 0; it < 4; ++it) { const int i = tid + it * NTHR; const int d = i >> 10, r = (i >> 6) & 15, k = i & 63; wg4[it] = A->in[I_GLAWG][(((size_t)l * 2 + d) * 16 + r) * 256 + 64 * h + k]; }
    if (tid < 128) bg1 = A->in[I_GLABG][((size_t)l * 2 + (tid >> 6)) * 256 + 64 * h + (tid & 63)];
    { const int d = tid >> 8, t = (tid >> 2) & 63; const GAS f32x4* p = (const GAS f32x4*)((const float*)(ws + WS_PS) + (size_t)(row0 + t) * NSM + 16 + d * 16);
#pragma unroll
      for (int e = 0; e < 4; ++e) glv[e] = p[e]; }
    { const int t = tid >> 3, kv = tid & 7; qv = *(const GAS v4u*)(P + (size_t)(row0 + t) * NP + C_Q + 64 * h + 8 * kv); kv8 = *(const GAS v4u*)(P + (size_t)(row0 + t) * NP + C_K + 64 * h + 8 * kv); }
#pragma unroll
    for (int it = 0; it < 2; ++it) { const int task = tid + it * NTHR; const int t = task >> 4, vv = task & 15; vv2[it] = *(const GAS v4u*)(P + (size_t)(row0 + t) * NP + C_V + 128 * h + 8 * vv); }
    SCHED_FENCE();
#pragma unroll
    for (int it = 0; it < 4; ++it) wgs[tid + it * NTHR] = wg4[it];
    if (tid < 128) bgs[tid] = bg1;
    __syncthreads();
    {   const int d = tid >> 8, t = (tid >> 2) & 63, kq = tid & 3;
        float gl[16];
#pragma unroll
        for (int e = 0; e < 4; ++e) { const f32x4 f = glv[e]; gl[4 * e] = f.x; gl[4 * e + 1] = f.y; gl[4 * e + 2] = f.z; gl[4 * e + 3] = f.w; }
        f32x4 acc[4] = {{0.f, 0.f, 0.f, 0.f}, {0.f, 0.f, 0.f, 0.f}, {0.f, 0.f, 0.f, 0.f}, {0.f, 0.f, 0.f, 0.f}};
#pragma unroll
        for (int r = 0; r < 16; ++r) { const LAS f32x4* w = (const LAS f32x4*)(wgs + (d * 16 + r) * 64 + kq * 16);
#pragma unroll
            for (int q = 0; q < 4; ++q) acc[q] += w[q] * gl[r]; }
#pragma unroll
        for (int q = 0; q < 4; ++q)
#pragma unroll
            for (int e = 0; e < 4; ++e) { const int k = kq * 16 + 4 * q + e; G[(d * 64 + t) * 65 + k] = logsig_f(acc[q][e] + bgs[d * 64 + k]) * (1.f / 16.f); }
    }
    __syncthreads();
    for (int col = wave; col < 128; col += NWAVES) {
        const int d = col >> 6, k = col & 63; float S = G[(d * 64 + lane) * 65 + k];
        if (d == 0) {
#pragma unroll
            for (int off = 1; off < 64; off <<= 1) { const float y = __shfl_up(S, off); if (lane >= off) S += y; }
        } else {
#pragma unroll
            for (int off = 1; off < 64; off <<= 1) { const float y = __shfl_down(S, off); if (lane + off < 64) S += y; }
        }
        G[(d * 64 + lane) * 65 + k] = S; }
    __syncthreads();
    {   const int t = tid >> 3, kv = tid & 7; float qf[8], kf[8];
        unpack8(qv, qf); unpack8(kv8, kf);
        bf16* QE = (bf16*)(ws + WS_QE);
#pragma unroll
        for (int d = 0; d < 2; ++d) { float qs[8], ks[8], qe[8];
#pragma unroll
            for (int e = 0; e < 8; ++e) { const int k = 8 * kv + e; const float gv = G[(d * 64 + t) * 65 + k], gref = G[(d * 64 + (d ? 31 : 32)) * 65 + k], glast = G[(d * 64 + (d ? 0 : 63)) * 65 + k];
                const float q = qf[e] * 0.125f; qs[e] = q * __expf(gv - gref); ks[e] = kf[e] * __expf(gref - gv); qe[e] = q * __expf(gv);
                KsT[d * 4608 + k * 72 + tswz<7>(k, t)] = (unsigned short)f2bf(kf[e] * __expf(glast - gv)); }
            *(LAS v4u*)(Qs + d * 4608 + t * 72 + 8 * kv) = pack8(qs); *(LAS v4u*)(Ks + d * 4608 + t * 72 + 8 * kv) = pack8(ks);
            *(GAS v4u*)(QE + (size_t)(row0 + t) * 512 + d * 256 + 64 * h + 8 * kv) = pack8(qe); }
    }
#pragma unroll
    for (int it = 0; it < 2; ++it) { const int task = tid + it * NTHR; const int t = task >> 4, vv = task & 15; float f[8]; unpack8(vv2[it], f);
#pragma unroll
        for (int e = 0; e < 8; ++e) Vt[(8 * vv + e) * 72 + tswz<7>(8 * vv + e, t)] = (unsigned short)f2bf(f[e]); }
    if (tid < 128) { const int d = tid >> 6, k = tid & 63; ((float*)(ws + WS_GLAST))[((((size_t)b * NCH_G + c) * 2 + d) * 4 + h) * 64 + k] = G[(d * 64 + (d ? 0 : 63)) * 65 + k]; }
    __syncthreads();
    if (wave < 4) { const int m0 = 32 * (wave >> 1), n0 = 32 * (wave & 1); Acc32 a0, a1; acc_zero(a0); acc_zero(a1);
        wave_mma32(a0, Qs, 72, Ks, 72, m0, n0, 64, lane); wave_mma32(a1, Qs + 4608, 72, Ks + 4608, 72, m0, n0, 64, lane);
#pragma unroll
        for (int a = 0; a < 2; ++a)
#pragma unroll
            for (int bq = 0; bq < 2; ++bq) { const int jj = n0 + 16 * bq + (lane & 15);
#pragma unroll
                for (int j = 0; j < 4; ++j) { const int i = m0 + 16 * a + 4 * (lane >> 4) + j; const float val = (jj <= i ? a0.v[a][bq][j] : 0.f) + (jj >= i ? a1.v[a][bq][j] : 0.f); Att[i * 72 + jj] = (unsigned short)f2bf(val); } }
    }
    __syncthreads();
    const int m0 = 32 * (wave >> 1), n0 = 32 * (wave & 1);
    {   Acc32 o; acc_zero(o); wave_mma32<7, -1>(o, Vt, 72, Att, 72, m0, n0, 64, lane);
        float* YG = (float*)(ws + WS_YGLA);
#pragma unroll
        for (int a = 0; a < 2; ++a)
#pragma unroll
            for (int bq = 0; bq < 2; ++bq) { const int v = m0 + 16 * a + 4 * (lane >> 4), i = n0 + 16 * bq + (lane & 15); *(GAS f32x4*)(YG + (size_t)(row0 + i) * 512 + 128 * h + v) = o.v[a][bq]; }
    }
    float* CSG = (float*)(ws + WS_CSG);
#pragma unroll
    for (int d = 0; d < 2; ++d) { Acc32 s; acc_zero(s); wave_mma32<7, 7>(s, Vt, 72, KsT + d * 4608, 72, m0, n0, 64, lane);
        float* cs = CSG + ((((size_t)b * NCH_G + c) * 2 + d) * 4 + h) * 8192;
#pragma unroll
        for (int a = 0; a < 2; ++a)
#pragma unroll
            for (int bq = 0; bq < 2; ++bq) { const int v = m0 + 16 * a + 4 * (lane >> 4), k = n0 + 16 * bq + (lane & 15); *(GAS f32x4*)(cs + k * 128 + v) = s.v[a][bq]; }
    }
    __syncthreads();
}

__device__ __forceinline__ void m2_phase(KA A, int wave, int lane, int bid, int G) {
    unsigned char* ws = A->ws; const int gw = bid * NWAVES + wave, NGW = G * NWAVES;
    float* CSM = (float*)(ws + WS_CSM); const float* AL = (const float*)(ws + WS_ALAST);
    for (int line = gw; line < BATCH * 2 * 8 * 64; line += NGW) {
        const int p = line & 63, h = (line >> 6) & 7, d = (line >> 9) & 1, b = line >> 10;
        float c0[NCH_M], c1[NCH_M], dc[NCH_M];
#pragma unroll
        for (int i = 0; i < NCH_M; ++i) { const int c = d == 0 ? i : (i < 2 ? 1 - i : NCH_M + 1 - i);
            const float* cs = CSM + (((((size_t)b * NCH_M + c) * 2 + d) * 8 + h) * 64 + p) * 128;
            c0[i] = cs[lane]; c1[i] = cs[lane + 64]; dc[i] = AL[(((size_t)b * NCH_M + c) * 2 + d) * 8 + h]; }
        float s0 = 0.f, s1 = 0.f;
#pragma unroll
        for (int i = 0; i < NCH_M; ++i) { const int c = d == 0 ? i : (i < 2 ? 1 - i : NCH_M + 1 - i);
            bf16* ss = (bf16*)(ws + WS_SSM) + (((((size_t)b * NCH_M + c) * 2 + d) * 8 + h) * 64 + p) * 128;
            ss[lane] = (unsigned short)f2bf(s0); ss[lane + 64] = (unsigned short)f2bf(s1); const float dec = __expf(dc[i]); s0 = dec * s0 + c0[i]; s1 = dec * s1 + c1[i]; }
    }
    float* CSG = (float*)(ws + WS_CSG); const float* GL = (const float*)(ws + WS_GLAST);
    for (int line = gw; line < BATCH * 2 * 4 * 64; line += NGW) {
        const int k = line & 63, h = (line >> 6) & 3, d = (line >> 8) & 1, b = line >> 9;
        float s0 = 0.f, s1 = 0.f;
#pragma unroll
        for (int half = 0; half < 2; ++half) {
            float c0[34], c1[34], dc[34];
#pragma unroll
            for (int ii = 0; ii < 34; ++ii) { const int i = half * 34 + ii; const int c = d == 0 ? i : (i < 4 ? 3 - i : NCH_G + 3 - i);
                const float* cs = CSG + (((((size_t)b * NCH_G + c) * 2 + d) * 4 + h) * 64 + k) * 128;
                c0[ii] = cs[lane]; c1[ii] = cs[lane + 64]; dc[ii] = GL[((((size_t)b * NCH_G + c) * 2 + d) * 4 + h) * 64 + k]; }
#pragma unroll
            for (int ii = 0; ii < 34; ++ii) { const int i = half * 34 + ii; const int c = d == 0 ? i : (i < 4 ? 3 - i : NCH_G + 3 - i);
                bf16* ss = (bf16*)(ws + WS_SSG) + (((((size_t)b * NCH_G + c) * 2 + d) * 4 + h) * 64 + k) * 128;
                ss[lane] = (unsigned short)f2bf(s0); ss[lane + 64] = (unsigned short)f2bf(s1); const float dec = __expf(dc[ii]); s0 = dec * s0 + c0[ii]; s1 = dec * s1 + c1[ii]; }
        }
    }
}

__device__ __forceinline__ void m3_mamba_item(KA A, LAS unsigned char* lds, int l, int item, int tid, int wave, int lane) {
    unsigned char* ws = A->ws; const bf16* P = (const bf16*)(ws + WS_P);
    const int cc = item >> 3, h = item & 7, g = h >> 2; const int b = cc / NCH_M, c = cc % NCH_M, row0 = b * TB + c * 128;
    const float* cw = A->in[I_MBCW] + (size_t)l * 3 * 1024; const float* cb = A->in[I_MBCB] + (size_t)l * 1024;
    lbf16* Sc = (lbf16*)lds; lbf16* Cc = (lbf16*)(lds + 33792);
    const bf16* CSM = (const bf16*)(ws + WS_SSM); const float* EA = (const float*)(ws + WS_EA);
    {   unsigned long long s[8]; ConvIn x[4]; float e0[4], e1[4]; const int v = tid & 15; ConvW w;
#pragma unroll
        for (int it = 0; it < 8; ++it) { const int task = tid + it * NTHR; const int d = task >> 11, p = (task >> 5) & 63, n4 = task & 31;
            s[it] = *(const GAS unsigned long long*)(CSM + (((((size_t)b * NCH_M + c) * 2 + d) * 8 + h) * 64 + p) * 128 + 4 * n4); }
#pragma unroll
        for (int it = 0; it < 4; ++it) { const int i = (tid >> 4) + 32 * it; convin_load(x[it], P, row0 + i, C_CM + 128 * g + 8 * v);
            e0[it] = EA[(size_t)(row0 + i) * 16 + h]; e1[it] = EA[(size_t)(row0 + i) * 16 + 8 + h]; }
        convw_load(w, cw, cb, 768 + 128 * g + 8 * v);
        SCHED_FENCE();
#pragma unroll
        for (int it = 0; it < 8; ++it) { const int task = tid + it * NTHR; const int d = task >> 11, p = (task >> 5) & 63, n4 = task & 31;
            *(LAS unsigned long long*)(Sc + p * 264 + d * 128 + 4 * n4) = s[it]; }
#pragma unroll
        for (int it = 0; it < 4; ++it) { const int i = (tid >> 4) + 32 * it; float o[8], o1[8]; conv8w(x[it], w, o);
#pragma unroll
            for (int e = 0; e < 8; ++e) { o1[e] = o[e] * e1[it]; o[e] *= e0[it]; }
            *(LAS v4u*)(Cc + i * 264 + 8 * v) = pack8(o); *(LAS v4u*)(Cc + i * 264 + 128 + 8 * v) = pack8(o1); }
    }
    __syncthreads();
    {   const int m0 = 32 * (wave >> 2), n0 = 32 * (wave & 3); Acc32 y; acc_zero(y);
        float* YMB = (float*)(ws + WS_YMB); f32x4 old[2][2];
#pragma unroll
        for (int a = 0; a < 2; ++a)
#pragma unroll
            for (int bq = 0; bq < 2; ++bq) { const int p = m0 + 16 * a + 4 * (lane >> 4), i = n0 + 16 * bq + (lane & 15); old[a][bq] = *(const GAS f32x4*)(YMB + (size_t)(row0 + i) * 512 + 64 * h + p); }
        SCHED_FENCE();
        wave_mma32(y, Sc, 264, Cc, 264, m0, n0, 256, lane);
#pragma unroll
        for (int a = 0; a < 2; ++a)
#pragma unroll
            for (int bq = 0; bq < 2; ++bq) { const int p = m0 + 16 * a + 4 * (lane >> 4), i = n0 + 16 * bq + (lane & 15); *(GAS f32x4*)(YMB + (size_t)(row0 + i) * 512 + 64 * h + p) = old[a][bq] + y.v[a][bq]; }
    }
    __syncthreads();
}
__device__ __forceinline__ void m3_gla_item(KA A, LAS unsigned char* lds, int item, int tid, int wave, int lane) {
    unsigned char* ws = A->ws;
    const int cgi = item >> 2, h = item & 3; const int b = cgi / NCH_G, c = cgi % NCH_G, row0 = b * TB + c * 64;
    lbf16* St = (lbf16*)lds; lbf16* Qc = (lbf16*)(lds + 34816);
    const bf16* CSG = (const bf16*)(ws + WS_SSG); const bf16* QE = (const bf16*)(ws + WS_QE);
    {   unsigned long long s[8]; v4u q[2];
#pragma unroll
        for (int it = 0; it < 8; ++it) { const int task = tid + it * NTHR; const int d = task >> 11, k = (task >> 5) & 63, v4 = task & 31;
            s[it] = *(const GAS unsigned long long*)(CSG + (((((size_t)b * NCH_G + c) * 2 + d) * 4 + h) * 64 + k) * 128 + 4 * v4); }
#pragma unroll
        for (int it = 0; it < 2; ++it) { const int task = tid + it * NTHR; const int i = task >> 4, d = (task >> 3) & 1, kv = task & 7;
            q[it] = *(const GAS v4u*)(QE + (size_t)(row0 + i) * 512 + d * 256 + 64 * h + 8 * kv); }
        SCHED_FENCE();
#pragma unroll
        for (int it = 0; it < 8; ++it) { const int task = tid + it * NTHR; const int d = task >> 11, k = (task >> 5) & 63, v4 = task & 31;
#pragma unroll
            for (int e = 0; e < 4; ++e) St[(4 * v4 + e) * 136 + tswz<15>(4 * v4 + e, d * 64 + k)] = (unsigned short)(s[it] >> (16 * e)); }
#pragma unroll
        for (int it = 0; it < 2; ++it) { const int task = tid + it * NTHR; const int i = task >> 4, d = (task >> 3) & 1, kv = task & 7; *(LAS v4u*)(Qc + i * 136 + d * 64 + 8 * kv) = q[it]; }
    }
    __syncthreads();
    {   const int m0 = 32 * (wave >> 1), n0 = 32 * (wave & 1); Acc32 o; acc_zero(o);
        float* YG = (float*)(ws + WS_YGLA); f32x4 old[2][2];
#pragma unroll
        for (int a = 0; a < 2; ++a)
#pragma unroll
            for (int bq = 0; bq < 2; ++bq) { const int v = m0 + 16 * a + 4 * (lane >> 4), i = n0 + 16 * bq + (lane & 15); old[a][bq] = *(const GAS f32x4*)(YG + (size_t)(row0 + i) * 512 + 128 * h + v); }
        SCHED_FENCE();
        wave_mma32<15, -1>(o, St, 136, Qc, 136, m0, n0, 128, lane);
#pragma unroll
        for (int a = 0; a < 2; ++a)
#pragma unroll
            for (int bq = 0; bq < 2; ++bq) { const int v = m0 + 16 * a + 4 * (lane >> 4), i = n0 + 16 * bq + (lane & 15); *(GAS f32x4*)(YG + (size_t)(row0 + i) * 512 + 128 * h + v) = old[a][bq] + o.v[a][bq]; }
    }
    __syncthreads();
}

struct M4Row { f32x4 y[2], o[2]; v4u zz, gz; };
__device__ __forceinline__ void m4_load(M4Row& r, const float* YMB, const float* YG, const bf16* P, int row, int lane) {
    const bf16* p = P + (size_t)row * NP; const int idx = 8 * lane;
#pragma unroll
    for (int hh = 0; hh < 2; ++hh) { r.y[hh] = *(const GAS f32x4*)(YMB + (size_t)row * 512 + idx + 4 * hh); r.o[hh] = *(const GAS f32x4*)(YG + (size_t)row * 512 + idx + 4 * hh); }
    r.zz = *(const GAS v4u*)(p + C_Z + idx); r.gz = *(const GAS v4u*)(p + C_G + idx);
}
__device__ __forceinline__ void m4_phase(KA A, int l, int wave, int lane, int bid, int G) {
    unsigned char* ws = A->ws; const bf16* P = (const bf16*)(ws + WS_P); bf16* YM = (bf16*)(ws + WS_YMIX);
    const float* YMB = (const float*)(ws + WS_YMB); const float* YG = (const float*)(ws + WS_YGLA);
    const float* mng = A->in[I_MBNG] + (size_t)l * 512; const float* gng = A->in[I_GLANG] + (size_t)l * 128;
    const int idx = 8 * lane;
    f32x4 mg[2], gn[2];
#pragma unroll
    for (int hh = 0; hh < 2; ++hh) { mg[hh] = *(const GAS f32x4*)(mng + idx + 4 * hh); gn[hh] = *(const GAS f32x4*)(gng + ((idx + 4 * hh) & 127)); }
    const int stride = G * NWAVES; int row = bid * NWAVES + wave;
    M4Row cur, nxt; if (row < MR) m4_load(cur, YMB, YG, P, row, lane);
    for (; row < MR; row += stride) {
        if (row + stride < MR) m4_load(nxt, YMB, YG, P, row + stride, lane);
        float z[8], g[8]; unpack8(cur.zz, z); unpack8(cur.gz, g);
        float y[8]; float ss = 0.f;
#pragma unroll
        for (int e = 0; e < 8; ++e) { y[e] = cur.y[e >> 2][e & 3] * silu_f(z[e]); ss += y[e] * y[e]; }
        const float r = __builtin_amdgcn_rsqf(wave_sum(ss) * (1.f / 512.f) + EPS);
        float o1[8];
#pragma unroll
        for (int e = 0; e < 8; ++e) o1[e] = y[e] * r * mg[e >> 2][e & 3];
        *(GAS v4u*)(YM + (size_t)row * D + 1024 + idx) = pack8(o1);
        float q = 0.f;
#pragma unroll
        for (int e = 0; e < 8; ++e) { const float ov = cur.o[e >> 2][e & 3]; q += ov * ov; }
        const float rr = __builtin_amdgcn_rsqf(row16_sum(q) * (1.f / 128.f) + EPS);
        float o2[8];
#pragma unroll
        for (int e = 0; e < 8; ++e) o2[e] = cur.o[e >> 2][e & 3] * rr * gn[e >> 2][e & 3] * silu_f(g[e]);
        *(GAS v4u*)(YM + (size_t)row * D + 1536 + idx) = pack8(o2);
        cur = nxt;
    }
}

__device__ __forceinline__ void dispatch_phase(KA A, LAS unsigned char* lds, int tid, int wave, int lane, int bid) {
    unsigned char* ws = A->ws;
    LAS int* cnt = (LAS int*)lds;
    LAS int* tab = cnt + 2048;
    const int* gc = (const int*)(ws + WS_CNT);
    { int c4[4];
#pragma unroll
      for (int it = 0; it < 4; ++it) c4[it] = gc[tid + it * NTHR];
      SCHED_FENCE();
#pragma unroll
      for (int it = 0; it < 4; ++it) cnt[tid + it * NTHR] = c4[it]; }
    __syncthreads();
    if (tid < 8) { int tot = 0, pre = 0; for (int w = 0; w < 256; ++w) { const int v = cnt[w * 8 + tid]; if (w < bid) pre += v; tot += v; } tab[8 + tid] = pre; tab[32 + tid] = (tot + 255) >> 8; }
    __syncthreads();
    if (tid == 0) { int tb = 0; for (int e = 0; e < 8; ++e) { tab[16 + e] = tb; tab[e] = tb * 256; tb += tab[32 + e]; } tab[24] = tb;
        if (bid == 0) { int* mi = (int*)(ws + WS_MOEINFO); for (int e = 0; e < 9; ++e) mi[e] = tab[16 + e]; } }
    __syncthreads();
    const int4* route = (const int4*)(ws + WS_ROUTE); int* tokpos = (int*)(ws + WS_TOKPOS);
    const bf16* XN = (const bf16*)(ws + WS_XN); bf16* AP = (bf16*)(ws + WS_APERM);
    {   int4 rr[4]; v4u xv[4][2];
#pragma unroll
        for (int k = 0; k < 4; ++k) { const int row = wg_row(bid, wave + NWAVES * k); rr[k] = route[row]; const GAS v4u* src = (const GAS v4u*)((const unsigned char*)XN + (size_t)row * D);
#pragma unroll
            for (int j = 0; j < 2; ++j) xv[k][j] = src[lane + 64 * j]; }
        SCHED_FENCE();
#pragma unroll
        for (int k = 0; k < 4; ++k) { const int row = wg_row(bid, wave + NWAVES * k); const int4 r = rr[k]; const int e1 = r.x & 15, e2 = (r.x >> 4) & 15, r1 = (r.x >> 8) & 255, r2 = (r.x >> 16) & 255;
            const int p1 = tab[e1] + tab[8 + e1] + r1, p2 = tab[e2] + tab[8 + e2] + r2;
            if (lane == 0) { tokpos[row * 2] = p1; tokpos[row * 2 + 1] = p2; }
            GAS v4u* d1 = (GAS v4u*)((unsigned char*)AP + (size_t)p1 * D); GAS v4u* d2 = (GAS v4u*)((unsigned char*)AP + (size_t)p2 * D);
#pragma unroll
            for (int j = 0; j < 2; ++j) { d1[lane + 64 * j] = xv[k][j]; d2[lane + 64 * j] = xv[k][j]; } }
    }
    __syncthreads();
}

__device__ __forceinline__ void combine_phase(KA A, int l, int wave, int lane, int bid, int G) {
    unsigned char* ws = A->ws; const bf16* H = (const bf16*)(ws + WS_H); const bf16* DO = (const bf16*)(ws + WS_DOUT); const bf16* DO2 = (const bf16*)(ws + WS_DOUT2);
    const int4* route = (const int4*)(ws + WS_ROUTE); const int* tokpos = (const int*)(ws + WS_TOKPOS);
    const int2* TT2 = (const int2*)(ws + WS_TT); const bf16* XT = (const bf16*)(ws + WS_XT);
    const float* modl = (const float*)(ws + WS_MODF) + (size_t)l * 3 * ADAW; const float* gf = A->in[I_GFINAL];
    for (int row = bid * NWAVES + wave; row < MR; row += G * NWAVES) { const int b = row / TB, s = row % TB; if (s < CTXL) continue;
        const int4 r = route[row]; const float w1 = __int_as_float(r.y), w2 = __int_as_float(r.z); const int p1 = tokpos[row * 2], p2 = tokpos[row * 2 + 1];
        const GAS v4u* a1 = (const GAS v4u*)(DO + (size_t)p1 * D) + lane; const GAS v4u* a2 = (const GAS v4u*)(DO + (size_t)p2 * D) + lane; const GAS v4u* a3 = (const GAS v4u*)(DO2 + (size_t)p1 * D) + lane; const GAS v4u* a4 = (const GAS v4u*)(DO2 + (size_t)p2 * D) + lane;
        const GAS v4u* hr = (const GAS v4u*)(H + (size_t)row * D) + lane; const float* gt = modl + (size_t)b * ADAW + 5 * D + 8 * lane;
        float v[4][8]; float ss = 0.f;
#pragma unroll
        for (int j = 0; j < 4; ++j) { float e1[8], e2[8], e3[8], e4[8]; unpack8(a1[64 * j], e1); unpack8(a2[64 * j], e2); unpack8(a3[64 * j], e3); unpack8(a4[64 * j], e4);
            {
                const int n = 2 * j + (lane >> 5); const int2 t1 = TT2[(p1 >> 8) * 8 + n], t2 = TT2[(p2 >> 8) * 8 + n];
#define CMB_TAIL(tt, p, ev) if (tt) { const int sl = (tt) >> 3, S_ = (tt) & 7; for (int q = 1; q < S_; ++q) { float t8[8]; \
                    unpack8(*(const GAS v4u*)(XT + ((size_t)((sl * 3 + q - 1) * 256 + ((p) & 255)) * 256 + ((8 * lane) & 255))), t8); _Pragma("unroll") for (int e = 0; e < 8; ++e) ev[e] += t8[e]; } }
                CMB_TAIL(t1.x, p1, e1) CMB_TAIL(t1.y, p1, e3) CMB_TAIL(t2.x, p2, e2) CMB_TAIL(t2.y, p2, e4)
#undef CMB_TAIL
            }
            float hf[8]; unpack8(hr[64 * j], hf); const f32x4 g0 = *(const GAS f32x4*)(gt + 512 * j), g1 = *(const GAS f32x4*)(gt + 512 * j + 4);
#pragma unroll
            for (int e = 0; e < 8; ++e) { const float hh = hf[e], gg = e < 4 ? g0[e] : g1[e - 4]; v[j][e] = hh + gg * ((e1[e] + e3[e]) * w1 + (e2[e] + e4[e]) * w2); ss += v[j][e] * v[j][e]; } }
        const float rstd = __builtin_amdgcn_rsqf(wave_sum(ss) * (1.f / D) + EPS);
        float* o = A->out + (size_t)(b * SEQ + s - CTXL) * D + 8 * lane; const float* gfv = gf + 8 * lane;
#pragma unroll
        for (int j = 0; j < 4; ++j) { const f32x4 f0 = *(const GAS f32x4*)(gfv + 512 * j), f1 = *(const GAS f32x4*)(gfv + 512 * j + 4);
            *(GAS f32x4*)(o + 512 * j) = (f32x4){v[j][0] * rstd * f0[0], v[j][1] * rstd * f0[1], v[j][2] * rstd * f0[2], v[j][3] * rstd * f0[3]};
            *(GAS f32x4*)(o + 512 * j + 4) = (f32x4){v[j][4] * rstd * f1[0], v[j][5] * rstd * f1[1], v[j][6] * rstd * f1[2], v[j][7] * rstd * f1[3]}; }
    }
}
constexpr int CT_INPROJ0_HI = 8596, CT_FFNUP_HI = 19596, CT_INPROJ1_HI = 25600;
__device__ __forceinline__ void ph_inproj(LAS unsigned char* lds, unsigned char* ws, int l, int bid, int tid) {
    pg8::Gemm g{(const pg8::bf16_t*)(ws + WS_XN), (const pg8::bf16_t*)(ws + WS_WIN) + (size_t)l * NP * D, MR, NP, D};
    pg8::MixOrder<NP / 256, D / 64, 1, D, 12, 10, true> S{l ? 32 : NMT, bid, l, l ? 24 : 0, pg8::ConvHook{l ? CT_FFNUP_HI : CT_P0A_HI, l ? CT_INPROJ1_HI : CT_INPROJ0_HI, bid & 1}};
    pg8::EpiP E{ws};
    pg8::gemm_phase<pg8::EpiP, decltype(S), true, true>(lds + RING_OFF, g, S, E, tid);
}
__device__ __forceinline__ void ph_outproj(LAS unsigned char* lds, unsigned char* ws, const float* x, int l, int bid, int tid) {
    pg8::Gemm g{(const pg8::bf16_t*)(ws + WS_YMIX), (const pg8::bf16_t*)(ws + WS_WOUT) + (size_t)l * D * D, MR, D, D};
    pg8::MixOrder<D / 256, D / 64, 4, 512, 8, 0> S{32, bid, 1, l == 0 ? 16 : 0, pg8::ConvHook{0, 0, -1}};
    pg8::EpiRes E{ws, l == 0 ? x : nullptr, l, 2};
    pg8::gemm_phase<pg8::EpiRes, decltype(S), true, true>(lds + RING_OFF, g, S, E, tid);
}
__device__ __forceinline__ void ph_ffnup(LAS unsigned char* lds, unsigned char* ws, int bid, int tid) {
    pg8::Gemm g{(const pg8::bf16_t*)(ws + WS_XN), (const pg8::bf16_t*)(ws + WS_FUP), MR, 2 * FF, D};
    pg8::MixOrder<2 * FF / 256, D / 64, 1, D, 1, 0, true> S{NMT, bid, 0, 0, pg8::ConvHook{CT_INPROJ0_HI, CT_FFNUP_HI, bid % 5}};
    pg8::EpiSwiglu E{(pg8::bf16_t*)(ws + WS_ACT), FF, 2 * FF / 256};
    pg8::gemm_phase<pg8::EpiSwiglu, decltype(S), true, true>(lds + RING_OFF, g, S, E, tid);
}
__device__ __forceinline__ void ph_ffndn(LAS unsigned char* lds, unsigned char* ws, int bid, int tid) {
    pg8::Gemm g{(const pg8::bf16_t*)(ws + WS_ACT), (const pg8::bf16_t*)(ws + WS_FDN), MR, D, FF};
    pg8::MixOrder<D / 256, FF / 64, 11, 512, 8, 0> S{32, bid, 1, 16, pg8::ConvHook{0, 0, -1}};
    pg8::EpiRes E{ws, nullptr, 0, 5};
    pg8::gemm_phase<pg8::EpiRes, decltype(S), true, true>(lds + RING_OFF, g, S, E, tid);
}
__device__ __forceinline__ void ph_moeup(LAS unsigned char* lds, unsigned char* ws, int bid, int tid) {
    pg8::Gemm g{(const pg8::bf16_t*)(ws + WS_APERM), (const pg8::bf16_t*)(ws + WS_MUP), 0, 0, D};
    pg8::MoeOrder<2 * FFE / 256, 1, D, 128> S{(const int*)(ws + WS_MOEINFO), bid};
    pg8::EpiSwiglu8 E{ws + WS_ACTM, FFE, 2 * FFE / 256};
    static_assert(ACT8_SCALE == 4.f && SC_W8UP == SC_W8 + 0x02020202, "the up half's block scale carries ACT8_SCALE");
    pg8::gemm_phase_f8<pg8::EpiSwiglu8, decltype(S), SC_W8, SC_XN8, SC_W8UP>(lds + RING_OFF, g, S, E, tid);
}
__device__ __forceinline__ void ph_moedn(LAS unsigned char* lds, unsigned char* ws, int bid, int tid) {
    pg8::Gemm g{(const pg8::bf16_t*)(ws + WS_ACTM), (const pg8::bf16_t*)(ws + WS_MDN), 0, 0, FFE};
    pg8::MoeOrder<D / 256, 2, FFE / 2, 128> S{(const int*)(ws + WS_MOEINFO), bid};
    pg8::EpiBf16g8 E{(pg8::bf16_t*)(ws + WS_DOUT), (pg8::bf16_t*)(ws + WS_DOUT2), (pg8::bf16_t*)(ws + WS_XT), (int*)(ws + WS_TT), D, D / 256};
    pg8::gemm_phase_f8<pg8::EpiBf16g8, decltype(S), SC_W8, SC_ACT8>(lds + RING_OFF, g, S, E, tid);
}

#ifndef MK_PER_PHASE
#define MK_PER_PHASE 0
#endif
constexpr int NPH = 24;
__global__ void __launch_bounds__(NTHR, 2) mk_fwd(Args args_unused) {
    extern __shared__ __attribute__((aligned(16))) unsigned char lds_raw[];
    LAS unsigned char* lds = (LAS unsigned char*)lds_raw;
    const int tid0 = threadIdx.x, bid0 = blockIdx.x, G0 = gridDim.x;
#define FRESH() int tid = tid0; asm volatile("" : "+v"(tid)); int bid = bid0, G = G0; asm volatile("" : "+s"(bid), "+s"(G)); const int lane = tid & 63, wave = __builtin_amdgcn_readfirstlane(tid >> 6); (void)lane; (void)wave; (void)bid; (void)G
    const int tid = tid0;
    volatile LAS unsigned* MISC = (volatile LAS unsigned*)(lds + MISC_OFF);
    for (int u = tid; u < (LDS_BYTES - LDSCTL_OFF) / 4; u += NTHR) ((LAS unsigned*)(lds + LDSCTL_OFF))[u] = 0u;
    __syncthreads();
    int lo, hi;
    XcdBarrier bar;
    { FRESH(); KA A = ka_get(); lo = A->ph_lo; hi = A->ph_hi; gu32* ctl = (gu32*)(A->ws + WS_CTL);
      bar.bar = (unsigned*)(ctl + CW_BAR); bar.x = 0; bar.st = nullptr;
      if (!MK_PER_PHASE) bar = xcd_barrier_post((unsigned*)(ctl + CW_BAR), MISC + 8); }
#define IN(k) (lo <= (k) && (k) < hi)
#define SEAM(k) do { if (!MK_PER_PHASE && IN(k) && IN((k) + 1)) xcd_barrier(bar); } while (0)

    if (IN(0)) { FRESH(); KA A = ka_get(); p0a_phase(A, lds, tid, wave, lane, bid, G); SEAM(0); }
    if (IN(1)) { FRESH(); KA A = ka_get(); p0b_phase(A, tid, bid, G); SEAM(1); }

    for (int l = 0; l < 2; ++l) {
        const int pb = 2 + 10 * l;
        if (IN(pb + 0)) { FRESH(); KA A = ka_get(); norm_phase<false, true>(A, lds, l, 0, l ? 11 : 0, (const float*)(A->ws + WS_MODF) + 2 * ADAW + 5 * D, tid, wave, lane, bid); SEAM(pb + 0); }
        if (IN(pb + 1)) { FRESH(); KA A = ka_get(); ph_inproj(lds, A->ws, l, bid, tid); SEAM(pb + 1); }
        if (IN(pb + 2)) {
            { const int c = bid0;
              for (int k = 0; k < 5; ++k) { FRESH(); KA A = ka_get(); int ty = -1, ix = 0;
                if (c < 136) { if (k == 0) { ty = 0; ix = c; } else if (c < 32) { if (k == 1) { ty = 2; ix = 240 + c; } } else if (c < 124) { if (k < 3) { ty = 1; ix = 360 + (c - 32) * 2 + (k - 1); } } }
                else { if (k < 3) { ty = 1; ix = (c - 136) * 3 + k; } else { ty = 2; ix = (c - 136) * 2 + (k - 3); } }
                if (ty == 0) m1_mamba_group(A, lds, l, ix, tid, wave, lane);
                else if (ty == 1) m1_gla_item(A, lds, l, ix, tid, wave, lane);
                else if (ty == 2) m1_sccm_item(A, lds, l, ix, tid, wave, lane); } }
            SEAM(pb + 2);
        }
        if (IN(pb + 3)) { FRESH(); KA A = ka_get(); m2_phase(A, wave, lane, bid, G); SEAM(pb + 3); }
        if (IN(pb + 4)) {
            { const int c = bid0;
              for (int k = 0; k < 5; ++k) { FRESH(); KA A = ka_get(); int ty = -1, ix = 0;
                if (k == 0) { ty = 0; ix = c; } else if (k == 1) { ty = 0; ix = c + 256; }
                else if (k == 2) { if (c < 32) { ty = 0; ix = c + 512; } else { ty = 1; ix = c; } }
                else if (k == 3) { ty = 1; ix = c < 32 ? c : 224 + c; }
                else { if (c >= 32 && c < 96) { ty = 1; ix = 448 + c; } }
                if (ty == 0) m3_mamba_item(A, lds, l, ix, tid, wave, lane);
                else if (ty == 1) m3_gla_item(A, lds, ix, tid, wave, lane); } }
            SEAM(pb + 4);
        }
        if (IN(pb + 5)) { FRESH(); KA A = ka_get(); m4_phase(A, l, wave, lane, bid, G); SEAM(pb + 5); }
        if (IN(pb + 6)) { FRESH(); KA A = ka_get(); ph_outproj(lds, A->ws, A->in[I_X], l, bid, tid); SEAM(pb + 6); }
        if (l == 0) {
            if (IN(9)) { FRESH(); KA A = ka_get(); norm_phase<false, false>(A, lds, 0, 1, 4, (const float*)(A->ws + WS_MODF) + 2 * ADAW + 2 * D, tid, wave, lane, bid); SEAM(9); }
            if (IN(10)) { FRESH(); KA A = ka_get(); ph_ffnup(lds, A->ws, bid, tid); SEAM(10); }
            if (IN(11)) { FRESH(); KA A = ka_get(); ph_ffndn(lds, A->ws, bid, tid); SEAM(11); }
        } else {
            if (IN(19)) { FRESH(); KA A = ka_get(); norm_phase<true, false>(A, lds, 1, 1, 0, nullptr, tid, wave, lane, bid); SEAM(19); }
            if (IN(20)) { FRESH(); KA A = ka_get(); dispatch_phase(A, lds, tid, wave, lane, bid); SEAM(20); }
            if (IN(21)) { FRESH(); KA A = ka_get(); ph_moeup(lds, A->ws, bid, tid); SEAM(21); }
            if (IN(22)) { FRESH(); KA A = ka_get(); ph_moedn(lds, A->ws, bid, tid); SEAM(22); }
            if (IN(23)) { FRESH(); KA A = ka_get(); combine_phase(A, 1, wave, lane, bid, G); }
        }
    }
#undef IN
#undef SEAM
}

extern "C" void kernel_launch(void* const* d_in, const int* in_sizes, int n_in, void* d_out, int out_size, void* d_ws, size_t ws_size, hipStream_t stream) {
    static int grid = 0;
    if (grid == 0) {
        if (n_in != N_IN || out_size != BATCH * SEQ * D || ws_size < WS_END) { fprintf(stderr, "kernel_launch: unexpected shapes: n_in %d out %d ws %zu (need %zu)\n", n_in, out_size, ws_size, (size_t)WS_END); grid = -1; return; }
        int dev = 0, cus = 0, per_cu = 0;
        if (hipGetDevice(&dev) != hipSuccess || hipDeviceGetAttribute(&cus, hipDeviceAttributeMultiprocessorCount, dev) != hipSuccess) { grid = -1; return; }
        if (hipFuncSetAttribute((const void*)mk_fwd, hipFuncAttributeMaxDynamicSharedMemorySize, LDS_BYTES) != hipSuccess) { fprintf(stderr, "kernel_launch: hipFuncSetAttribute failed\n"); grid = -1; return; }
        if (hipOccupancyMaxActiveBlocksPerMultiprocessor(&per_cu, (const void*)mk_fwd, NTHR, LDS_BYTES) != hipSuccess || per_cu < 1) fprintf(stderr, "kernel_launch: occupancy query says %d\n", per_cu);
        (void)hipGetLastError();
        grid = cus;
        if (grid != 256) { fprintf(stderr, "kernel_launch: built for 256 CUs, device has %d\n", grid); grid = -1; return; }
    }
    if (grid < 0) return;
    if (hipMemsetAsync((char*)d_ws + WS_CTL, 0, CTL_ZERO_BYTES, stream) != hipSuccess) return;
    Args a{};
    for (int i = 0; i < N_IN; ++i) a.in[i] = (const float*)d_in[i];
    a.out = (float*)d_out; a.ws = (unsigned char*)d_ws;
#if MK_PER_PHASE
    for (int p = 0; p < NPH; ++p) { a.ph_lo = p; a.ph_hi = p + 1; hipLaunchKernelGGL(mk_fwd, dim3(grid), dim3(NTHR), LDS_BYTES, stream, a); }
#else
    a.ph_lo = 0; a.ph_hi = NPH; hipLaunchKernelGGL(mk_fwd, dim3(grid), dim3(NTHR), LDS_BYTES, stream, a);
#endif
    const hipError_t le = hipPeekAtLastError();
    if (le != hipSuccess) fprintf(stderr, "kernel_launch: launch failed: %s\n", hipGetErrorName(le));
}
```

```cpp
#include <hip/hip_runtime.h>
#include <cstdio>
#include <cstdint>
namespace pg8 {
#define PG8_LAS __attribute__((address_space(3)))
typedef unsigned short bf16_t;
typedef short bf16x8 __attribute__((ext_vector_type(8)));
typedef float f32x4 __attribute__((ext_vector_type(4)));
typedef unsigned u32x4 __attribute__((ext_vector_type(4)));
constexpr int BM = 256, BK = 64, HALF = 128, HTB = HALF * BK * 2  , STAGE_BYTES = 8 * HTB, NXCD = 8, WGM = 8;

__host__ __device__ __forceinline__ int lds_byte(int r, int c) { const int st = (r >> 4) * 2 + (c >> 5), rr = r & 15, cc = c & 31, ob = rr * 64 + cc * 2; return st * 1024 + (ob ^ (((ob >> 9) & 1) << 5)); }
__host__ __device__ __forceinline__ void stage_rc(int b, int& R, int& C) { const int st = b / 1024, sb = b % 1024, swz = sb ^ (((sb >> 9) & 1) << 5); R = (st >> 1) * 16 + swz / 64; C = (st & 1) * 32 + (swz % 64) / 2; }
__host__ __device__ __forceinline__ int perm32(int rho) { const int n = rho >> 4, i = rho & 15; return 8 * (i >> 2) + 4 * n + (i & 3); }

struct Unit { int pm, pn, k0, nt, dst, tt; };
struct Gemm { const bf16_t* A; const bf16_t* Bt; int M, N, K; };
struct ConvHook { int t0, t1, trig; };
template <int NSLOT, bool MOE> __device__ __forceinline__ void conv_burst(const ConvHook& h, int bid, PG8_LAS unsigned char* T, int tid);

__device__ __forceinline__ unsigned cvt_pk_bf16(float lo, float hi) { unsigned r; asm volatile("v_cvt_pk_bf16_f32 %0, %1, %2" : "=v"(r) : "v"(lo), "v"(hi)); return r; }
typedef float f32x2 __attribute__((ext_vector_type(2)));
constexpr int GRID = 256;
template <int NN, int NTF, int PPU, int PK, int XCOLS, int XPN0, bool HOOK = false>
struct MixOrder {
    int nM, c, skipctx, nx; ConvHook cv;
    __device__ bool next(int i, Unit& u) const {
        const int L = i * GRID + c, nwg = nM * NN;
        if (L >= nwg) { const int idx = L - nwg; if (idx >= nx * PPU) return false;
            const int piece = idx % PPU, un = idx / PPU; u.pm = (un / XCOLS) ? 17 : 0; u.pn = XPN0 + un % XCOLS; u.k0 = piece * PK; u.nt = PK / BK; return true; }
        int wgid = L; { const int q = nwg / NXCD, r = nwg % NXCD, xcd = wgid % NXCD, off = wgid / NXCD; wgid = (xcd < r ? xcd * (q + 1) : r * (q + 1) + (xcd - r) * q) + off; }
        const int nig = WGM * NN, gid = wgid / nig, fm = gid * WGM, gsz = (nM - fm) < WGM ? (nM - fm) : WGM;
        int pm = fm + ((wgid % nig) % gsz); u.pn = (wgid % nig) / gsz;
        if (skipctx) pm = pm + 1 + (pm >= 16 ? 1 : 0);
        u.pm = pm; u.k0 = 0; u.nt = NTF; return true;
    }
    __device__ __forceinline__ void a_ready(const Unit&) const {}
    __device__ __forceinline__ void done(const Unit&, int ui, PG8_LAS unsigned char* lds, int tid) const { if constexpr (HOOK) { if (ui == cv.trig) conv_burst<4, true>(cv, c, lds + 131072, tid); } }
};
template <int NT, int KS, int PK, int KT, bool HOOK = false>
struct MoeOrder {
    int mi[9]; int c; ConvHook cv;
    __device__ __forceinline__ MoeOrder(const int* p, int c_) : c(c_), cv{} {
#pragma unroll
        for (int j = 0; j < 9; ++j) mi[j] = __builtin_amdgcn_readfirstlane(p[j]); }
    __device__ bool next(int i, Unit& u) const {
        const int U = mi[8] * NT * KS, x = c & 7, q = U >> 3, r = U & 7;
        const int start = x * q + (x < r ? x : r), len = q + (x < r ? 1 : 0), j = c >> 3;
        int k = i * 32 + j, sub = 0, S = 1, slot = 0;
        if constexpr (KS == 2) {
            const int full = len & ~31, tl = len - full;
            if (i * 32 >= full) {
                if (i * 32 > full || tl == 0) return false;
                S = tl <= 8 ? 4 : (tl <= 16 ? 2 : 1);
                if (j >= tl * S) return false;
                const int ju = j % tl; k = full + ju; sub = j / tl; slot = x * 16 + ju; }
        } else { if (k >= len) return false; }
        const int L = start + k;
        int t0 = mi[0], t1 = mi[1], e = 0;
#pragma unroll
        for (int j = 1; j < 8; ++j) { const bool ge = L >= mi[j] * NT * KS; t0 = ge ? mi[j] : t0; t1 = ge ? mi[j + 1] : t1; e += ge ? 1 : 0; }
        const int me = t1 - t0, local = L - t0 * NT * KS;
        const int m = local % me, rest = local / me, n = rest % NT, piece = rest / NT;
        int kt0 = 0, ntk = PK / KT;
        if constexpr (KS == 2) { static_assert(PK / KT == 28, "tail split assumes 28 K-tiles per piece");
            if (S == 4) { kt0 = (sub >> 1) * 14 + (sub & 1) * 8; ntk = (sub & 1) ? 6 : 8; } else if (S == 2) { kt0 = 14 * sub; ntk = 14; } }
        u.pm = t0 + m; u.pn = e * NT + n; u.k0 = piece * PK + kt0 * KT; u.nt = ntk;
        u.dst = sub == 0 ? piece : 2 + slot * 3 + (sub - 1); u.tt = (S > 1 && sub == 0) ? ((slot << 3) | S) : 0; return true;
    }
    __device__ __forceinline__ void a_ready(const Unit&) const {}
    __device__ __forceinline__ void done(const Unit&, int ui, PG8_LAS unsigned char* lds, int tid) const { if constexpr (HOOK) { if (ui == cv.trig) conv_burst<4, true>(cv, c, lds + 131072, tid); } }
};
template <class Epi, class Sched, bool ALIGN_EPI = false, bool SP2 = false>
__device__ __forceinline__ void gemm_phase(PG8_LAS unsigned char* lds, const Gemm g, const Sched& S, const Epi& E, const int tid) {
    const int wid = __builtin_amdgcn_readfirstlane(tid >> 6), lane = tid & 63, wr = wid >> 2, wc = wid & 3, fr = lane & 15, fq = lane >> 4;
    const int K = g.K; int nt;
    unsigned voffA[2], voffB[2];
#pragma unroll
    for (int i = 0; i < 2; ++i) { int R, C; stage_rc(tid * 16 + i * 8192, R, C); const int Rb = Epi::PERM ? ((R & ~31) + perm32(R & 31)) : R;
        voffA[i] = (unsigned)(R * K + C) * 2u; voffB[i] = (unsigned)(Rb * K + C) * 2u; }
    const size_t kstep = (size_t)(BK * 2);
    const size_t hstep = (size_t)HALF * K * 2;
    const size_t tstep = 2 * hstep;
    const unsigned ldsw = (unsigned)wid * 1024u;
    const int aoff = lds_byte(wr * 64 + fr, fq * 8), boff = lds_byte(wc * 32 + fr, fq * 8);
#define PG8_SA(b, h) (((b) * 2 + (h)) * HTB)
#define PG8_SB(b, h) ((4 + (b) * 2 + (h)) * HTB)
#define PG8_STAGE(bufoff, gbase, voff) do { _Pragma("unroll") for (int _i = 0; _i < 2; ++_i) \
        __builtin_amdgcn_global_load_lds((const unsigned*)((const char*)(gbase) + (voff)[_i]), (PG8_LAS unsigned*)(lds + (bufoff) + ldsw + _i * 8192), 16, 0, 0); } while (0)
#define PG8_LDA(dst, b, h) do { _Pragma("unroll") for (int m = 0; m < 4; ++m) _Pragma("unroll") for (int k = 0; k < 2; ++k) dst[m][k] = *(const PG8_LAS bf16x8*)(lds + PG8_SA(b, h) + aoff + m * 2048 + k * 1024); } while (0)
#define PG8_LDB(dst, b, h) do { _Pragma("unroll") for (int n = 0; n < 2; ++n) _Pragma("unroll") for (int k = 0; k < 2; ++k) dst[n][k] = *(const PG8_LAS bf16x8*)(lds + PG8_SB(b, h) + boff + n * 2048 + k * 1024); } while (0)
#define PG8_MMA(ai, bj, At, Bt) do { __builtin_amdgcn_s_setprio(1); _Pragma("unroll") for (int m = 0; m < 4; ++m) _Pragma("unroll") for (int n = 0; n < 2; ++n) _Pragma("unroll") for (int k = 0; k < 2; ++k) \
        acc[ai][bj][m][n] = __builtin_amdgcn_mfma_f32_16x16x32_bf16(Bt[n][k], At[m][k], acc[ai][bj][m][n], 0, 0, 0); __builtin_amdgcn_s_setprio(0); } while (0)
#define PG8_WAIT_V(n) asm volatile("s_waitcnt vmcnt(" #n ")" ::: "memory")
#define PG8_WAIT_L(n) asm volatile("s_waitcnt lgkmcnt(" #n ")" ::: "memory")
#define PG8_BAR __builtin_amdgcn_s_barrier()
#define PG8_SCHED __builtin_amdgcn_sched_barrier(0)
    Unit cur, nxt; int ui = 0;
    if (!S.next(0, cur)) return;
    f32x4 acc[2][2][4][2];
#pragma unroll
    for (int a = 0; a < 2; ++a)
#pragma unroll
        for (int b = 0; b < 2; ++b)
#pragma unroll
            for (int m = 0; m < 4; ++m)
#pragma unroll
                for (int n = 0; n < 2; ++n) acc[a][b][m][n] = (f32x4){0.f, 0.f, 0.f, 0.f};
    bf16x8 At[4][2], B0[2][2], B1[2][2];
    const char* cA = (const char*)g.A + (size_t)cur.pm * tstep + (size_t)cur.k0 * 2; const char* cB = (const char*)g.Bt + (size_t)cur.pn * tstep + (size_t)cur.k0 * 2; nt = cur.nt;
    S.a_ready(cur);
    if constexpr (SP2) {
        PG8_STAGE(PG8_SB(0, 0), cB, voffB); PG8_STAGE(PG8_SB(0, 1), cB + hstep, voffB); PG8_STAGE(PG8_SA(0, 0), cA, voffA); PG8_STAGE(PG8_SA(0, 1), cA + hstep, voffA);
        if (wr == 1) PG8_BAR;
        PG8_WAIT_V(2); PG8_BAR;
        PG8_STAGE(PG8_SB(1, 0), cB + kstep, voffB); PG8_STAGE(PG8_SA(1, 0), cA + kstep, voffA); PG8_STAGE(PG8_SB(1, 1), cB + hstep + kstep, voffB);
        PG8_WAIT_V(6); PG8_BAR;
    } else {
        PG8_STAGE(PG8_SB(0, 0), cB, voffB); PG8_STAGE(PG8_SA(0, 0), cA, voffA); PG8_STAGE(PG8_SB(0, 1), cB + hstep, voffB); PG8_STAGE(PG8_SA(0, 1), cA + hstep, voffA);
        if (wr == 1) PG8_BAR;
        PG8_WAIT_V(4); PG8_BAR;
        PG8_STAGE(PG8_SB(1, 0), cB + kstep, voffB); PG8_STAGE(PG8_SA(1, 0), cA + kstep, voffA); PG8_STAGE(PG8_SB(1, 1), cB + hstep + kstep, voffB);
        PG8_WAIT_V(6); PG8_BAR;
    }
    for (;;) {
        const bool has_next = S.next(ui + 1, nxt);
        const char* nA = has_next ? (const char*)g.A + (size_t)nxt.pm * tstep + (size_t)nxt.k0 * 2 : cA; const char* nB = has_next ? (const char*)g.Bt + (size_t)nxt.pn * tstep + (size_t)nxt.k0 * 2 : cB;
        for (int t = 0; t < nt; t += 2) {
            const bool last = (t == nt - 2);
            const char* a1 = cA + (size_t)(t + 1) * kstep;
            const char* a2 = last ? nA : cA + (size_t)(t + 2) * kstep; const char* b2 = last ? nB : cB + (size_t)(t + 2) * kstep;
            const char* a3 = a2 + kstep; const char* b3 = b2 + kstep;
            if (last && has_next) S.a_ready(nxt);
            if constexpr (SP2) {
            PG8_LDB(B0, 0, 0); PG8_LDB(B1, 0, 1); PG8_SCHED; PG8_LDA(At, 0, 0); PG8_STAGE(PG8_SA(1, 1), a1 + hstep, voffA);
            PG8_WAIT_V(8); PG8_WAIT_L(0); PG8_BAR; PG8_MMA(0, 0, At, B0); PG8_MMA(0, 1, At, B1); PG8_BAR; PG8_SCHED;
            PG8_LDA(At, 0, 1); PG8_STAGE(PG8_SB(0, 0), b2, voffB); PG8_STAGE(PG8_SB(0, 1), b2 + hstep, voffB); PG8_STAGE(PG8_SA(0, 0), a2, voffA);
            PG8_WAIT_V(8); PG8_WAIT_L(0); PG8_BAR; PG8_MMA(1, 0, At, B0); PG8_MMA(1, 1, At, B1); PG8_BAR; PG8_SCHED;
            PG8_LDB(B0, 1, 0); PG8_LDB(B1, 1, 1); PG8_SCHED; PG8_LDA(At, 1, 0); PG8_STAGE(PG8_SA(0, 1), a2 + hstep, voffA);
            PG8_WAIT_V(8); PG8_WAIT_L(0); PG8_BAR; PG8_MMA(0, 0, At, B0); PG8_MMA(0, 1, At, B1); PG8_BAR; PG8_SCHED;
            PG8_LDA(At, 1, 1); PG8_STAGE(PG8_SB(1, 0), b3, voffB); PG8_STAGE(PG8_SB(1, 1), b3 + hstep, voffB); PG8_STAGE(PG8_SA(1, 0), a3, voffA);
            PG8_WAIT_V(8); PG8_WAIT_L(0); PG8_BAR; PG8_MMA(1, 0, At, B0); PG8_MMA(1, 1, At, B1); PG8_BAR; PG8_SCHED;
            } else {
            PG8_LDB(B0, 0, 0); PG8_SCHED; PG8_LDA(At, 0, 0); PG8_STAGE(PG8_SA(1, 1), a1 + hstep, voffA);
            PG8_WAIT_L(8); PG8_BAR; PG8_WAIT_L(0); PG8_MMA(0, 0, At, B0); PG8_BAR; PG8_SCHED;
            PG8_LDB(B1, 0, 1); PG8_STAGE(PG8_SB(0, 0), b2, voffB);
            PG8_BAR; PG8_WAIT_L(0); PG8_MMA(0, 1, At, B1); PG8_BAR;
            PG8_LDA(At, 0, 1); PG8_STAGE(PG8_SA(0, 0), a2, voffA);
            PG8_BAR; PG8_WAIT_L(0); PG8_MMA(1, 0, At, B0); PG8_BAR; PG8_SCHED;
            PG8_STAGE(PG8_SB(0, 1), b2 + hstep, voffB);
            PG8_WAIT_V(6); PG8_BAR; PG8_MMA(1, 1, At, B1); PG8_BAR;
            PG8_LDB(B0, 1, 0); PG8_SCHED; PG8_LDA(At, 1, 0); PG8_STAGE(PG8_SA(0, 1), a2 + hstep, voffA);
            PG8_WAIT_L(8); PG8_BAR; PG8_WAIT_L(0); PG8_MMA(0, 0, At, B0); PG8_BAR; PG8_SCHED;
            PG8_LDB(B1, 1, 1); PG8_STAGE(PG8_SB(1, 0), b3, voffB);
            PG8_BAR; PG8_WAIT_L(0); PG8_MMA(0, 1, At, B1); PG8_BAR;
            PG8_LDA(At, 1, 1); PG8_STAGE(PG8_SA(1, 0), a3, voffA);
            PG8_BAR; PG8_WAIT_L(0); PG8_MMA(1, 0, At, B0); PG8_BAR; PG8_SCHED;
            PG8_STAGE(PG8_SB(1, 1), b3 + hstep, voffB);
            PG8_WAIT_V(6); PG8_BAR; PG8_MMA(1, 1, At, B1); PG8_BAR;
            }
        }
        if constexpr (ALIGN_EPI) { if (wr == 0) PG8_BAR; }
        if constexpr (!Epi::AFTER_DRAIN) { E(acc, cur, wr, wc, fr, fq); S.done(cur, ui, lds, tid); }
        if (!has_next) break;
#pragma unroll
        for (int a = 0; a < 2; ++a)
#pragma unroll
            for (int b = 0; b < 2; ++b)
#pragma unroll
                for (int m = 0; m < 4; ++m)
#pragma unroll
                    for (int n = 0; n < 2; ++n) acc[a][b][m][n] = (f32x4){0.f, 0.f, 0.f, 0.f};
        cur = nxt; cA = nA; cB = nB; ++ui; nt = cur.nt;
        if constexpr (ALIGN_EPI) { if (wr == 1) PG8_BAR; }
    }
    PG8_WAIT_V(0);
    if constexpr (!ALIGN_EPI) { if (wr == 0) PG8_BAR; }
    PG8_BAR;
    if constexpr (Epi::AFTER_DRAIN) { E.fused(acc, cur, wr, wc, fr, fq, lds, wid, lane); S.done(cur, ui, lds, tid); }
#undef PG8_SA
#undef PG8_SB
#undef PG8_STAGE
#undef PG8_LDA
#undef PG8_LDB
#undef PG8_MMA
#undef PG8_WAIT_V
#undef PG8_WAIT_L
#undef PG8_BAR
#undef PG8_SCHED
}

typedef int v8i __attribute__((ext_vector_type(8)));
typedef float f32x16 __attribute__((ext_vector_type(16)));
typedef float f32x2 __attribute__((ext_vector_type(2)));
__device__ __forceinline__ v8i cat8(bf16x8 lo, bf16x8 hi) { typedef int i4v __attribute__((ext_vector_type(4))); const i4v a = __builtin_bit_cast(i4v, lo), b = __builtin_bit_cast(i4v, hi); return __builtin_shufflevector(a, b, 0, 1, 2, 3, 4, 5, 6, 7); }
__host__ __device__ __forceinline__ int f8swz(int R) { return (R >> 1) & 7; }
__host__ __device__ __forceinline__ int permf8(int rho) { return 16 * ((rho >> 2) & 1) + 4 * (rho >> 3) + (rho & 3); }
template <class Epi, class Sched, int SCW, int SCX, int SCW1 = SCW>
__device__ __forceinline__ void gemm_phase_f8(PG8_LAS unsigned char* lds, const Gemm g, const Sched& S, const Epi& E, const int tid) {
    const int wid = __builtin_amdgcn_readfirstlane(tid >> 6), lane = tid & 63, wr = wid >> 2, wc = wid & 3, r32 = lane & 31, kh = lane >> 5;
    const int K = g.K; int nt;
    unsigned voffA[2], voffB[2];
#pragma unroll
    for (int i = 0; i < 2; ++i) { const int bb = tid * 16 + i * 8192, R = bb >> 7, C = 16 * (((bb >> 4) & 7) ^ f8swz(R)); const int Rb = Epi::PERM ? ((R & ~31) + permf8(R & 31)) : R;
        voffA[i] = (unsigned)(R * K + C); voffB[i] = (unsigned)(Rb * 128 + C); }
    const size_t kstep = 128, hstep = (size_t)HALF * K, tstep = 2 * hstep, kstepB = 32768, hstepB = 16384;
    const unsigned ldsw = (unsigned)wid * 1024u;
    int aoffk[2][2], boffk[2][2];
#pragma unroll
    for (int s = 0; s < 2; ++s)
#pragma unroll
        for (int h2 = 0; h2 < 2; ++h2) { const int ch = 16 * ((4 * s + 2 * kh + h2) ^ f8swz(r32)); aoffk[s][h2] = (wr * 64 + r32) * 128 + ch; boffk[s][h2] = (wc * 32 + r32) * 128 + ch; }
#define PG8_SA(b, h) (((b) * 2 + (h)) * HTB)
#define PG8_SB(b, h) ((4 + (b) * 2 + (h)) * HTB)
#define PG8_STAGE(bufoff, gbase, voff) do { _Pragma("unroll") for (int _i = 0; _i < 2; ++_i) \
        __builtin_amdgcn_global_load_lds((const unsigned*)((const char*)(gbase) + (voff)[_i]), (PG8_LAS unsigned*)(lds + (bufoff) + ldsw + _i * 8192), 16, 0, 0); } while (0)
#define PG8_LDA(dst, b, h) do { _Pragma("unroll") for (int mb = 0; mb < 2; ++mb) _Pragma("unroll") for (int s = 0; s < 2; ++s) \
        dst[mb][s] = cat8(*(const PG8_LAS bf16x8*)(lds + PG8_SA(b, h) + aoffk[s][0] + mb * 4096), *(const PG8_LAS bf16x8*)(lds + PG8_SA(b, h) + aoffk[s][1] + mb * 4096)); } while (0)
#define PG8_LDB(dst, b, h) do { _Pragma("unroll") for (int s = 0; s < 2; ++s) \
        dst[s] = cat8(*(const PG8_LAS bf16x8*)(lds + PG8_SB(b, h) + boffk[s][0]), *(const PG8_LAS bf16x8*)(lds + PG8_SB(b, h) + boffk[s][1])); } while (0)
#define PG8_MMA(ai, bj, At, Bt) do { __builtin_amdgcn_s_setprio(1); _Pragma("unroll") for (int mb = 0; mb < 2; ++mb) _Pragma("unroll") for (int s = 0; s < 2; ++s) \
        acc[ai][bj][mb] = __builtin_amdgcn_mfma_scale_f32_32x32x64_f8f6f4(Bt[s], At[mb][s], acc[ai][bj][mb], 0, 0, 0, (bj) ? SCW1 : SCW, 0, SCX); __builtin_amdgcn_s_setprio(0); } while (0)
#define PG8_WAIT_V(n) asm volatile("s_waitcnt vmcnt(" #n ")" ::: "memory")
#define PG8_WAIT_L(n) asm volatile("s_waitcnt lgkmcnt(" #n ")" ::: "memory")
#define PG8_BAR __builtin_amdgcn_s_barrier()
#define PG8_SCHED __builtin_amdgcn_sched_barrier(0)
#define PG8_ZERO() do { _Pragma("unroll") for (int a = 0; a < 2; ++a) _Pragma("unroll") for (int b = 0; b < 2; ++b) _Pragma("unroll") for (int m = 0; m < 2; ++m) _Pragma("unroll") for (int e = 0; e < 16; ++e) acc[a][b][m][e] = 0.f; } while (0)
    Unit cur, nxt; int ui = 0;
    if (!S.next(0, cur)) return;
    f32x16 acc[2][2][2]; PG8_ZERO();
    v8i At[2][2], B0[2], B1[2];
    const char* cA = (const char*)g.A + (size_t)cur.pm * tstep + (size_t)cur.k0; const char* cB = (const char*)g.Bt + (size_t)cur.pn * tstep + (size_t)cur.k0 * 256; nt = cur.nt;
    S.a_ready(cur);
    PG8_STAGE(PG8_SB(0, 0), cB, voffB); PG8_STAGE(PG8_SB(0, 1), cB + hstepB, voffB); PG8_STAGE(PG8_SA(0, 0), cA, voffA); PG8_STAGE(PG8_SA(0, 1), cA + hstep, voffA);
    if (wr == 1) PG8_BAR;
    PG8_WAIT_V(2); PG8_BAR;
    PG8_STAGE(PG8_SB(1, 0), cB + kstepB, voffB); PG8_STAGE(PG8_SA(1, 0), cA + kstep, voffA); PG8_STAGE(PG8_SB(1, 1), cB + hstepB + kstepB, voffB);
    PG8_WAIT_V(6); PG8_BAR;
    for (;;) {
        const bool has_next = S.next(ui + 1, nxt);
        const char* nA = has_next ? (const char*)g.A + (size_t)nxt.pm * tstep + (size_t)nxt.k0 : cA; const char* nB = has_next ? (const char*)g.Bt + (size_t)nxt.pn * tstep + (size_t)nxt.k0 * 256 : cB;
        for (int t = 0; t < nt; t += 2) {
            const bool last = (t == nt - 2);
            const char* a1 = cA + (size_t)(t + 1) * kstep;
            const char* a2 = last ? nA : cA + (size_t)(t + 2) * kstep; const char* b2 = last ? nB : cB + (size_t)(t + 2) * kstepB;
            const char* a3 = a2 + kstep; const char* b3 = b2 + kstepB;
            if (last && has_next) S.a_ready(nxt);
            PG8_LDB(B0, 0, 0); PG8_LDB(B1, 0, 1); PG8_SCHED; PG8_LDA(At, 0, 0); PG8_STAGE(PG8_SA(1, 1), a1 + hstep, voffA);
            PG8_WAIT_V(8); PG8_WAIT_L(0); PG8_BAR; PG8_MMA(0, 0, At, B0); PG8_MMA(0, 1, At, B1); PG8_BAR; PG8_SCHED;
            PG8_LDA(At, 0, 1); PG8_STAGE(PG8_SB(0, 0), b2, voffB); PG8_STAGE(PG8_SB(0, 1), b2 + hstepB, voffB); PG8_STAGE(PG8_SA(0, 0), a2, voffA);
            PG8_WAIT_V(8); PG8_WAIT_L(0); PG8_BAR; PG8_MMA(1, 0, At, B0); PG8_MMA(1, 1, At, B1); PG8_BAR; PG8_SCHED;
            PG8_LDB(B0, 1, 0); PG8_LDB(B1, 1, 1); PG8_SCHED; PG8_LDA(At, 1, 0); PG8_STAGE(PG8_SA(0, 1), a2 + hstep, voffA);
            PG8_WAIT_V(8); PG8_WAIT_L(0); PG8_BAR; PG8_MMA(0, 0, At, B0); PG8_MMA(0, 1, At, B1); PG8_BAR; PG8_SCHED;
            PG8_LDA(At, 1, 1); PG8_STAGE(PG8_SB(1, 0), b3, voffB); PG8_STAGE(PG8_SB(1, 1), b3 + hstepB, voffB); PG8_STAGE(PG8_SA(1, 0), a3, voffA);
            PG8_WAIT_V(8); PG8_WAIT_L(0); PG8_BAR; PG8_MMA(1, 0, At, B0); PG8_MMA(1, 1, At, B1); PG8_BAR; PG8_SCHED;
        }
        if (wr == 0) PG8_BAR;
        E(acc, cur, wr, wc, r32, kh); S.done(cur, ui, lds, tid);
        if (!has_next) break;
        PG8_ZERO();
        cur = nxt; cA = nA; cB = nB; ++ui; nt = cur.nt;
        if (wr == 1) PG8_BAR;
    }
    PG8_WAIT_V(0);
    PG8_BAR;
#undef PG8_SA
#undef PG8_SB
#undef PG8_STAGE
#undef PG8_LDA
#undef PG8_LDB
#undef PG8_MMA
#undef PG8_WAIT_V
#undef PG8_WAIT_L
#undef PG8_BAR
#undef PG8_SCHED
#undef PG8_ZERO
}
}

constexpr int NWAVES = 8, NTHR = 512;
constexpr int D = 2048, BATCH = 2, SEQ = 4096, CTXL = 256, TB = CTXL + SEQ  , MR = BATCH * TB  ;
constexpr int NMT = MR / 256;
constexpr int PSRC = 5680, NP = 5632, NSM = 48;
constexpr int FF = 5632, FFE = 7168, NE = 8;
constexpr int NMOD = 6, ADAW = NMOD * D;
constexpr int MOE_TILES = 72, MOE_ROWS = MOE_TILES * 256;
constexpr float EPS = 1e-6f;
constexpr int C_BG = 0, C_CG = 512, C_XA = 1024, C_CMU = 1536, C_CMV = 2048, C_Z = 2560, C_XS = 3072, C_BM = 3584, C_CM = 3840, C_Q = 4096, C_K = 4352, C_V = 4608, C_G = 5120;
constexpr int NCH_M = TB / 128  , NCH_G = TB / 64  ;

constexpr size_t MiB = 1u << 20;
constexpr size_t WS_CTL = 0, CTL_ZERO_BYTES = 1 * MiB;
constexpr size_t WS_MODF = 1 * MiB;
constexpr size_t WS_ADAP = 2 * MiB;
constexpr size_t WS_ALAST = 12 * MiB;
constexpr size_t WS_GLAST = 12 * MiB + 65536;
constexpr size_t WS_EA = 13 * MiB;
constexpr size_t WS_ROUTE = 14 * MiB;
constexpr size_t WS_CNT = 14 * MiB + 512 * 1024;
constexpr size_t WS_TOKPOS = 14 * MiB + 768 * 1024;
constexpr size_t WS_MOEINFO = 15 * MiB;
constexpr size_t WS_WSM = 15 * MiB + 65536;
constexpr size_t WS_PS = 1012 * MiB;
constexpr size_t WS_PART = 1579 * MiB;
constexpr size_t WS_DOUT2 = 918 * MiB;
constexpr size_t WS_WIN = 16 * MiB;
constexpr size_t WS_WOUT = 62 * MiB;
constexpr size_t WS_FUP = 78 * MiB;
constexpr size_t WS_FDN = 122 * MiB;
constexpr size_t WS_MUP = 144 * MiB;
constexpr size_t WS_MDN = 592 * MiB;
constexpr size_t WS_H = 816 * MiB;
constexpr size_t WS_XN = 884 * MiB;
constexpr size_t WS_P = 918 * MiB;
constexpr size_t WS_YMIX = 1016 * MiB;
constexpr size_t WS_YMB = 1050 * MiB;
constexpr size_t WS_YGLA = 1067 * MiB;
constexpr size_t WS_CSM = 1084 * MiB;
constexpr size_t WS_CSG = 1118 * MiB;
constexpr size_t WS_QE = 1152 * MiB;
constexpr size_t WS_ACT = 1161 * MiB;
constexpr size_t WS_APERM = 1255 * MiB;
constexpr size_t WS_ACTM = 1327 * MiB;
constexpr size_t WS_DOUT = 1579 * MiB;
constexpr size_t WS_END = 1723 * MiB;
constexpr size_t WS_SSM = 1161 * MiB, WS_SSG = 1180 * MiB;
constexpr size_t WS_XT = 1016 * MiB;
constexpr size_t WS_TT = WS_CTL + 512 * 1024;
static_assert(WS_WIN + (size_t)2 * NP * D * 2 <= WS_WOUT && WS_WOUT + (size_t)2 * D * D * 2 <= WS_FUP && WS_FUP + (size_t)2 * FF * D * 2 <= WS_FDN && WS_FDN + (size_t)D * FF * 2 <= WS_MUP, "ws map 1");
static_assert(WS_MUP + (size_t)NE * 2 * FFE * D * 2 <= WS_MDN && WS_MDN + (size_t)NE * D * FFE * 2 <= WS_H && WS_H + (size_t)MR * D * 4 <= WS_XN && WS_XN + (size_t)MR * D * 2 <= WS_P, "ws map 2");
static_assert(WS_P + (size_t)MR * NP * 2 <= WS_YMIX && WS_YMIX + (size_t)MR * D * 2 <= WS_YMB && WS_YMB + (size_t)MR * 512 * 4 <= WS_YGLA && WS_YGLA + (size_t)MR * 512 * 4 <= WS_CSM, "ws map 3");
static_assert(WS_CSM + (size_t)BATCH * NCH_M * 2 * 8 * 64 * 128 * 4 <= WS_CSG && WS_CSG + (size_t)BATCH * NCH_G * 2 * 4 * 64 * 128 * 4 <= WS_QE && WS_QE + (size_t)MR * 512 * 2 <= WS_ACT && WS_ACT + (size_t)MR * FF * 2 <= WS_APERM, "ws map 4");
static_assert(WS_APERM + (size_t)MOE_ROWS * D * 2 <= WS_ACTM && WS_ACTM + (size_t)MOE_ROWS * FFE * 2 <= WS_DOUT && WS_DOUT + (size_t)MOE_ROWS * D * 4 <= WS_END, "ws map 5");
static_assert(WS_ADAP + (size_t)2 * 32 * 3 * ADAW * 4 <= WS_ALAST && WS_GLAST + (size_t)BATCH * NCH_G * 2 * 4 * 64 * 4 <= WS_EA && WS_EA + (size_t)MR * 16 * 4 <= WS_ROUTE && WS_ROUTE + (size_t)MR * 16 <= WS_CNT, "ws map 6");
constexpr int CW_TMO = 0, CW_BAR = 4096;

constexpr int RING_OFF = 0, RING_BYTES = 131072;
constexpr int CONV_OFF = RING_BYTES, CONV_BYTES = 16384;
constexpr int LDSCTL_OFF = CONV_OFF + CONV_BYTES, MISC_OFF = LDSCTL_OFF + 320;
constexpr int LDS_BYTES = 163840;

enum { I_X = 0, I_C, I_CTX, I_CCTX, I_WADA, I_BADA, I_GMIX, I_GFFN, I_WIN, I_WOUT, I_SCW, I_CMW, I_CMB, I_MBCW, I_MBCB, I_MBALOG, I_MBDTB, I_MBD, I_MBNG, I_GLAWG, I_GLABG, I_GLANG,
       I_FWG, I_FWU, I_FWD, I_MROUTER, I_MWG, I_MWU, I_MWD, I_GFINAL, N_IN };
#define GAS __attribute__((address_space(1)))
#define LAS __attribute__((address_space(3)))
typedef unsigned short bf16;
typedef unsigned v4u __attribute__((ext_vector_type(4)));
typedef float f32x4 __attribute__((ext_vector_type(4)));
typedef short bf16x8 __attribute__((ext_vector_type(8)));
typedef GAS unsigned gu32;
typedef GAS unsigned long long gu64;
#define RLX_AGENT __ATOMIC_RELAXED, __HIP_MEMORY_SCOPE_AGENT
#define LDS_WAIT() asm volatile("s_waitcnt lgkmcnt(0)" ::: "memory")
#define VM_WAIT() asm volatile("s_waitcnt vmcnt(0)" ::: "memory")
__device__ __forceinline__ unsigned long long rt() { return __builtin_amdgcn_s_memrealtime(); }
__device__ __forceinline__ unsigned f2bf(float f) { unsigned u = __builtin_bit_cast(unsigned, f); return (u + 0x7fffu + ((u >> 16) & 1u)) >> 16; }
__device__ __forceinline__ unsigned pk2(float lo, float hi) { return f2bf(lo) | (f2bf(hi) << 16); }

#define XB_TMO      128
#define XB_XCNT(j)  (256  + 64 * (j))
#define XB_XSUB(j)  (1280 + 64 * (j))
#define XB_XGEN(j)  (2304 + 64 * (j))
#define XB_TOP      3328
#define XB_TOPGEN   3392
#define XCD_BAR_WORDS 3456
#define XB_SPIN_CAP (1u << 18)

__device__ __forceinline__ unsigned xb_ld(unsigned* p)              { return __hip_atomic_load(p, __ATOMIC_RELAXED, __HIP_MEMORY_SCOPE_AGENT); }
__device__ __forceinline__ unsigned xb_add(unsigned* p, unsigned v) { return __hip_atomic_fetch_add(p, v, __ATOMIC_RELAXED, __HIP_MEMORY_SCOPE_AGENT); }
__device__ __forceinline__ unsigned xb_xcc_id() { return (unsigned)__builtin_amdgcn_s_getreg((3 << 11) | 20) & 0xFu; }
#define XB_SPIN(cond, bar) do { unsigned _sp = 0; while (cond) { __builtin_amdgcn_s_sleep(1); \
    if ((++_sp & 255u) == 0u) { if (xb_ld(&(bar)[XB_TMO])) break; if (_sp > XB_SPIN_CAP) { atomicAdd(&(bar)[XB_TMO], 1u); break; } } } } while (0)

struct XcdBarrier {
    unsigned* bar; unsigned x;
    volatile LAS unsigned* st;
};

__device__ __forceinline__ XcdBarrier xcd_barrier_post(unsigned* bar, volatile LAS unsigned* st) {
    XcdBarrier b; b.bar = bar; b.x = xb_xcc_id(); b.st = st;
    if (threadIdx.x == 0) (void)xb_add(&bar[XB_XCNT(b.x)], 1u);
    return b;
}
__device__ __forceinline__ void xcd_barrier_complete(unsigned* bar, unsigned x, unsigned& nloc, unsigned& nx) {
    const unsigned G = gridDim.x * gridDim.y * gridDim.z;
    unsigned sum, cnt, mine, sp = 0u;
    for (;;) {
        sum = 0u; cnt = 0u; mine = 0u;
#pragma unroll
        for (unsigned j = 0; j < 16; ++j) { const unsigned c = xb_ld(&bar[XB_XCNT(j)]); sum += c; cnt += (c > 0u) ? 1u : 0u; mine = (j == x) ? c : mine; }
        if (sum == G) break;
        __builtin_amdgcn_s_sleep(1);
        if ((++sp & 255u) == 0u) { if (xb_ld(&bar[XB_TMO])) break; if (sp > XB_SPIN_CAP) { atomicAdd(&bar[XB_TMO], 1u); break; } }
    }
    nloc = mine > 0u ? mine : 1u; nx = cnt > 0u ? cnt : 1u;
}

__device__ __forceinline__ void xcd_barrier(const XcdBarrier& b) {
    asm volatile("s_waitcnt vmcnt(0)" ::: "memory");
    __syncthreads();
    if (threadIdx.x == 0) {
        unsigned* bar = b.bar;
        __builtin_amdgcn_s_waitcnt(0);
        unsigned nloc = b.st[0], nx = b.st[1];
        if (nloc == 0u) { xcd_barrier_complete(bar, b.x, nloc, nx); b.st[0] = nloc; b.st[1] = nx; }
        const unsigned old = xb_add(&bar[XB_XSUB(b.x)], 1u);
        const unsigned gen = old / nloc;
        if (old + 1u == (gen + 1u) * nloc) {
            __builtin_amdgcn_fence(__ATOMIC_RELEASE, "agent");
            asm volatile("s_waitcnt vmcnt(0)" ::: "memory");
            const unsigned og = xb_add(&bar[XB_TOP], 1u);
            const unsigned tg = og / nx;
            if (og + 1u == (tg + 1u) * nx) xb_add(&bar[XB_TOPGEN], 1u);
            else XB_SPIN(xb_ld(&bar[XB_TOPGEN]) == tg, bar);
            __builtin_amdgcn_fence(__ATOMIC_ACQUIRE, "agent");
            xb_add(&bar[XB_XGEN(b.x)], 1u);
            asm volatile("s_waitcnt vmcnt(0)" ::: "memory");
        } else {
            XB_SPIN(xb_ld(&bar[XB_XGEN(b.x)]) == gen, bar);
            __builtin_amdgcn_fence(__ATOMIC_ACQUIRE, "agent");
            asm volatile("s_waitcnt vmcnt(0)" ::: "memory");
        }
    }
    __syncthreads();
}

struct Args { const float* in[N_IN]; float* out; unsigned char* ws; int ph_lo, ph_hi; };
typedef LAS unsigned short lbf16;
typedef const __attribute__((address_space(4))) Args* KA;
__device__ __forceinline__ KA ka_get() { KA p = (KA)__builtin_amdgcn_kernarg_segment_ptr(); asm volatile("" : "+s"(p)); return p; }
__device__ __forceinline__ float bf2f(unsigned short v) { return __uint_as_float((unsigned)v << 16); }
__device__ __forceinline__ void unpack8(const v4u v, float (&f)[8]) {
    f[0] = __uint_as_float(v.x << 16); f[1] = __uint_as_float(v.x & 0xffff0000u); f[2] = __uint_as_float(v.y << 16); f[3] = __uint_as_float(v.y & 0xffff0000u);
    f[4] = __uint_as_float(v.z << 16); f[5] = __uint_as_float(v.z & 0xffff0000u); f[6] = __uint_as_float(v.w << 16); f[7] = __uint_as_float(v.w & 0xffff0000u); }
__device__ __forceinline__ v4u pack8(const float (&f)[8]) { v4u o; o.x = pg8::cvt_pk_bf16(f[0], f[1]); o.y = pg8::cvt_pk_bf16(f[2], f[3]); o.z = pg8::cvt_pk_bf16(f[4], f[5]); o.w = pg8::cvt_pk_bf16(f[6], f[7]); return o; }
__device__ __forceinline__ float silu_f(float x) { return x * __builtin_amdgcn_rcpf(1.f + __expf(-x)); }
__device__ __forceinline__ float softplus_f(float x) { return x > 20.f ? x : log1pf(__expf(x)); }
__device__ __forceinline__ float logsig_f(float x) { return fminf(x, 0.f) - __logf(1.f + __expf(-fabsf(x))); }
__device__ __forceinline__ float gelu_tanh(float x) { const float u = 0.7978845608028654f * (x + 0.044715f * x * x * x); const float t = 1.f - 2.f * __builtin_amdgcn_rcpf(1.f + __expf(2.f * u)); return 0.5f * x * (1.f + t); }
template <int CTRL, int ROWMASK> __device__ __forceinline__ float dpp_f(float v) { return __int_as_float(__builtin_amdgcn_update_dpp(0, __float_as_int(v), CTRL, ROWMASK, 0xF, false)); }
__device__ __forceinline__ float row16_sum(float v) { v += dpp_f<0xB1, 0xF>(v); v += dpp_f<0x4E, 0xF>(v); v += dpp_f<0x141, 0xF>(v); v += dpp_f<0x140, 0xF>(v); return v; }
__device__ __forceinline__ float wave_sum(float v) {
    v = row16_sum(v); v += dpp_f<0x142, 0xA>(v); v += dpp_f<0x143, 0xC>(v);
    return __int_as_float(__builtin_amdgcn_readlane(__float_as_int(v), 63));
}
__device__ __forceinline__ float half_sum(float v, int lane) {
    v = row16_sum(v); v += dpp_f<0x142, 0xA>(v);
    const float lo = __int_as_float(__builtin_amdgcn_readlane(__float_as_int(v), 31)), hi = __int_as_float(__builtin_amdgcn_readlane(__float_as_int(v), 63)); return lane < 32 ? lo : hi;
}
struct Acc32 { f32x4 v[2][2]; };
__device__ __forceinline__ void acc_zero(Acc32& a) { a.v[0][0] = a.v[0][1] = a.v[1][0] = a.v[1][1] = (f32x4){0.f, 0.f, 0.f, 0.f}; }
template <int MASK> __device__ __forceinline__ int tswz(int row, int col) { return (((col >> 3) ^ ((row >> 3) & MASK)) << 3) | (col & 7); }
template <int MA = -1, int MB = -1>
__device__ __forceinline__ void wave_mma32(Acc32& acc, const lbf16* A, int lda, const lbf16* Bt, int ldb, int m0, int n0, int K, int lane) {
    const int l16 = lane & 15, q = lane >> 4;
    const lbf16* a0 = A + (m0 + l16) * lda; const lbf16* a1 = a0 + 16 * lda;
    const lbf16* b0 = Bt + (n0 + l16) * ldb; const lbf16* b1 = b0 + 16 * ldb;
    const int fa0 = MA >= 0 ? ((m0 + l16) >> 3) & MA : 0, fa1 = MA >= 0 ? ((m0 + l16 + 16) >> 3) & MA : 0, fb0 = MB >= 0 ? ((n0 + l16) >> 3) & MB : 0, fb1 = MB >= 0 ? ((n0 + l16 + 16) >> 3) & MB : 0;
    for (int k = 0; k < K; k += 32) { const int c = (k >> 3) + q;
        const bf16x8 fa0v = *(const LAS bf16x8*)(a0 + 8 * (c ^ fa0)), fa1v = *(const LAS bf16x8*)(a1 + 8 * (c ^ fa1)), fb0v = *(const LAS bf16x8*)(b0 + 8 * (c ^ fb0)), fb1v = *(const LAS bf16x8*)(b1 + 8 * (c ^ fb1));
        acc.v[0][0] = __builtin_amdgcn_mfma_f32_16x16x32_bf16(fa0v, fb0v, acc.v[0][0], 0, 0, 0);
        acc.v[0][1] = __builtin_amdgcn_mfma_f32_16x16x32_bf16(fa0v, fb1v, acc.v[0][1], 0, 0, 0);
        acc.v[1][0] = __builtin_amdgcn_mfma_f32_16x16x32_bf16(fa1v, fb0v, acc.v[1][0], 0, 0, 0);
        acc.v[1][1] = __builtin_amdgcn_mfma_f32_16x16x32_bf16(fa1v, fb1v, acc.v[1][1], 0, 0, 0);
    }
}

__device__ __forceinline__ unsigned pk4_fp8(float a, float b, float c, float d) {
    a = __builtin_amdgcn_fmed3f(a, -448.f, 448.f); b = __builtin_amdgcn_fmed3f(b, -448.f, 448.f); c = __builtin_amdgcn_fmed3f(c, -448.f, 448.f); d = __builtin_amdgcn_fmed3f(d, -448.f, 448.f);
    int w = 0; w = __builtin_amdgcn_cvt_pk_fp8_f32(a, b, w, false); w = __builtin_amdgcn_cvt_pk_fp8_f32(c, d, w, true); return (unsigned)w; }
constexpr float XN8_SCALE = 16.f, ACT8_SCALE = 4.f, W8_SCALE = 64.f;
constexpr int SC_W8UP = 0x7b7b7b7b  , SC_W8 = 0x79797979  , SC_XN8 = 0x7b7b7b7b  , SC_ACT8 = 0x7d7d7d7d  ;
namespace pg8 {
struct EpiP {
    static constexpr bool PERM = true, AFTER_DRAIN = false; unsigned char* ws;
    __device__ __forceinline__ void operator()(const f32x4 (&acc)[2][2][4][2], const Unit& u, int wr, int wc, int fr, int fq) const {
        bf16_t* O = (bf16_t*)(ws + WS_P); const int row0 = u.pm * BM + wr * 64 + fr, col0 = u.pn * BM + wc * 32 + 8 * fq;
#pragma unroll
        for (int ai = 0; ai < 2; ++ai)
#pragma unroll
            for (int m = 0; m < 4; ++m) { bf16_t* rowp = O + (size_t)(row0 + ai * HALF + m * 16) * NP + col0;
#pragma unroll
                for (int bj = 0; bj < 2; ++bj) { const f32x4 v0 = acc[ai][bj][m][0], v1 = acc[ai][bj][m][1];
                    u32x4 w; w.x = cvt_pk_bf16(v0[0], v0[1]); w.y = cvt_pk_bf16(v0[2], v0[3]); w.z = cvt_pk_bf16(v1[0], v1[1]); w.w = cvt_pk_bf16(v1[2], v1[3]);
                    *(u32x4*)(rowp + bj * HALF) = w; } }
    }
};
struct EpiRes {
    static constexpr bool PERM = false, AFTER_DRAIN = false;
    unsigned char* ws; const float* x; int l; int gate_idx;
    __device__ __forceinline__ void operator()(const f32x4 (&acc)[2][2][4][2], const Unit& u, int wr, int wc, int fr, int fq) const {
        const int b = u.pm / 17, j = u.pm % 17;
        const int col0 = u.pn * BM + wc * 32 + 4 * fq;
        if (j == 0) {
            float* out = (float*)(ws + WS_PART) + ((size_t)(u.k0 >> 9) * 512 + b * 256) * D + col0;
#pragma unroll
            for (int ai = 0; ai < 2; ++ai)
#pragma unroll
                for (int m = 0; m < 4; ++m) { int r = wr * 64 + fr + ai * HALF + m * 16; asm volatile("" : "+v"(r)); float* o = out + (size_t)(unsigned)(r * D);
#pragma unroll
                    for (int bj = 0; bj < 2; ++bj)
#pragma unroll
                        for (int n = 0; n < 2; ++n) *(f32x4*)(o + bj * HALF + n * 16) = acc[ai][bj][m][n];
                    asm volatile("" ::: "memory"); }
            return; }
        const float* base = x ? x + (size_t)(b * SEQ + (j - 1) * 256) * D : nullptr;
        bf16_t* out = (bf16_t*)(ws + WS_H) + (size_t)u.pm * 256 * D;
        const float* gate = (const float*)(ws + WS_MODF) + ((size_t)l * 3 + b) * ADAW + gate_idx * D + col0;
        f32x4 gv[2][2];
#pragma unroll
        for (int bj = 0; bj < 2; ++bj)
#pragma unroll
            for (int n = 0; n < 2; ++n) gv[bj][n] = *(const f32x4*)(gate + bj * HALF + n * 16);
#pragma unroll
        for (int ai = 0; ai < 2; ++ai)
#pragma unroll
            for (int m = 0; m < 4; ++m) { int r = wr * 64 + fr + ai * HALF + m * 16; asm volatile("" : "+v"(r)); const unsigned off = (unsigned)(r * D) + col0;
                f32x4 bs[2][2];
                if (base) {
#pragma unroll
                    for (int bj = 0; bj < 2; ++bj)
#pragma unroll
                        for (int n = 0; n < 2; ++n) bs[bj][n] = *(const f32x4*)(base + off + bj * HALF + n * 16);
                } else {
#pragma unroll
                    for (int bj = 0; bj < 2; ++bj)
#pragma unroll
                        for (int n = 0; n < 2; ++n) { const unsigned long long q = *(const unsigned long long*)(out + off + bj * HALF + n * 16);
                            bs[bj][n] = (f32x4){__uint_as_float((unsigned)q << 16), __uint_as_float((unsigned)q & 0xffff0000u), __uint_as_float((unsigned)(q >> 32) << 16), __uint_as_float((unsigned)(q >> 32) & 0xffff0000u)}; }
                }
#pragma unroll
                for (int bj = 0; bj < 2; ++bj)
#pragma unroll
                    for (int n = 0; n < 2; ++n) { const f32x4 r4 = bs[bj][n] + gv[bj][n] * acc[ai][bj][m][n];
                        *(unsigned long long*)(out + off + bj * HALF + n * 16) = (unsigned long long)cvt_pk_bf16(r4[0], r4[1]) | ((unsigned long long)cvt_pk_bf16(r4[2], r4[3]) << 32); }
                asm volatile("" ::: "memory"); }
    }
};
struct EpiSwiglu {
    static constexpr bool PERM = true, AFTER_DRAIN = false; bf16_t* O; int ldc; int nt;
    __device__ __forceinline__ void operator()(const f32x4 (&acc)[2][2][4][2], const Unit& u, int wr, int wc, int fr, int fq) const {
        const int pl = u.pn % nt; const int row0 = u.pm * BM + wr * 64 + fr, col0 = pl * HALF + wc * 32 + 8 * fq;
#pragma unroll
        for (int ai = 0; ai < 2; ++ai)
#pragma unroll
            for (int m = 0; m < 4; ++m) { bf16_t* rowp = O + (size_t)(row0 + ai * HALF + m * 16) * ldc + col0;
                float a[8];
#pragma unroll
                for (int n = 0; n < 2; ++n)
#pragma unroll
                    for (int e = 0; e < 4; e += 2) { typedef float f32x2 __attribute__((ext_vector_type(2)));
                        const f32x2 g = {acc[ai][0][m][n][e], acc[ai][0][m][n][e + 1]}, up = {acc[ai][1][m][n][e], acc[ai][1][m][n][e + 1]};
                        const f32x2 x = g * (f32x2){-1.44269504f, -1.44269504f};
                        const f32x2 d = (f32x2){__builtin_amdgcn_exp2f(x.x), __builtin_amdgcn_exp2f(x.y)} + (f32x2){1.f, 1.f};
                        const f32x2 o = (g * up) * (f32x2){__builtin_amdgcn_rcpf(d.x), __builtin_amdgcn_rcpf(d.y)};
                        a[4 * n + e] = o.x; a[4 * n + e + 1] = o.y; }
                u32x4 w; w.x = cvt_pk_bf16(a[0], a[1]); w.y = cvt_pk_bf16(a[2], a[3]); w.z = cvt_pk_bf16(a[4], a[5]); w.w = cvt_pk_bf16(a[6], a[7]);
                *(u32x4*)rowp = w; }
    }
};
struct EpiSwiglu8 {
    static constexpr bool PERM = true; unsigned char* O; int ldc; int nt;
    __device__ __forceinline__ void operator()(const f32x16 (&acc)[2][2][2], const Unit& u, int wr, int wc, int c32, int h) const {
        const int pl = u.pn % nt; const int row0 = u.pm * BM + wr * 64 + c32, col0 = pl * HALF + wc * 32 + 16 * h;
#pragma unroll
        for (int ai = 0; ai < 2; ++ai)
#pragma unroll
            for (int mb = 0; mb < 2; ++mb) { unsigned char* rowp = O + (size_t)(row0 + ai * HALF + mb * 32) * ldc + col0;
                float a[16];
#pragma unroll
                for (int r = 0; r < 16; r += 2) {
                    const f32x2 g = {acc[ai][0][mb][r], acc[ai][0][mb][r + 1]}, up = {acc[ai][1][mb][r], acc[ai][1][mb][r + 1]};
                    const f32x2 x = g * (f32x2){-1.44269504f, -1.44269504f};
                    const f32x2 d = (f32x2){__builtin_amdgcn_exp2f(x.x), __builtin_amdgcn_exp2f(x.y)} + (f32x2){1.f, 1.f};
                    const f32x2 o = (g * up) * (f32x2){__builtin_amdgcn_rcpf(d.x), __builtin_amdgcn_rcpf(d.y)};
                    a[r] = o.x; a[r + 1] = o.y; }
                u32x4 w; w.x = pk4_fp8(a[0], a[1], a[2], a[3]); w.y = pk4_fp8(a[4], a[5], a[6], a[7]); w.z = pk4_fp8(a[8], a[9], a[10], a[11]); w.w = pk4_fp8(a[12], a[13], a[14], a[15]);
                *(u32x4*)rowp = w; }
    }
};
struct EpiBf16g8 {
    static constexpr bool PERM = true; bf16_t* C0; bf16_t* C1; bf16_t* XT; int* TT; int ldc; int nt;
    __device__ __forceinline__ void operator()(const f32x16 (&acc)[2][2][2], const Unit& u, int wr, int wc, int c32, int h) const {
        const int pl = u.pn % nt; const bool tail = u.dst >= 2;
        const int row0 = (tail ? 0 : u.pm * BM) + wr * 64 + c32, col0 = (tail ? 0 : pl * BM) + wc * 32 + 16 * h, ld = tail ? 256 : ldc;
        bf16_t* C = tail ? XT + (size_t)(u.dst - 2) * 65536 : (u.dst ? C1 : C0);
        if (u.tt != 0 && (wr | wc | c32 | h) == 0) TT[(u.pm * 8 + pl) * 2 + u.dst] = u.tt;
#pragma unroll
        for (int ai = 0; ai < 2; ++ai)
#pragma unroll
            for (int mb = 0; mb < 2; ++mb) { bf16_t* rowp = C + (size_t)(row0 + ai * HALF + mb * 32) * ld + col0;
#pragma unroll
                for (int bj = 0; bj < 2; ++bj) { const f32x16 w = acc[ai][bj][mb]; u32x4 lo, hi;
                    lo.x = cvt_pk_bf16(w[0], w[1]); lo.y = cvt_pk_bf16(w[2], w[3]); lo.z = cvt_pk_bf16(w[4], w[5]); lo.w = cvt_pk_bf16(w[6], w[7]);
                    hi.x = cvt_pk_bf16(w[8], w[9]); hi.y = cvt_pk_bf16(w[10], w[11]); hi.z = cvt_pk_bf16(w[12], w[13]); hi.w = cvt_pk_bf16(w[14], w[15]);
                    *(u32x4*)(rowp + bj * HALF) = lo; *(u32x4*)(rowp + bj * HALF + 8) = hi; } }
    }
};
struct EpiF32g8 {
    static constexpr bool PERM = false; float* C0; float* C1; int ldc; int nt;
    __device__ __forceinline__ void operator()(const f32x16 (&acc)[2][2][2], const Unit& u, int wr, int wc, int c32, int h) const {
        const int pl = u.pn % nt; const int row0 = u.pm * BM + wr * 64 + c32, col0 = pl * BM + wc * 32 + 4 * h; float* C = u.k0 ? C1 : C0;
#pragma unroll
        for (int ai = 0; ai < 2; ++ai)
#pragma unroll
            for (int mb = 0; mb < 2; ++mb) { float* rowp = C + (size_t)(row0 + ai * HALF + mb * 32) * ldc + col0;
#pragma unroll
                for (int bj = 0; bj < 2; ++bj)
#pragma unroll
                    for (int gq = 0; gq < 4; ++gq) { const f32x16 w = acc[ai][bj][mb]; *(f32x4*)(rowp + bj * HALF + 8 * gq) = (f32x4){w[4 * gq], w[4 * gq + 1], w[4 * gq + 2], w[4 * gq + 3]}; } }
    }
};
struct EpiF32g {
    static constexpr bool PERM = false, AFTER_DRAIN = false; float* C0; float* C1; int ldc; int nt;
    __device__ __forceinline__ void operator()(const f32x4 (&acc)[2][2][4][2], const Unit& u, int wr, int wc, int fr, int fq) const {
        const int pl = u.pn % nt; const int row0 = u.pm * BM + wr * 64 + fr, col0 = pl * BM + wc * 32 + 4 * fq; float* C = u.k0 ? C1 : C0;
#pragma unroll
        for (int ai = 0; ai < 2; ++ai)
#pragma unroll
            for (int m = 0; m < 4; ++m) { float* rowp = C + (size_t)(row0 + ai * HALF + m * 16) * ldc + col0;
#pragma unroll
                for (int bj = 0; bj < 2; ++bj)
#pragma unroll
                    for (int n = 0; n < 2; ++n) *(f32x4*)(rowp + bj * HALF + n * 16) = acc[ai][bj][m][n]; }
    }
};
}

constexpr int CT_P0A_HI = 4096;
struct RmOff { int off; __device__ __forceinline__ int operator()(int n) const { return off + n; } };
struct RmWin { __device__ __forceinline__ int operator()(int c) const { return c < 4096 ? c : (c < 4112 ? -1 : (c < 5648 ? c - 16 : -1)); } };
struct RmGU { int half; __device__ __forceinline__ int operator()(int n) const { return 256 * (n >> 7) + 128 * half + (n & 127); } };
#define SCHED_FENCE() __builtin_amdgcn_sched_barrier(0)
#define LDS_BARRIER() do { asm volatile("s_waitcnt lgkmcnt(0)" ::: "memory"); __builtin_amdgcn_s_barrier(); asm volatile("" ::: "memory"); } while (0)
__device__ __forceinline__ void conv_load(const float* W, int N, int k0, int n0, int wave, int lane, f32x4 (&r)[8]) {
    const int n = n0 + 4 * lane; const bool ok = n < N;
    const float* p = W + (size_t)(k0 + 8 * wave) * N + n;
#pragma unroll
    for (int i = 0; i < 8; ++i) r[i] = ok ? __builtin_nontemporal_load((const GAS f32x4*)(p + (size_t)i * N)) : (f32x4){0.f, 0.f, 0.f, 0.f};
}
template <class RowMap>
__device__ __forceinline__ void conv_store_bf16(const f32x4 (&r)[8], unsigned char* WT, int Kbytes, int k0bytes, int n0, const RowMap rm, LAS unsigned char* T, int tid, int wave, int lane) {
    const int c = tid & 7, rr = tid >> 3;
#pragma unroll
    for (int p = 0; p < 2; ++p) {
        if ((lane >> 5) == p) {
#pragma unroll
            for (int j = 0; j < 4; ++j) { v4u o; o.x = pg8::cvt_pk_bf16(r[0][j], r[1][j]); o.y = pg8::cvt_pk_bf16(r[2][j], r[3][j]); o.z = pg8::cvt_pk_bf16(r[4][j], r[5][j]); o.w = pg8::cvt_pk_bf16(r[6][j], r[7][j]);
                *(LAS v4u*)(T + (4 * (lane & 31) + j) * 128 + 16 * (wave ^ (lane & 7))) = o; } }
        LDS_BARRIER();
#pragma unroll
        for (int q = 0; q < 2; ++q) { const int row = rr + 64 * q; const v4u v = *(const LAS v4u*)(T + row * 128 + 16 * (c ^ ((row >> 2) & 7)));
            const int dr = rm(n0 + 128 * p + row); if (dr >= 0) *(GAS v4u*)(WT + (size_t)dr * Kbytes + k0bytes + 16 * c) = v; }
        LDS_BARRIER();
    }
}
template <class RowMap>
__device__ __forceinline__ void conv_store_fp8(const f32x4 (&r)[8], unsigned char* WT, int Kbytes, int k0bytes, int n0, const RowMap rm, LAS unsigned char* T, int tid, int wave, int lane) {
    const int s = 2 * (lane & 3);
#pragma unroll
    for (int j = 0; j < 4; ++j) { const unsigned lo = pk4_fp8(r[0][j] * W8_SCALE, r[1][j] * W8_SCALE, r[2][j] * W8_SCALE, r[3][j] * W8_SCALE), hi = pk4_fp8(r[4][j] * W8_SCALE, r[5][j] * W8_SCALE, r[6][j] * W8_SCALE, r[7][j] * W8_SCALE);
        *(LAS unsigned long long*)(T + (4 * lane + j) * 64 + 8 * (wave ^ s)) = (unsigned long long)lo | ((unsigned long long)hi << 32); }
    LDS_BARRIER();
    const int c16 = tid & 3, rr = tid >> 2;
#pragma unroll
    for (int q = 0; q < 2; ++q) { const int row = rr + 128 * q; const v4u v = *(const LAS v4u*)(T + row * 64 + 16 * (c16 ^ ((row >> 2) & 3)));
        const int dr = rm(n0 + row); if (dr >= 0) *(GAS v4u*)(WT + (unsigned)((((dr >> 8) * (Kbytes >> 7) + (k0bytes >> 7)) << 15) + ((dr & 255) << 7) + (k0bytes & 127) + 16 * c16)) = v; }
    LDS_BARRIER();
}
struct ConvTile { const float* W; unsigned char* WT; int K, N, k0, n0, kind, f8; };
__device__ __forceinline__ bool conv_decode(KA A, int t, ConvTile& c) {
    unsigned char* ws = A->ws; c.f8 = 0;
    if (t >= 25600) return false;
    if (t < 1472) { const int l = t / 736, r = t % 736; c.W = A->in[I_WIN] + (size_t)l * D * PSRC; c.WT = ws + WS_WIN + (size_t)l * NP * D * 2; c.K = D; c.N = PSRC; c.k0 = 64 * (r / 23); c.n0 = 256 * (r % 23); c.kind = 1; return true; } t -= 1472;
    if (t < 512) { const int l = t >> 8, r = t & 255; c.W = A->in[I_WOUT] + (size_t)l * D * D; c.WT = ws + WS_WOUT + (size_t)l * D * D * 2; c.K = D; c.N = D; c.k0 = 64 * (r >> 3); c.n0 = 256 * (r & 7); c.kind = 0; return true; } t -= 512;
    if (t < 1408) { const int hf = t / 704, r = t % 704; c.W = hf ? A->in[I_FWU] : A->in[I_FWG]; c.WT = ws + WS_FUP; c.K = D; c.N = FF; c.k0 = 64 * (r / 22); c.n0 = 256 * (r % 22); c.kind = 2 + hf; return true; } t -= 1408;
    if (t < 704) { c.W = A->in[I_FWD]; c.WT = ws + WS_FDN; c.K = FF; c.N = D; c.k0 = 64 * (t >> 3); c.n0 = 256 * (t & 7); c.kind = 0; return true; } t -= 704;
    c.f8 = 1;
    if (t < 14336) { const int hf = t / 7168, r2 = t % 7168, e = r2 / 896, r = r2 % 896, hk = r & 1, q = r >> 1; c.W = (hf ? A->in[I_MWU] : A->in[I_MWG]) + (size_t)e * D * FFE; c.WT = ws + WS_MUP + (size_t)e * 2 * FFE * D; c.K = D; c.N = FFE; c.k0 = 128 * (q / 28) + 64 * hk; c.n0 = 256 * (q % 28); c.kind = 2 + hf; return true; } t -= 14336;
    { const int e = t / 896, r = t % 896, hk = r & 1, q = r >> 1; c.W = A->in[I_MWD] + (size_t)e * FFE * D; c.WT = ws + WS_MDN + (size_t)e * D * FFE; c.K = FFE; c.N = D; c.k0 = 128 * (q >> 3) + 64 * hk; c.n0 = 256 * (q & 7); c.kind = 0; return true; }
}
__device__ __forceinline__ bool conv_decode_moe(KA A, int t, ConvTile& c) {
    unsigned char* ws = A->ws; c.f8 = 1; c.K = D; c.N = FFE; t -= 4096;
    if (t < 14336) { const int hf = t / 7168, r2 = t % 7168, e = r2 / 896, r = r2 % 896, hk = r & 1, q = r >> 1; c.W = (hf ? A->in[I_MWU] : A->in[I_MWG]) + (size_t)e * D * FFE; c.WT = ws + WS_MUP + (size_t)e * 2 * FFE * D; c.k0 = 128 * (q / 28) + 64 * hk; c.n0 = 256 * (q % 28); c.kind = 2 + hf; return true; } t -= 14336;
    if (t >= 7168) return false;
    { const int e = t / 896, r = t % 896, hk = r & 1, q = r >> 1; c.W = A->in[I_MWD] + (size_t)e * FFE * D; c.WT = ws + WS_MDN + (size_t)e * D * FFE; c.K = FFE; c.N = D; c.k0 = 128 * (q >> 3) + 64 * hk; c.n0 = 256 * (q & 7); c.kind = 0; return true; }
}
__device__ __forceinline__ void conv_emit_moe(const ConvTile& c, const f32x4 (&r)[8], LAS unsigned char* T, int tid, int wave, int lane) {
    if (c.kind == 0) conv_store_fp8(r, c.WT, c.K, c.k0, c.n0, RmOff{0}, T, tid, wave, lane); else conv_store_fp8(r, c.WT, c.K, c.k0, c.n0, RmGU{c.kind - 2}, T, tid, wave, lane);
}
__device__ __forceinline__ void conv_emit(const ConvTile& c, const f32x4 (&r)[8], LAS unsigned char* T, int tid, int wave, int lane) {
    if (c.f8) { if (c.kind == 0) conv_store_fp8(r, c.WT, c.K, c.k0, c.n0, RmOff{0}, T, tid, wave, lane); else conv_store_fp8(r, c.WT, c.K, c.k0, c.n0, RmGU{c.kind - 2}, T, tid, wave, lane); }
    else if (c.kind == 0) conv_store_bf16(r, c.WT, c.K * 2, c.k0 * 2, c.n0, RmOff{0}, T, tid, wave, lane);
    else if (c.kind == 1) conv_store_bf16(r, c.WT, c.K * 2, c.k0 * 2, c.n0, RmWin{}, T, tid, wave, lane);
    else conv_store_bf16(r, c.WT, c.K * 2, c.k0 * 2, c.n0, RmGU{c.kind - 2}, T, tid, wave, lane);
}
namespace pg8 {
template <int NSLOT, bool MOE> __device__ __forceinline__ void conv_burst(const ConvHook& h, int bid, PG8_LAS unsigned char* T_, int tid) {
    KA A = ka_get(); const int lane = tid & 63, wave = __builtin_amdgcn_readfirstlane(tid >> 6); LAS unsigned char* T = (LAS unsigned char*)T_;
    const int p0 = (h.t0 >> 1) + bid, p1 = h.t1 >> 1;
#define CV_TILE(j) (2 * (p0 + 256 * ((j) >> 1)) + ((j) & 1))
#define CV_VALID(j) ((p0 + 256 * ((j) >> 1)) < p1)
#define CV_DEC(t, c) (MOE ? conv_decode_moe(A, (t), (c)) : conv_decode(A, (t), (c)))
#define CV_LOAD(j, R) do { ConvTile c_; if (CV_VALID(j) && CV_DEC(CV_TILE(j), c_)) conv_load(c_.W, c_.N, c_.k0, c_.n0, wave, lane, R); } while (0)
#define CV_PROC(j, R) { ConvTile c_; if (!CV_VALID(j) || !CV_DEC(CV_TILE(j), c_)) break; if constexpr (MOE) conv_emit_moe(c_, R, T, tid, wave, lane); else conv_emit(c_, R, T, tid, wave, lane); }
    if constexpr (NSLOT == 4) {
        f32x4 R0[8], R1[8], R2[8], R3[8];
        CV_LOAD(0, R0); CV_LOAD(1, R1); CV_LOAD(2, R2);
        for (int j = 0;; j += 4) {
            CV_LOAD(j + 3, R3); CV_PROC(j, R0)
            CV_LOAD(j + 4, R0); CV_PROC(j + 1, R1)
            CV_LOAD(j + 5, R1); CV_PROC(j + 2, R2)
            CV_LOAD(j + 6, R2); CV_PROC(j + 3, R3)
        }
    } else {
        f32x4 R0[8], R1[8], R2[8];
        CV_LOAD(0, R0); CV_LOAD(1, R1);
        for (int j = 0;; j += 3) {
            CV_LOAD(j + 2, R2); CV_PROC(j, R0)
            CV_LOAD(j + 3, R0); CV_PROC(j + 1, R1)
            CV_LOAD(j + 4, R1); CV_PROC(j + 2, R2)
        }
    }
#undef CV_TILE
#undef CV_VALID
#undef CV_LOAD
#undef CV_PROC
#undef CV_DEC
}
}
__device__ __forceinline__ void ada_item(const float* wada, float* adap, const LAS float* S, int it, int lane) {
    const int l = it / 1536, rem = it - l * 1536, cg = rem >> 5, ks = rem & 31; const int k0 = ks * 64, col = cg * 256 + 4 * lane;
    const float* w = wada + ((size_t)l * D + k0) * ADAW + col;
    f32x4 a0 = {0.f, 0.f, 0.f, 0.f}, a1 = a0, a2 = a0;
#pragma unroll 8
    for (int kk = 0; kk < 64; ++kk) { const f32x4 v = *(const GAS f32x4*)(w + (size_t)kk * ADAW); const float s0 = S[k0 + kk], s1 = S[2048 + k0 + kk], s2 = S[4096 + k0 + kk];
        a0 += v * s0; a1 += v * s1; a2 += v * s2; }
    float* o = adap + (((size_t)l * 32 + ks) * 3) * ADAW + col;
    *(GAS f32x4*)o = a0; *(GAS f32x4*)(o + ADAW) = a1; *(GAS f32x4*)(o + 2 * ADAW) = a2;
}
__device__ __forceinline__ void p0a_phase(KA A, LAS unsigned char* lds, int tid, int wave, int lane, int bid, int G) {
    unsigned char* ws = A->ws;
    LAS float* S = (LAS float*)(lds + 73728);
    { float cv[12];
#pragma unroll
      for (int it = 0; it < 12; ++it) { const int i = tid + it * NTHR; cv[it] = i < 2 * D ? A->in[I_C][i] : A->in[I_CCTX][i - 2 * D]; }
      SCHED_FENCE();
#pragma unroll
      for (int it = 0; it < 12; ++it) S[tid + it * NTHR] = silu_f(cv[it]); }
    __syncthreads();
    const int gw = bid * NWAVES + wave, NGW = G * NWAVES;
    for (int it = gw; it < 3072; it += NGW) ada_item(A->in[I_WADA], (float*)(ws + WS_ADAP), S, it, lane);
    { bf16* wsm = (bf16*)(ws + WS_WSM); const float* win = A->in[I_WIN];
      for (int idx = bid * NTHR + tid; idx < 2 * NSM * D; idx += G * NTHR) { const int l = idx / (NSM * D), j = (idx / D) % NSM, k = idx % D; const int col = j < 16 ? 4096 + j : 5648 + (j - 16);
          wsm[idx] = (unsigned short)f2bf(win[((size_t)l * D + k) * PSRC + col]); } }
    __syncthreads();
    pg8::conv_burst<4, false>(pg8::ConvHook{0, CT_P0A_HI, -1}, bid, lds + CONV_OFF, tid);
    __syncthreads();
}
__device__ __forceinline__ void p0b_phase(KA A, int tid, int bid, int G) {
    const float* adap = (const float*)(A->ws + WS_ADAP); float* modf = (float*)(A->ws + WS_MODF);
    constexpr int NV = 2 * 3 * ADAW / 4;
    for (int v = bid * NTHR + tid; v < NV; v += G * NTHR) {
        const int l = v / (3 * ADAW / 4), rem = v % (3 * ADAW / 4), r = rem / (ADAW / 4), c4 = rem % (ADAW / 4);
        f32x4 s = *(const GAS f32x4*)(A->in[I_BADA] + (size_t)l * ADAW + 4 * c4);
        for (int ks = 0; ks < 32; ++ks) s += *(const GAS f32x4*)(adap + (((size_t)l * 32 + ks) * 3 + r) * ADAW + 4 * c4);
        *(GAS f32x4*)(modf + ((size_t)l * 3 + r) * ADAW + 4 * c4) = s;
    }
}

__device__ __forceinline__ int wg_row(int bid, int rl) { if (rl < 32) return (bid >> 7) * TB + CTXL + 32 * (bid & 127) + rl; const int q = 2 * bid + (rl - 32); return (q >> 8) * TB + (q & 255); }
#define VIDX(j) (128 * ((j) >> 1) + ((j) & 1))
template <bool ROUTER, bool SMALLP>
__device__ __forceinline__ void norm_phase(KA A, LAS unsigned char* lds, int l, int which, int npart, const float* pgate, int tid, int wave, int lane, int bid) {
    unsigned char* ws = A->ws;
    const float* modl = (const float*)(ws + WS_MODF) + (size_t)l * 3 * ADAW;
    const float* gvec = (which ? A->in[I_GFFN] : A->in[I_GMIX]) + (size_t)l * D;
    const int bw = bid >> 7;
    LAS float* cA = (LAS float*)lds;
    LAS float* cB = cA + 2 * D;
    LAS float* wrT = (LAS float*)(lds + 32768);
    LAS int* rt = (LAS int*)(lds + 98304);
    {   float gv[8], m1[8], m0[8];
#pragma unroll
        for (int it = 0; it < 8; ++it) { const int i = tid + it * NTHR; const int t = i >> 11, col = i & (D - 1); const float* m = modl + (size_t)(t ? 2 : bw) * ADAW;
            gv[it] = gvec[col]; m1[it] = m[(which ? 4 : 1) * D + col]; m0[it] = m[(which ? 3 : 0) * D + col]; }
        SCHED_FENCE();
#pragma unroll
        for (int it = 0; it < 8; ++it) { const int i = tid + it * NTHR; cA[i] = gv[it] * (1.f + m1[it]); cB[i] = m0[it]; }
    }
    if (ROUTER) { const float* wr = A->in[I_MROUTER]; float w32[32];
#pragma unroll
        for (int it = 0; it < 32; ++it) w32[it] = wr[tid + it * NTHR];
        SCHED_FENCE();
#pragma unroll
        for (int it = 0; it < 32; ++it) { const int i = tid + it * NTHR; wrT[(i & 7) * D + (i >> 3)] = w32[it]; } }
    __syncthreads();
    bf16* XN = (bf16*)(ws + WS_XN); bf16* H = (bf16*)(ws + WS_H); const float* PART = (const float*)(ws + WS_PART);
#define NORM_LOAD(rl_) do { const int row_ = wg_row(bid, (rl_)), s_ = row_ % TB, b_ = row_ / TB; const bool isctx_ = s_ < CTXL; const bool from_in_ = (l == 0) && (which == 0 || (isctx_ && npart > 0)); nb = !from_in_; \
        if (from_in_) { const GAS f32x4* xr_ = (const GAS f32x4*)(isctx_ ? A->in[I_CTX] + (size_t)(b_ * CTXL + s_) * D : A->in[I_X] + (size_t)(b_ * SEQ + s_ - CTXL) * D) + 2 * lane; \
            _Pragma("unroll") for (int j = 0; j < 8; ++j) vnx[j] = xr_[VIDX(j)]; } \
        else { const GAS v4u* hr_ = (const GAS v4u*)(H + (size_t)row_ * D) + lane; _Pragma("unroll") for (int jj = 0; jj < 4; ++jj) vnb[jj] = hr_[64 * jj]; } } while (0)
    f32x4 vnx[8]; v4u vnb[4]; bool nb;
    NORM_LOAD(wave);
    for (int rl = wave; rl < 34; rl += NWAVES) {
        const int row = wg_row(bid, rl), s = row % TB; const bool isctx = s < CTXL; const int b = row / TB;
        f32x4 v[8]; float ss = 0.f;
        if (nb) {
#pragma unroll
            for (int jj = 0; jj < 4; ++jj) { float f[8]; unpack8(vnb[jj], f); v[2 * jj] = (f32x4){f[0], f[1], f[2], f[3]}; v[2 * jj + 1] = (f32x4){f[4], f[5], f[6], f[7]}; }
        } else {
#pragma unroll
            for (int j = 0; j < 8; ++j) v[j] = vnx[j];
        }
        if (rl + NWAVES < 34) NORM_LOAD(rl + NWAVES);
        if (isctx && npart > 0) {
            f32x4 acc[8];
#pragma unroll
            for (int j = 0; j < 8; ++j) acc[j] = (f32x4){0.f, 0.f, 0.f, 0.f};
            for (int p = 0; p < npart; ++p) { const GAS f32x4* pr = (const GAS f32x4*)(PART + ((size_t)p * 512 + b * CTXL + s) * D) + 2 * lane;
#pragma unroll
                for (int j = 0; j < 8; ++j) acc[j] += pr[VIDX(j)]; }
            const GAS f32x4* gp = (const GAS f32x4*)pgate + 2 * lane; GAS v4u* hw = (GAS v4u*)(H + (size_t)row * D) + lane;
#pragma unroll
            for (int j = 0; j < 8; ++j) v[j] += gp[VIDX(j)] * acc[j];
#pragma unroll
            for (int jj = 0; jj < 4; ++jj) { const float f[8] = {v[2 * jj].x, v[2 * jj].y, v[2 * jj].z, v[2 * jj].w, v[2 * jj + 1].x, v[2 * jj + 1].y, v[2 * jj + 1].z, v[2 * jj + 1].w}; hw[64 * jj] = pack8(f); }
        }
#pragma unroll
        for (int j = 0; j < 8; ++j) ss += (v[j].x * v[j].x + v[j].y * v[j].y) + (v[j].z * v[j].z + v[j].w * v[j].w);
        const float rstd = __builtin_amdgcn_rsqf(wave_sum(ss) * (1.f / D) + EPS);
        const LAS f32x4* ca = (const LAS f32x4*)(cA + (isctx ? D : 0)) + 2 * lane; const LAS f32x4* cb = (const LAS f32x4*)(cB + (isctx ? D : 0)) + 2 * lane;
        GAS v4u* o16 = (GAS v4u*)(XN + (size_t)row * D) + lane; GAS unsigned long long* o8 = (GAS unsigned long long*)((unsigned char*)XN + (size_t)row * D) + lane;
#pragma unroll
        for (int j = 0; j < 8; ++j) v[j] = v[j] * rstd * ca[VIDX(j)] + cb[VIDX(j)];
#pragma unroll
        for (int jj = 0; jj < 4; ++jj) { const f32x4 x0 = v[2 * jj], x1 = v[2 * jj + 1];
            if (ROUTER) o8[64 * jj] = (unsigned long long)pk4_fp8(x0.x * XN8_SCALE, x0.y * XN8_SCALE, x0.z * XN8_SCALE, x0.w * XN8_SCALE) | ((unsigned long long)pk4_fp8(x1.x * XN8_SCALE, x1.y * XN8_SCALE, x1.z * XN8_SCALE, x1.w * XN8_SCALE) << 32);
            else { v4u o; o.x = pg8::cvt_pk_bf16(x0.x, x0.y); o.y = pg8::cvt_pk_bf16(x0.z, x0.w); o.z = pg8::cvt_pk_bf16(x1.x, x1.y); o.w = pg8::cvt_pk_bf16(x1.z, x1.w); o16[64 * jj] = o; } }
        if (ROUTER) {
            float lg[8];
#pragma unroll
            for (int e = 0; e < 8; ++e) { const LAS f32x4* wv = (const LAS f32x4*)(wrT + e * D) + 2 * lane; float a = 0.f;
#pragma unroll
                for (int j = 0; j < 8; ++j) { const f32x4 w = wv[VIDX(j)]; a += (v[j].x * w.x + v[j].y * w.y) + (v[j].z * w.z + v[j].w * w.w); }
                lg[e] = wave_sum(a); }
            int e1 = 0; float v1 = lg[0];
#pragma unroll
            for (int e = 1; e < 8; ++e) if (lg[e] > v1) { v1 = lg[e]; e1 = e; }
            int e2 = -1; float v2 = -3.0e38f;
#pragma unroll
            for (int e = 0; e < 8; ++e) if (e != e1 && lg[e] > v2) { v2 = lg[e]; e2 = e; }
            const float ex = __expf(v2 - v1), w1 = 1.f / (1.f + ex), w2 = ex * w1;
            if (lane == 0) { rt[rl * 4 + 0] = isctx ? -1 : e1; rt[rl * 4 + 1] = e2; rt[rl * 4 + 2] = __float_as_int(w1); rt[rl * 4 + 3] = __float_as_int(w2); }
        }
    }
    if (ROUTER) {
        __syncthreads();
        LAS int* cnt = rt + 34 * 4;
        if (tid < 8) cnt[tid] = 0;
        __syncthreads();
        if (tid == 0) {
            int4* route = (int4*)(ws + WS_ROUTE);
            for (int rl = 0; rl < 34; ++rl) { const int e1 = rt[rl * 4]; if (e1 < 0) continue; const int e2 = rt[rl * 4 + 1];
                const int r1 = cnt[e1]; cnt[e1] = r1 + 1; const int r2 = cnt[e2]; cnt[e2] = r2 + 1;
                route[wg_row(bid, rl)] = make_int4(e1 | (e2 << 4) | (r1 << 8) | (r2 << 16), rt[rl * 4 + 2], rt[rl * 4 + 3], 0); }
            int* gc = (int*)(ws + WS_CNT) + bid * 8;
            for (int e = 0; e < 8; ++e) gc[e] = cnt[e];
        }
    }
    if (SMALLP) {
        asm volatile("s_waitcnt vmcnt(0)" ::: "memory"); __syncthreads();
        const bf16* wsm = (const bf16*)(ws + WS_WSM) + (size_t)l * NSM * D;
        const int l16 = lane & 15, q = lane >> 4;
        f32x4 acc[3][3];
#pragma unroll
        for (int a = 0; a < 3; ++a)
#pragma unroll
            for (int c = 0; c < 3; ++c) acc[a][c] = (f32x4){0.f, 0.f, 0.f, 0.f};
        const bf16* ap[3]; const bf16* bp[3];
#pragma unroll
        for (int a = 0; a < 3; ++a) { int r = 16 * a + l16; r = r < 34 ? r : 33; ap[a] = XN + (size_t)wg_row(bid, r) * D + 256 * wave + 8 * q; bp[a] = wsm + (size_t)(16 * a + l16) * D + 256 * wave + 8 * q; }
#pragma unroll
        for (int ks = 0; ks < 8; ++ks) { bf16x8 fa[3], fb[3];
#pragma unroll
            for (int a = 0; a < 3; ++a) { fa[a] = *(const GAS bf16x8*)(ap[a] + 32 * ks); fb[a] = *(const GAS bf16x8*)(bp[a] + 32 * ks); }
#pragma unroll
            for (int a = 0; a < 3; ++a)
#pragma unroll
                for (int c = 0; c < 3; ++c) acc[a][c] = __builtin_amdgcn_mfma_f32_16x16x32_bf16(fa[a], fb[c], acc[a][c], 0, 0, 0); }
        LAS float* red = (LAS float*)(lds + 32768);
#pragma unroll
        for (int a = 0; a < 3; ++a)
#pragma unroll
            for (int c = 0; c < 3; ++c)
#pragma unroll
                for (int j = 0; j < 4; ++j) red[(wave * 48 + 16 * a + 4 * q + j) * 48 + 16 * c + l16] = acc[a][c][j];
        __syncthreads();
        float* PS = (float*)(ws + WS_PS);
        for (int i = tid; i < 34 * 48; i += NTHR) { float s = 0.f;
#pragma unroll
            for (int w = 0; w < 8; ++w) s += red[w * 2304 + i];
            PS[(size_t)wg_row(bid, i / 48) * NSM + (i % 48)] = s; }
    }
    __syncthreads();
}

__device__ __forceinline__ void seg_flags(int row, bool& hl, bool& hr) { const int s = row % TB; if (s < CTXL) { hl = s != 0; hr = s != CTXL - 1; } else { const int t = (s - CTXL) & 63; hl = t != 0; hr = t != 63; } }
__device__ __forceinline__ void conv8(const bf16* P, const float* cw, const float* cb, int row, int pcol, int xc, float (&o)[8]) {
    bool hl, hr; seg_flags(row, hl, hr);
    const bf16* p = P + (size_t)row * NP + pcol; const v4u z = {0u, 0u, 0u, 0u};
    const v4u vc = *(const GAS v4u*)p, vl = hl ? *(const GAS v4u*)(p - NP) : z, vr = hr ? *(const GAS v4u*)(p + NP) : z;
    float c[8], lf[8], rg[8]; unpack8(vc, c); unpack8(vl, lf); unpack8(vr, rg);
    const f32x4 w0a = *(const GAS f32x4*)(cw + xc), w0b = *(const GAS f32x4*)(cw + xc + 4), w1a = *(const GAS f32x4*)(cw + 1024 + xc), w1b = *(const GAS f32x4*)(cw + 1024 + xc + 4),
                w2a = *(const GAS f32x4*)(cw + 2048 + xc), w2b = *(const GAS f32x4*)(cw + 2048 + xc + 4), ba = *(const GAS f32x4*)(cb + xc), bb = *(const GAS f32x4*)(cb + xc + 4);
#pragma unroll
    for (int e = 0; e < 4; ++e) { o[e] = silu_f(w0a[e] * lf[e] + w1a[e] * c[e] + w2a[e] * rg[e] + ba[e]); o[4 + e] = silu_f(w0b[e] * lf[4 + e] + w1b[e] * c[4 + e] + w2b[e] * rg[4 + e] + bb[e]); }
}

struct ConvW { f32x4 w0a, w0b, w1a, w1b, w2a, w2b, ba, bb; };
__device__ __forceinline__ void convw_load(ConvW& w, const float* cw, const float* cb, int xc) {
    w.w0a = *(const GAS f32x4*)(cw + xc); w.w0b = *(const GAS f32x4*)(cw + xc + 4); w.w1a = *(const GAS f32x4*)(cw + 1024 + xc); w.w1b = *(const GAS f32x4*)(cw + 1024 + xc + 4);
    w.w2a = *(const GAS f32x4*)(cw + 2048 + xc); w.w2b = *(const GAS f32x4*)(cw + 2048 + xc + 4); w.ba = *(const GAS f32x4*)(cb + xc); w.bb = *(const GAS f32x4*)(cb + xc + 4); }
struct ConvIn { v4u vc, vl, vr; };
__device__ __forceinline__ void convin_load(ConvIn& x, const bf16* P, int row, int pcol) {
    bool hl, hr; seg_flags(row, hl, hr); const bf16* p = P + (size_t)row * NP + pcol; const v4u z = {0u, 0u, 0u, 0u};
    x.vc = *(const GAS v4u*)p; x.vl = hl ? *(const GAS v4u*)(p - NP) : z; x.vr = hr ? *(const GAS v4u*)(p + NP) : z; }
__device__ __forceinline__ void conv8w(const ConvIn& x, const ConvW& w, float (&o)[8]) {
    float c[8], lf[8], rg[8]; unpack8(x.vc, c); unpack8(x.vl, lf); unpack8(x.vr, rg);
#pragma unroll
    for (int e = 0; e < 4; ++e) { o[e] = silu_f(w.w0a[e] * lf[e] + w.w1a[e] * c[e] + w.w2a[e] * rg[e] + w.ba[e]); o[4 + e] = silu_f(w.w0b[e] * lf[4 + e] + w.w1b[e] * c[4 + e] + w.w2b[e] * rg[4 + e] + w.bb[e]); }
}
__device__ __forceinline__ void m1_sccm_item(KA A, LAS unsigned char* lds, int l, int item, int tid, int wave, int lane) {
    unsigned char* ws = A->ws; const bf16* P = (const bf16*)(ws + WS_P); bf16* YM = (bf16*)(ws + WS_YMIX);
    const int cc = item >> 2, g = item & 3; const int b = cc / NCH_M, c = cc % NCH_M, row0 = b * TB + c * 128;
    const float* scw = A->in[I_SCW] + (size_t)l * 3 * 512;
    {   const int v = tid & 15, ch = 128 * g + 8 * v; const v4u z = {0u, 0u, 0u, 0u}; v4u in[4][7]; f32x4 sw[6];
#pragma unroll
        for (int it = 0; it < 4; ++it) { const int row = row0 + (tid >> 4) + 32 * it; bool hl, hr; seg_flags(row, hl, hr); const bf16* p = P + (size_t)row * NP;
            in[it][0] = *(const GAS v4u*)(p + C_BG + ch); in[it][1] = *(const GAS v4u*)(p + C_CG + ch); in[it][2] = *(const GAS v4u*)(p + C_XA + ch);
            in[it][3] = hl ? *(const GAS v4u*)(p - NP + C_CG + ch) : z; in[it][4] = hl ? *(const GAS v4u*)(p - NP + C_XA + ch) : z;
            in[it][5] = hr ? *(const GAS v4u*)(p + NP + C_CG + ch) : z; in[it][6] = hr ? *(const GAS v4u*)(p + NP + C_XA + ch) : z; }
#pragma unroll
        for (int k = 0; k < 3; ++k) { sw[2 * k] = *(const GAS f32x4*)(scw + 512 * k + ch); sw[2 * k + 1] = *(const GAS f32x4*)(scw + 512 * k + ch + 4); }
        SCHED_FENCE();
#pragma unroll
        for (int it = 0; it < 4; ++it) { const int row = row0 + (tid >> 4) + 32 * it; float bg[8], u0[8], u1[8], u2[8], t0[8], t1[8];
            unpack8(in[it][0], bg); unpack8(in[it][1], t0); unpack8(in[it][2], t1);
#pragma unroll
            for (int e = 0; e < 8; ++e) u1[e] = t0[e] * t1[e];
            unpack8(in[it][3], t0); unpack8(in[it][4], t1);
#pragma unroll
            for (int e = 0; e < 8; ++e) u0[e] = t0[e] * t1[e];
            unpack8(in[it][5], t0); unpack8(in[it][6], t1);
#pragma unroll
            for (int e = 0; e < 8; ++e) u2[e] = t0[e] * t1[e];
            float o[8];
#pragma unroll
            for (int e = 0; e < 8; ++e) o[e] = bg[e] * (sw[e >> 2][e & 3] * u0[e] + sw[2 + (e >> 2)][e & 3] * u1[e] + sw[4 + (e >> 2)][e & 3] * u2[e]);
            *(GAS v4u*)(YM + (size_t)row * D + ch) = pack8(o); }
    }
    lbf16* Ws = (lbf16*)lds; lbf16* Vt = (lbf16*)(lds + 34816);
    const float* wsrc = A->in[I_CMW] + ((size_t)l * 4 + g) * 128 * 128; const float* bsrc = A->in[I_CMB] + ((size_t)l * 4 + g) * 128;
    f32x4 wv[8]; v4u vin[4]; unsigned long long uu[2][2][2]; float bias[2][2];
#pragma unroll
    for (int it = 0; it < 8; ++it) { const int task = tid + it * NTHR; const int i = task >> 5, j4 = task & 31; wv[it] = *(const GAS f32x4*)(wsrc + i * 128 + 4 * j4); }
#pragma unroll
    for (int it = 0; it < 4; ++it) { const int task = tid + it * NTHR; const int j = task >> 4, v = task & 15; vin[it] = *(const GAS v4u*)(P + (size_t)(row0 + j) * NP + C_CMV + 128 * g + 8 * v); }
#pragma unroll
    for (int qb = 0; qb < 2; ++qb) { const int blk = wave + qb * NWAVES; const int m0 = 32 * (blk >> 2), n0 = 32 * (blk & 3);
#pragma unroll
        for (int bq = 0; bq < 2; ++bq) { const int i = n0 + 16 * bq + (lane & 15); bias[qb][bq] = bsrc[i];
#pragma unroll
            for (int a = 0; a < 2; ++a) { const int d = m0 + 16 * a + 4 * (lane >> 4); uu[qb][a][bq] = *(const GAS unsigned long long*)(P + (size_t)(row0 + i) * NP + C_CMU + 128 * g + d); } } }
    SCHED_FENCE();
#pragma unroll
    for (int it = 0; it < 8; ++it) { const int task = tid + it * NTHR; const int i = task >> 5, j4 = task & 31; const f32x4 w = wv[it];
        *(LAS unsigned long long*)(Ws + i * 136 + 4 * j4) = (unsigned long long)pg8::cvt_pk_bf16(w.x, w.y) | ((unsigned long long)pg8::cvt_pk_bf16(w.z, w.w) << 32); }
#pragma unroll
    for (int it = 0; it < 4; ++it) { const int task = tid + it * NTHR; const int j = task >> 4, v = task & 15; float f[8]; unpack8(vin[it], f);
#pragma unroll
        for (int e = 0; e < 8; ++e) Vt[(8 * v + e) * 136 + tswz<15>(8 * v + e, j)] = (unsigned short)f2bf(gelu_tanh(f[e])); }
    __syncthreads();
#pragma unroll
    for (int qb = 0; qb < 2; ++qb) { const int blk = wave + qb * NWAVES; const int m0 = 32 * (blk >> 2), n0 = 32 * (blk & 3);
        Acc32 acc; acc_zero(acc); wave_mma32<15, -1>(acc, Vt, 136, Ws, 136, m0, n0, 128, lane);
#pragma unroll
        for (int a = 0; a < 2; ++a)
#pragma unroll
            for (int bq = 0; bq < 2; ++bq) { const int d = m0 + 16 * a + 4 * (lane >> 4), i = n0 + 16 * bq + (lane & 15); const float bi = bias[qb][bq];
                const size_t prow = (size_t)(row0 + i); const unsigned long long u8 = uu[qb][a][bq];
                const float u0 = gelu_tanh(__uint_as_float((unsigned)u8 << 16)), u1 = gelu_tanh(__uint_as_float((unsigned)u8 & 0xffff0000u)), u2 = gelu_tanh(__uint_as_float((unsigned)(u8 >> 32) << 16)), u3 = gelu_tanh(__uint_as_float((unsigned)(u8 >> 32) & 0xffff0000u));
                const f32x4 sv = acc.v[a][bq];
                *(GAS unsigned long long*)(YM + prow * D + 512 + 128 * g + d) = (unsigned long long)pg8::cvt_pk_bf16(u0 * (sv[0] + bi), u1 * (sv[1] + bi)) | ((unsigned long long)pg8::cvt_pk_bf16(u2 * (sv[2] + bi), u3 * (sv[3] + bi)) << 32); }
    }
    __syncthreads();
}

__device__ __forceinline__ void m1_mamba_group(KA A, LAS unsigned char* lds, int l, int item, int tid, int wave, int lane) {
    unsigned char* ws = A->ws; const bf16* P = (const bf16*)(ws + WS_P);
    const int cc = item >> 1, g = item & 1; const int b = cc / NCH_M, c = cc % NCH_M, row0 = b * TB + c * 128;
    const float* cw = A->in[I_MBCW] + (size_t)l * 3 * 1024; const float* cb = A->in[I_MBCB] + (size_t)l * 1024;
    lbf16* Cm = (lbf16*)lds; lbf16* Bm = (lbf16*)(lds + 34816); lbf16* BmT = (lbf16*)(lds + 69632); lbf16* Xt = (lbf16*)(lds + 104448);
    LAS float* sm = (LAS float*)(lds + 121856);
    {
        const int v = tid & 15; ConvIn xb[4], xc[4]; ConvW wB, wC;
#pragma unroll
        for (int q = 0; q < 4; ++q) convin_load(xb[q], P, row0 + (tid >> 4) + 32 * q, C_BM + 128 * g + 8 * v);
#pragma unroll
        for (int q = 0; q < 4; ++q) convin_load(xc[q], P, row0 + (tid >> 4) + 32 * q, C_CM + 128 * g + 8 * v);
        convw_load(wB, cw, cb, 512 + 128 * g + 8 * v); convw_load(wC, cw, cb, 768 + 128 * g + 8 * v);
        SCHED_FENCE();
#pragma unroll
        for (int q = 0; q < 4; ++q) { const int t = (tid >> 4) + 32 * q; float o[8]; conv8w(xb[q], wB, o); *(LAS v4u*)(Bm + t * 136 + 8 * v) = pack8(o);
#pragma unroll
            for (int e = 0; e < 8; ++e) BmT[(8 * v + e) * 136 + tswz<15>(8 * v + e, t)] = (unsigned short)f2bf(o[e]); }
#pragma unroll
        for (int q = 0; q < 4; ++q) { const int t = (tid >> 4) + 32 * q; float o[8]; conv8w(xc[q], wC, o); *(LAS v4u*)(Cm + t * 136 + 8 * v) = pack8(o); }
    }
    __syncthreads();
    Acc32 cbraw[2];
#pragma unroll
    for (int q2 = 0; q2 < 2; ++q2) { const int blk = wave + 8 * q2; acc_zero(cbraw[q2]); wave_mma32(cbraw[q2], Cm, 136, Bm, 136, 32 * (blk >> 2), 32 * (blk & 3), 128, lane); }
    __syncthreads();
    lbf16* Wl = Cm; lbf16* XwT = Bm;
    ConvIn xn[2]; ConvW wn; float dtn = 0.f;
#define MG_ISSUE(hx) do { const int v_ = tid & 7; _Pragma("unroll") for (int i = 0; i < 2; ++i) convin_load(xn[i], P, row0 + (tid >> 3) + 64 * i, C_XS + 64 * (hx) + 8 * v_); convw_load(wn, cw, cb, 64 * (hx) + 8 * v_); \
        if (tid < 256) dtn = ((const float*)(ws + WS_PS))[(size_t)(row0 + (tid & 127)) * NSM + (tid >> 7) * 8 + (hx)] + A->in[I_MBDTB][(l * 2 + (tid >> 7)) * 8 + (hx)]; } while (0)
    MG_ISSUE(4 * g);
#pragma unroll 1
    for (int hh = 0; hh < 4; ++hh) { const int h = 4 * g + hh;
    {
        const int v = tid & 7; const ConvW w = wn; const ConvIn x[2] = {xn[0], xn[1]}; const float dtx = dtn;
        asm volatile("" : "+v"(tid), "+v"(lane)); asm volatile("" : "+s"(wave));
        if (hh < 3) MG_ISSUE(h + 1);
        SCHED_FENCE();
#pragma unroll
        for (int i = 0; i < 2; ++i) { const int t = (tid >> 3) + 64 * i; float o[8]; conv8w(x[i], w, o);
#pragma unroll
            for (int e = 0; e < 8; ++e) Xt[(8 * v + e) * 136 + tswz<15>(8 * v + e, t)] = (unsigned short)f2bf(o[e]); }
        if (tid < 256) sm[(tid >> 7) * 128 + (tid & 127)] = softplus_f(dtx);
    }
    __syncthreads();
    const float an0 = -__expf(A->in[I_MBALOG][(l * 2 + 0) * 8 + h]), an1 = -__expf(A->in[I_MBALOG][(l * 2 + 1) * 8 + h]);
    if (wave == 0) {
        const float x0 = sm[2 * lane] * an0, x1 = sm[2 * lane + 1] * an0; float S = x0 + x1;
#pragma unroll
        for (int off = 1; off < 64; off <<= 1) { const float y = __shfl_up(S, off); if (lane >= off) S += y; }
        float E = __shfl_up(S, 1); if (lane == 0) E = 0.f;
        sm[256 + 2 * lane] = E + x0; sm[256 + 2 * lane + 1] = E + (x0 + x1);
    } else if (wave == 1) {
        const float x0 = sm[128 + 2 * lane] * an1, x1 = sm[128 + 2 * lane + 1] * an1; float S = x0 + x1;
#pragma unroll
        for (int off = 1; off < 64; off <<= 1) { const float y = __shfl_down(S, off); if (lane + off < 64) S += y; }
        float E = __shfl_down(S, 1); if (lane == 63) E = 0.f;
        sm[384 + 2 * lane + 1] = E + x1; sm[384 + 2 * lane] = E + (x1 + x0);
    }
    __syncthreads();
    const LAS float* dt0 = sm; const LAS float* dt1 = sm + 128; const LAS float* ac0 = sm + 256; const LAS float* ac1 = sm + 384;
#pragma unroll
    for (int q2 = 0; q2 < 2; ++q2) { const int blk = wave + 8 * q2;
#pragma unroll
        for (int a = 0; a < 2; ++a)
#pragma unroll
            for (int bq = 0; bq < 2; ++bq) { const int jj = 32 * (blk & 3) + 16 * bq + (lane & 15); const float a0j = ac0[jj], a1j = ac1[jj], d0j = dt0[jj], d1j = dt1[jj];
#pragma unroll
                for (int j = 0; j < 4; ++j) { const int i = 32 * (blk >> 2) + 16 * a + 4 * (lane >> 4) + j; float f = 0.f;
                    if (jj <= i) f += __expf(ac0[i] - a0j) * d0j;
                    if (jj >= i) f += __expf(ac1[i] - a1j) * d1j;
                    Wl[i * 136 + jj] = (unsigned short)f2bf(cbraw[q2].v[a][bq][j] * f); } }
    }
    const float al0 = ac0[127], al1 = ac1[0];
#pragma unroll
    for (int it = 0; it < 2048 / NTHR; ++it) { const int task = tid + it * NTHR; const int d = task >> 10, p = (task >> 4) & 63, v = task & 15; float f[8]; unpack8(*(const LAS v4u*)(Xt + p * 136 + 8 * (v ^ ((p >> 3) & 15))), f);
#pragma unroll
        for (int e = 0; e < 8; ++e) { const int j = 8 * v + e; f[e] *= d ? __expf(al1 - ac1[j]) * dt1[j] : __expf(al0 - ac0[j]) * dt0[j]; }
        *(LAS v4u*)(XwT + d * 8704 + p * 136 + 8 * v) = pack8(f); }
    __syncthreads();
    {
        const int m0 = 32 * (wave >> 2), n0 = 32 * (wave & 3); Acc32 y; acc_zero(y); wave_mma32<15, -1>(y, Xt, 136, Wl, 136, m0, n0, 128, lane);
        const float dsum = A->in[I_MBD][(l * 2 + 0) * 8 + h] + A->in[I_MBD][(l * 2 + 1) * 8 + h];
        float* YMB = (float*)(ws + WS_YMB);
#pragma unroll
        for (int a = 0; a < 2; ++a)
#pragma unroll
            for (int bq = 0; bq < 2; ++bq) { const int p = m0 + 16 * a + 4 * (lane >> 4), i = n0 + 16 * bq + (lane & 15); f32x4 o = y.v[a][bq];
#pragma unroll
                for (int j = 0; j < 4; ++j) o[j] += bf2f(Xt[(p + j) * 136 + tswz<15>(p + j, i)]) * dsum;
                *(GAS f32x4*)(YMB + (size_t)(row0 + i) * 512 + 64 * h + p) = o; }
    }
    float* CSM = (float*)(ws + WS_CSM);
#pragma unroll
    for (int d = 0; d < 2; ++d) {
        const int m0 = 32 * (wave >> 1), n0 = 32 * (wave & 1); Acc32 s; acc_zero(s); wave_mma32<15, -1>(s, BmT, 136, XwT + d * 8704, 136, m0, n0, 128, lane);
        float* cs = CSM + ((((size_t)b * NCH_M + c) * 2 + d) * 8 + h) * 8192;
#pragma unroll
        for (int a = 0; a < 2; ++a)
#pragma unroll
            for (int bq = 0; bq < 2; ++bq) { const int n = m0 + 16 * a + 4 * (lane >> 4), p = n0 + 16 * bq + (lane & 15); *(GAS f32x4*)(cs + p * 128 + n) = s.v[a][bq]; }
    }
    if (tid < 256) { const int d = tid >> 7, t = tid & 127; ((float*)(ws + WS_EA))[(size_t)(row0 + t) * 16 + d * 8 + h] = __expf(sm[256 + d * 128 + t]); }
    if (tid < 2) ((float*)(ws + WS_ALAST))[(((size_t)b * NCH_M + c) * 2 + tid) * 8 + h] = tid ? al1 : al0;
    __syncthreads();
    }
#undef MG_ISSUE
}

__device__ __forceinline__ void m1_gla_item(KA A, LAS unsigned char* lds, int l, int item, int tid, int wave, int lane) {
    unsigned char* ws = A->ws; const bf16* P = (const bf16*)(ws + WS_P);
    const int cgi = item >> 2, h = item & 3; const int b = cgi / NCH_G, c = cgi % NCH_G, row0 = b * TB + c * 64;
    LAS float* G = (LAS float*)lds;
    LAS float* wgs = (LAS float*)(lds + 33280);
    LAS float* bgs = (LAS float*)(lds + 41472);
    lbf16* Qs = (lbf16*)(lds + 41984); lbf16* Ks = (lbf16*)(lds + 60416); lbf16* KsT = (lbf16*)(lds + 78848); lbf16* Vt = (lbf16*)(lds + 97280); lbf16* Att = (lbf16*)(lds + 115712);
    float wg4[4]; float bg1 = 0.f; f32x4 glv[4]; v4u qv, kv8, vv2[2];
#pragma unroll
    for (int it = 0; it < 4; ++it) { const int i = tid + it * NTHR; const int d = i >> 10, r = (i >> 6) & 15, k = i & 63; wg4[it] = A->in[I_GLAWG][(((size_t)l * 2 + d) * 16 + r) * 256 + 64 * h + k]; }
    if (tid < 128) bg1 = A->in[I_GLABG][((size_t)l * 2 + (tid >> 6)) * 256 + 64 * h + (tid & 63)];
    { const int d = tid >> 8, t = (tid >> 2) & 63; const GAS f32x4* p = (const GAS f32x4*)((const float*)(ws + WS_PS) + (size_t)(row0 + t) * NSM + 16 + d * 16);
#pragma unroll
      for (int e = 0; e < 4; ++e) glv[e] = p[e]; }
    { const int t = tid >> 3, kv = tid & 7; qv = *(const GAS v4u*)(P + (size_t)(row0 + t) * NP + C_Q + 64 * h + 8 * kv); kv8 = *(const GAS v4u*)(P + (size_t)(row0 + t) * NP + C_K + 64 * h + 8 * kv); }
#pragma unroll
    for (int it = 0; it < 2; ++it) { const int task = tid + it * NTHR; const int t = task >> 4, vv = task & 15; vv2[it] = *(const GAS v4u*)(P + (size_t)(row0 + t) * NP + C_V + 128 * h + 8 * vv); }
    SCHED_FENCE();
#pragma unroll
    for (int it = 0; it < 4; ++it) wgs[tid + it * NTHR] = wg4[it];
    if (tid < 128) bgs[tid] = bg1;
    __syncthreads();
    {   const int d = tid >> 8, t = (tid >> 2) & 63, kq = tid & 3;
        float gl[16];
#pragma unroll
        for (int e = 0; e < 4; ++e) { const f32x4 f = glv[e]; gl[4 * e] = f.x; gl[4 * e + 1] = f.y; gl[4 * e + 2] = f.z; gl[4 * e + 3] = f.w; }
        f32x4 acc[4] = {{0.f, 0.f, 0.f, 0.f}, {0.f, 0.f, 0.f, 0.f}, {0.f, 0.f, 0.f, 0.f}, {0.f, 0.f, 0.f, 0.f}};
#pragma unroll
        for (int r = 0; r < 16; ++r) { const LAS f32x4* w = (const LAS f32x4*)(wgs + (d * 16 + r) * 64 + kq * 16);
#pragma unroll
            for (int q = 0; q < 4; ++q) acc[q] += w[q] * gl[r]; }
#pragma unroll
        for (int q = 0; q < 4; ++q)
#pragma unroll
            for (int e = 0; e < 4; ++e) { const int k = kq * 16 + 4 * q + e; G[(d * 64 + t) * 65 + k] = logsig_f(acc[q][e] + bgs[d * 64 + k]) * (1.f / 16.f); }
    }
    __syncthreads();
#pragma unroll 4
    for (int ci = 0; ci < 128 / NWAVES; ++ci) { const int col = wave + ci * NWAVES;
        const int d = col >> 6, k = col & 63; float S = G[(d * 64 + lane) * 65 + k];
        if (d == 0) {
#pragma unroll
            for (int off = 1; off < 64; off <<= 1) { const float y = __shfl_up(S, off); if (lane >= off) S += y; }
        } else {
#pragma unroll
            for (int off = 1; off < 64; off <<= 1) { const float y = __shfl_down(S, off); if (lane + off < 64) S += y; }
        }
        G[(d * 64 + lane) * 65 + k] = S; }
    __syncthreads();
    {   const int t = tid >> 3, kv = tid & 7; float qf[8], kf[8];
        unpack8(qv, qf); unpack8(kv8, kf);
        bf16* QE = (bf16*)(ws + WS_QE);
#pragma unroll
        for (int d = 0; d < 2; ++d) { float qs[8], ks[8], qe[8];
#pragma unroll
            for (int e = 0; e < 8; ++e) { const int k = 8 * kv + e; const float gv = G[(d * 64 + t) * 65 + k], gref = G[(d * 64 + (d ? 31 : 32)) * 65 + k], glast = G[(d * 64 + (d ? 0 : 63)) * 65 + k];
                const float q = qf[e] * 0.125f; qs[e] = q * __expf(gv - gref); ks[e] = kf[e] * __expf(gref - gv); qe[e] = q * __expf(gv);
                KsT[d * 4608 + k * 72 + tswz<7>(k, t)] = (unsigned short)f2bf(kf[e] * __expf(glast - gv)); }
            *(LAS v4u*)(Qs + d * 4608 + t * 72 + 8 * kv) = pack8(qs); *(LAS v4u*)(Ks + d * 4608 + t * 72 + 8 * kv) = pack8(ks);
            *(GAS v4u*)(QE + (size_t)(row0 + t) * 512 + d * 256 + 64 * h + 8 * kv) = pack8(qe); }
    }
#pragma unroll
    for (int it = 0; it < 2; ++it) { const int task = tid + it * NTHR; const int t = task >> 4, vv = task & 15; float f[8]; unpack8(vv2[it], f);
#pragma unroll
        for (int e = 0; e < 8; ++e) Vt[(8 * vv + e) * 72 + tswz<7>(8 * vv + e, t)] = (unsigned short)f2bf(f[e]); }
    if (tid < 128) { const int d = tid >> 6, k = tid & 63; ((float*)(ws + WS_GLAST))[((((size_t)b * NCH_G + c) * 2 + d) * 4 + h) * 64 + k] = G[(d * 64 + (d ? 0 : 63)) * 65 + k]; }
    __syncthreads();
    if (wave < 4) { const int m0 = 32 * (wave >> 1), n0 = 32 * (wave & 1); Acc32 a0, a1; acc_zero(a0); acc_zero(a1);
        wave_mma32(a0, Qs, 72, Ks, 72, m0, n0, 64, lane); wave_mma32(a1, Qs + 4608, 72, Ks + 4608, 72, m0, n0, 64, lane);
#pragma unroll
        for (int a = 0; a < 2; ++a)
#pragma unroll
            for (int bq = 0; bq < 2; ++bq) { const int jj = n0 + 16 * bq + (lane & 15);
#pragma unroll
                for (int j = 0; j < 4; ++j) { const int i = m0 + 16 * a + 4 * (lane >> 4) + j; const float val = (jj <= i ? a0.v[a][bq][j] : 0.f) + (jj >= i ? a1.v[a][bq][j] : 0.f); Att[i * 72 + jj] = (unsigned short)f2bf(val); } }
    }
    __syncthreads();
    const int m0 = 32 * (wave >> 1), n0 = 32 * (wave & 1);
    {   Acc32 o; acc_zero(o); wave_mma32<7, -1>(o, Vt, 72, Att, 72, m0, n0, 64, lane);
        float* YG = (float*)(ws + WS_YGLA);
#pragma unroll
        for (int a = 0; a < 2; ++a)
#pragma unroll
            for (int bq = 0; bq < 2; ++bq) { const int v = m0 + 16 * a + 4 * (lane >> 4), i = n0 + 16 * bq + (lane & 15); *(GAS f32x4*)(YG + (size_t)(row0 + i) * 512 + 128 * h + v) = o.v[a][bq]; }
    }
    float* CSG = (float*)(ws + WS_CSG);
#pragma unroll
    for (int d = 0; d < 2; ++d) { Acc32 s; acc_zero(s); wave_mma32<7, 7>(s, Vt, 72, KsT + d * 4608, 72, m0, n0, 64, lane);
        float* cs = CSG + ((((size_t)b * NCH_G + c) * 2 + d) * 4 + h) * 8192;
#pragma unroll
        for (int a = 0; a < 2; ++a)
#pragma unroll
            for (int bq = 0; bq < 2; ++bq) { const int v = m0 + 16 * a + 4 * (lane >> 4), k = n0 + 16 * bq + (lane & 15); *(GAS f32x4*)(cs + k * 128 + v) = s.v[a][bq]; }
    }
    __syncthreads();
}

__device__ __forceinline__ void m2_phase(KA A, int wave, int lane, int bid, int G) {
    unsigned char* ws = A->ws; const int gw = bid * NWAVES + wave, NGW = G * NWAVES;
    float* CSM = (float*)(ws + WS_CSM); const float* AL = (const float*)(ws + WS_ALAST);
    for (int line = gw; line < BATCH * 2 * 8 * 64; line += NGW) {
        const int p = line & 63, h = (line >> 6) & 7, d = (line >> 9) & 1, b = line >> 10;
        float c0[NCH_M], c1[NCH_M], dc[NCH_M];
#pragma unroll
        for (int i = 0; i < NCH_M; ++i) { const int c = d == 0 ? i : (i < 2 ? 1 - i : NCH_M + 1 - i);
            const float* cs = CSM + (((((size_t)b * NCH_M + c) * 2 + d) * 8 + h) * 64 + p) * 128;
            c0[i] = cs[lane]; c1[i] = cs[lane + 64]; dc[i] = AL[(((size_t)b * NCH_M + c) * 2 + d) * 8 + h]; }
        float s0 = 0.f, s1 = 0.f;
#pragma unroll
        for (int i = 0; i < NCH_M; ++i) { const int c = d == 0 ? i : (i < 2 ? 1 - i : NCH_M + 1 - i);
            bf16* ss = (bf16*)(ws + WS_SSM) + (((((size_t)b * NCH_M + c) * 2 + d) * 8 + h) * 64 + p) * 128;
            ss[lane] = (unsigned short)f2bf(s0); ss[lane + 64] = (unsigned short)f2bf(s1); const float dec = __expf(dc[i]); s0 = dec * s0 + c0[i]; s1 = dec * s1 + c1[i]; }
    }
    float* CSG = (float*)(ws + WS_CSG); const float* GL = (const float*)(ws + WS_GLAST);
    for (int line = gw; line < BATCH * 2 * 4 * 64; line += NGW) {
        const int k = line & 63, h = (line >> 6) & 3, d = (line >> 8) & 1, b = line >> 9;
        float s0 = 0.f, s1 = 0.f;
#pragma unroll
        for (int half = 0; half < 2; ++half) {
            float c0[34], c1[34], dc[34];
#pragma unroll
            for (int ii = 0; ii < 34; ++ii) { const int i = half * 34 + ii; const int c = d == 0 ? i : (i < 4 ? 3 - i : NCH_G + 3 - i);
                const float* cs = CSG + (((((size_t)b * NCH_G + c) * 2 + d) * 4 + h) * 64 + k) * 128;
                c0[ii] = cs[lane]; c1[ii] = cs[lane + 64]; dc[ii] = GL[((((size_t)b * NCH_G + c) * 2 + d) * 4 + h) * 64 + k]; }
#pragma unroll
            for (int ii = 0; ii < 34; ++ii) { const int i = half * 34 + ii; const int c = d == 0 ? i : (i < 4 ? 3 - i : NCH_G + 3 - i);
                bf16* ss = (bf16*)(ws + WS_SSG) + (((((size_t)b * NCH_G + c) * 2 + d) * 4 + h) * 64 + k) * 128;
                ss[lane] = (unsigned short)f2bf(s0); ss[lane + 64] = (unsigned short)f2bf(s1); const float dec = __expf(dc[ii]); s0 = dec * s0 + c0[ii]; s1 = dec * s1 + c1[ii]; }
        }
    }
}

__device__ __forceinline__ void m3_mamba_item(KA A, LAS unsigned char* lds, int l, int item, int tid, int wave, int lane) {
    unsigned char* ws = A->ws; const bf16* P = (const bf16*)(ws + WS_P);
    const int cc = item >> 3, h = item & 7, g = h >> 2; const int b = cc / NCH_M, c = cc % NCH_M, row0 = b * TB + c * 128;
    const float* cw = A->in[I_MBCW] + (size_t)l * 3 * 1024; const float* cb = A->in[I_MBCB] + (size_t)l * 1024;
    lbf16* Sc = (lbf16*)lds; lbf16* Cc = (lbf16*)(lds + 33792);
    const bf16* CSM = (const bf16*)(ws + WS_SSM); const float* EA = (const float*)(ws + WS_EA);
    {   unsigned long long s[8]; ConvIn x[4]; float e0[4], e1[4]; const int v = tid & 15; ConvW w;
#pragma unroll
        for (int it = 0; it < 8; ++it) { const int task = tid + it * NTHR; const int d = task >> 11, p = (task >> 5) & 63, n4 = task & 31;
            s[it] = *(const GAS unsigned long long*)(CSM + (((((size_t)b * NCH_M + c) * 2 + d) * 8 + h) * 64 + p) * 128 + 4 * n4); }
#pragma unroll
        for (int it = 0; it < 4; ++it) { const int i = (tid >> 4) + 32 * it; convin_load(x[it], P, row0 + i, C_CM + 128 * g + 8 * v);
            e0[it] = EA[(size_t)(row0 + i) * 16 + h]; e1[it] = EA[(size_t)(row0 + i) * 16 + 8 + h]; }
        convw_load(w, cw, cb, 768 + 128 * g + 8 * v);
        SCHED_FENCE();
#pragma unroll
        for (int it = 0; it < 8; ++it) { const int task = tid + it * NTHR; const int d = task >> 11, p = (task >> 5) & 63, n4 = task & 31;
            *(LAS unsigned long long*)(Sc + p * 264 + d * 128 + 4 * n4) = s[it]; }
#pragma unroll
        for (int it = 0; it < 4; ++it) { const int i = (tid >> 4) + 32 * it; float o[8], o1[8]; conv8w(x[it], w, o);
#pragma unroll
            for (int e = 0; e < 8; ++e) { o1[e] = o[e] * e1[it]; o[e] *= e0[it]; }
            *(LAS v4u*)(Cc + i * 264 + 8 * v) = pack8(o); *(LAS v4u*)(Cc + i * 264 + 128 + 8 * v) = pack8(o1); }
    }
    __syncthreads();
    {   const int m0 = 32 * (wave >> 2), n0 = 32 * (wave & 3); Acc32 y; acc_zero(y);
        float* YMB = (float*)(ws + WS_YMB); f32x4 old[2][2];
#pragma unroll
        for (int a = 0; a < 2; ++a)
#pragma unroll
            for (int bq = 0; bq < 2; ++bq) { const int p = m0 + 16 * a + 4 * (lane >> 4), i = n0 + 16 * bq + (lane & 15); old[a][bq] = *(const GAS f32x4*)(YMB + (size_t)(row0 + i) * 512 + 64 * h + p); }
        SCHED_FENCE();
        wave_mma32(y, Sc, 264, Cc, 264, m0, n0, 256, lane);
#pragma unroll
        for (int a = 0; a < 2; ++a)
#pragma unroll
            for (int bq = 0; bq < 2; ++bq) { const int p = m0 + 16 * a + 4 * (lane >> 4), i = n0 + 16 * bq + (lane & 15); *(GAS f32x4*)(YMB + (size_t)(row0 + i) * 512 + 64 * h + p) = old[a][bq] + y.v[a][bq]; }
    }
    __syncthreads();
}
__device__ __forceinline__ void m3_gla_item(KA A, LAS unsigned char* lds, int item, int tid, int wave, int lane) {
    unsigned char* ws = A->ws;
    const int cgi = item >> 2, h = item & 3; const int b = cgi / NCH_G, c = cgi % NCH_G, row0 = b * TB + c * 64;
    lbf16* St = (lbf16*)lds; lbf16* Qc = (lbf16*)(lds + 34816);
    const bf16* CSG = (const bf16*)(ws + WS_SSG); const bf16* QE = (const bf16*)(ws + WS_QE);
    {   unsigned long long s[8]; v4u q[2];
#pragma unroll
        for (int it = 0; it < 8; ++it) { const int task = tid + it * NTHR; const int d = task >> 11, k = (task >> 5) & 63, v4 = task & 31;
            s[it] = *(const GAS unsigned long long*)(CSG + (((((size_t)b * NCH_G + c) * 2 + d) * 4 + h) * 64 + k) * 128 + 4 * v4); }
#pragma unroll
        for (int it = 0; it < 2; ++it) { const int task = tid + it * NTHR; const int i = task >> 4, d = (task >> 3) & 1, kv = task & 7;
            q[it] = *(const GAS v4u*)(QE + (size_t)(row0 + i) * 512 + d * 256 + 64 * h + 8 * kv); }
        SCHED_FENCE();
#pragma unroll
        for (int it = 0; it < 8; ++it) { const int task = tid + it * NTHR; const int d = task >> 11, k = (task >> 5) & 63, v4 = task & 31;
#pragma unroll
            for (int e = 0; e < 4; ++e) St[(4 * v4 + e) * 136 + tswz<15>(4 * v4 + e, d * 64 + k)] = (unsigned short)(s[it] >> (16 * e)); }
#pragma unroll
        for (int it = 0; it < 2; ++it) { const int task = tid + it * NTHR; const int i = task >> 4, d = (task >> 3) & 1, kv = task & 7; *(LAS v4u*)(Qc + i * 136 + d * 64 + 8 * kv) = q[it]; }
    }
    __syncthreads();
    {   const int m0 = 32 * (wave >> 1), n0 = 32 * (wave & 1); Acc32 o; acc_zero(o);
        float* YG = (float*)(ws + WS_YGLA); f32x4 old[2][2];
#pragma unroll
        for (int a = 0; a < 2; ++a)
#pragma unroll
            for (int bq = 0; bq < 2; ++bq) { const int v = m0 + 16 * a + 4 * (lane >> 4), i = n0 + 16 * bq + (lane & 15); old[a][bq] = *(const GAS f32x4*)(YG + (size_t)(row0 + i) * 512 + 128 * h + v); }
        SCHED_FENCE();
        wave_mma32<15, -1>(o, St, 136, Qc, 136, m0, n0, 128, lane);
#pragma unroll
        for (int a = 0; a < 2; ++a)
#pragma unroll
            for (int bq = 0; bq < 2; ++bq) { const int v = m0 + 16 * a + 4 * (lane >> 4), i = n0 + 16 * bq + (lane & 15); *(GAS f32x4*)(YG + (size_t)(row0 + i) * 512 + 128 * h + v) = old[a][bq] + o.v[a][bq]; }
    }
    __syncthreads();
}

struct M4Row { f32x4 y[2], o[2]; v4u zz, gz; };
__device__ __forceinline__ void m4_load(M4Row& r, const float* YMB, const float* YG, const bf16* P, int row, int lane) {
    const bf16* p = P + (size_t)row * NP; const int idx = 8 * lane;
#pragma unroll
    for (int hh = 0; hh < 2; ++hh) { r.y[hh] = *(const GAS f32x4*)(YMB + (size_t)row * 512 + idx + 4 * hh); r.o[hh] = *(const GAS f32x4*)(YG + (size_t)row * 512 + idx + 4 * hh); }
    r.zz = *(const GAS v4u*)(p + C_Z + idx); r.gz = *(const GAS v4u*)(p + C_G + idx);
}
__device__ __forceinline__ void m4_phase(KA A, int l, int wave, int lane, int bid, int G) {
    unsigned char* ws = A->ws; const bf16* P = (const bf16*)(ws + WS_P); bf16* YM = (bf16*)(ws + WS_YMIX);
    const float* YMB = (const float*)(ws + WS_YMB); const float* YG = (const float*)(ws + WS_YGLA);
    const float* mng = A->in[I_MBNG] + (size_t)l * 512; const float* gng = A->in[I_GLANG] + (size_t)l * 128;
    const int idx = 8 * lane;
    f32x4 mg[2], gn[2];
#pragma unroll
    for (int hh = 0; hh < 2; ++hh) { mg[hh] = *(const GAS f32x4*)(mng + idx + 4 * hh); gn[hh] = *(const GAS f32x4*)(gng + ((idx + 4 * hh) & 127)); }
    const int stride = G * NWAVES; int row = bid * NWAVES + wave;
    M4Row cur, nxt; if (row < MR) m4_load(cur, YMB, YG, P, row, lane);
    for (; row < MR; row += stride) {
        if (row + stride < MR) m4_load(nxt, YMB, YG, P, row + stride, lane);
        float z[8], g[8]; unpack8(cur.zz, z); unpack8(cur.gz, g);
        float y[8]; float ss = 0.f;
#pragma unroll
        for (int e = 0; e < 8; ++e) { y[e] = cur.y[e >> 2][e & 3] * silu_f(z[e]); ss += y[e] * y[e]; }
        const float r = __builtin_amdgcn_rsqf(wave_sum(ss) * (1.f / 512.f) + EPS);
        float o1[8];
#pragma unroll
        for (int e = 0; e < 8; ++e) o1[e] = y[e] * r * mg[e >> 2][e & 3];
        *(GAS v4u*)(YM + (size_t)row * D + 1024 + idx) = pack8(o1);
        float q = 0.f;
#pragma unroll
        for (int e = 0; e < 8; ++e) { const float ov = cur.o[e >> 2][e & 3]; q += ov * ov; }
        const float rr = __builtin_amdgcn_rsqf(row16_sum(q) * (1.f / 128.f) + EPS);
        float o2[8];
#pragma unroll
        for (int e = 0; e < 8; ++e) o2[e] = cur.o[e >> 2][e & 3] * rr * gn[e >> 2][e & 3] * silu_f(g[e]);
        *(GAS v4u*)(YM + (size_t)row * D + 1536 + idx) = pack8(o2);
        cur = nxt;
    }
}

__device__ __forceinline__ void dispatch_phase(KA A, LAS unsigned char* lds, int tid, int wave, int lane, int bid) {
    unsigned char* ws = A->ws;
    LAS int* cnt = (LAS int*)lds;
    LAS int* tab = cnt + 2048;
    const int* gc = (const int*)(ws + WS_CNT);
    { int c4[4];
#pragma unroll
      for (int it = 0; it < 4; ++it) c4[it] = gc[tid + it * NTHR];
      SCHED_FENCE();
#pragma unroll
      for (int it = 0; it < 4; ++it) cnt[tid + it * NTHR] = c4[it]; }
    __syncthreads();
    if (tid < 8) { int tot = 0, pre = 0; for (int w = 0; w < 256; ++w) { const int v = cnt[w * 8 + tid]; if (w < bid) pre += v; tot += v; } tab[8 + tid] = pre; tab[32 + tid] = (tot + 255) >> 8; }
    __syncthreads();
    if (tid == 0) { int tb = 0; for (int e = 0; e < 8; ++e) { tab[16 + e] = tb; tab[e] = tb * 256; tb += tab[32 + e]; } tab[24] = tb;
        if (bid == 0) { int* mi = (int*)(ws + WS_MOEINFO); for (int e = 0; e < 9; ++e) mi[e] = tab[16 + e]; } }
    __syncthreads();
    const int4* route = (const int4*)(ws + WS_ROUTE); int* tokpos = (int*)(ws + WS_TOKPOS);
    const bf16* XN = (const bf16*)(ws + WS_XN); bf16* AP = (bf16*)(ws + WS_APERM);
    {   int4 rr[4]; v4u xv[4][2];
#pragma unroll
        for (int k = 0; k < 4; ++k) { const int row = wg_row(bid, wave + NWAVES * k); rr[k] = route[row]; const GAS v4u* src = (const GAS v4u*)((const unsigned char*)XN + (size_t)row * D);
#pragma unroll
            for (int j = 0; j < 2; ++j) xv[k][j] = src[lane + 64 * j]; }
        SCHED_FENCE();
#pragma unroll
        for (int k = 0; k < 4; ++k) { const int row = wg_row(bid, wave + NWAVES * k); const int4 r = rr[k]; const int e1 = r.x & 15, e2 = (r.x >> 4) & 15, r1 = (r.x >> 8) & 255, r2 = (r.x >> 16) & 255;
            const int p1 = tab[e1] + tab[8 + e1] + r1, p2 = tab[e2] + tab[8 + e2] + r2;
            if (lane == 0) { tokpos[row * 2] = p1; tokpos[row * 2 + 1] = p2; }
            GAS v4u* d1 = (GAS v4u*)((unsigned char*)AP + (size_t)p1 * D); GAS v4u* d2 = (GAS v4u*)((unsigned char*)AP + (size_t)p2 * D);
#pragma unroll
            for (int j = 0; j < 2; ++j) { d1[lane + 64 * j] = xv[k][j]; d2[lane + 64 * j] = xv[k][j]; } }
    }
    __syncthreads();
}

__device__ __forceinline__ void combine_phase(KA A, int l, int wave, int lane, int bid, int G) {
    unsigned char* ws = A->ws; const bf16* H = (const bf16*)(ws + WS_H); const bf16* DO = (const bf16*)(ws + WS_DOUT); const bf16* DO2 = (const bf16*)(ws + WS_DOUT2);
    const int4* route = (const int4*)(ws + WS_ROUTE); const int* tokpos = (const int*)(ws + WS_TOKPOS);
    const int2* TT2 = (const int2*)(ws + WS_TT); const bf16* XT = (const bf16*)(ws + WS_XT);
    const float* modl = (const float*)(ws + WS_MODF) + (size_t)l * 3 * ADAW; const float* gf = A->in[I_GFINAL];
    for (int row = bid * NWAVES + wave; row < MR; row += G * NWAVES) { const int b = row / TB, s = row % TB; if (s < CTXL) continue;
        const int4 r = route[row]; const float w1 = __int_as_float(r.y), w2 = __int_as_float(r.z); const int p1 = tokpos[row * 2], p2 = tokpos[row * 2 + 1];
        const GAS v4u* a1 = (const GAS v4u*)(DO + (size_t)p1 * D) + lane; const GAS v4u* a2 = (const GAS v4u*)(DO + (size_t)p2 * D) + lane; const GAS v4u* a3 = (const GAS v4u*)(DO2 + (size_t)p1 * D) + lane; const GAS v4u* a4 = (const GAS v4u*)(DO2 + (size_t)p2 * D) + lane;
        const GAS v4u* hr = (const GAS v4u*)(H + (size_t)row * D) + lane; const float* gt = modl + (size_t)b * ADAW + 5 * D + 8 * lane;
        float v[4][8]; float ss = 0.f;
#pragma unroll
        for (int j = 0; j < 4; ++j) { float e1[8], e2[8], e3[8], e4[8]; unpack8(a1[64 * j], e1); unpack8(a2[64 * j], e2); unpack8(a3[64 * j], e3); unpack8(a4[64 * j], e4);
            {
                const int n = 2 * j + (lane >> 5); const int2 t1 = TT2[(p1 >> 8) * 8 + n], t2 = TT2[(p2 >> 8) * 8 + n];
#define CMB_TAIL(tt, p, ev) if (tt) { const int sl = (tt) >> 3, S_ = (tt) & 7; for (int q = 1; q < S_; ++q) { float t8[8]; \
                    unpack8(*(const GAS v4u*)(XT + ((size_t)((sl * 3 + q - 1) * 256 + ((p) & 255)) * 256 + ((8 * lane) & 255))), t8); _Pragma("unroll") for (int e = 0; e < 8; ++e) ev[e] += t8[e]; } }
                CMB_TAIL(t1.x, p1, e1) CMB_TAIL(t1.y, p1, e3) CMB_TAIL(t2.x, p2, e2) CMB_TAIL(t2.y, p2, e4)
#undef CMB_TAIL
            }
            float hf[8]; unpack8(hr[64 * j], hf); const f32x4 g0 = *(const GAS f32x4*)(gt + 512 * j), g1 = *(const GAS f32x4*)(gt + 512 * j + 4);
#pragma unroll
            for (int e = 0; e < 8; ++e) { const float hh = hf[e], gg = e < 4 ? g0[e] : g1[e - 4]; v[j][e] = hh + gg * ((e1[e] + e3[e]) * w1 + (e2[e] + e4[e]) * w2); ss += v[j][e] * v[j][e]; } }
        const float rstd = __builtin_amdgcn_rsqf(wave_sum(ss) * (1.f / D) + EPS);
        float* o = A->out + (size_t)(b * SEQ + s - CTXL) * D + 8 * lane; const float* gfv = gf + 8 * lane;
#pragma unroll
        for (int j = 0; j < 4; ++j) { const f32x4 f0 = *(const GAS f32x4*)(gfv + 512 * j), f1 = *(const GAS f32x4*)(gfv + 512 * j + 4);
            *(GAS f32x4*)(o + 512 * j) = (f32x4){v[j][0] * rstd * f0[0], v[j][1] * rstd * f0[1], v[j][2] * rstd * f0[2], v[j][3] * rstd * f0[3]};
            *(GAS f32x4*)(o + 512 * j + 4) = (f32x4){v[j][4] * rstd * f1[0], v[j][5] * rstd * f1[1], v[j][6] * rstd * f1[2], v[j][7] * rstd * f1[3]}; }
    }
}
constexpr int CT_INPROJ0_HI = 8596, CT_FFNUP_HI = 19596, CT_INPROJ1_HI = 25600;
__device__ __forceinline__ void ph_inproj(LAS unsigned char* lds, unsigned char* ws, int l, int bid, int tid) {
    pg8::Gemm g{(const pg8::bf16_t*)(ws + WS_XN), (const pg8::bf16_t*)(ws + WS_WIN) + (size_t)l * NP * D, MR, NP, D};
    pg8::MixOrder<NP / 256, D / 64, 1, D, 12, 10, true> S{l ? 32 : NMT, bid, l, l ? 24 : 0, pg8::ConvHook{l ? CT_FFNUP_HI : CT_P0A_HI, l ? CT_INPROJ1_HI : CT_INPROJ0_HI, bid & 1}};
    pg8::EpiP E{ws};
    pg8::gemm_phase<pg8::EpiP, decltype(S), true, true>(lds + RING_OFF, g, S, E, tid);
}
__device__ __forceinline__ void ph_outproj(LAS unsigned char* lds, unsigned char* ws, const float* x, int l, int bid, int tid) {
    pg8::Gemm g{(const pg8::bf16_t*)(ws + WS_YMIX), (const pg8::bf16_t*)(ws + WS_WOUT) + (size_t)l * D * D, MR, D, D};
    pg8::MixOrder<D / 256, D / 64, 4, 512, 8, 0> S{32, bid, 1, l == 0 ? 16 : 0, pg8::ConvHook{0, 0, -1}};
    pg8::EpiRes E{ws, l == 0 ? x : nullptr, l, 2};
    pg8::gemm_phase<pg8::EpiRes, decltype(S), true, true>(lds + RING_OFF, g, S, E, tid);
}
__device__ __forceinline__ void ph_ffnup(LAS unsigned char* lds, unsigned char* ws, int bid, int tid) {
    pg8::Gemm g{(const pg8::bf16_t*)(ws + WS_XN), (const pg8::bf16_t*)(ws + WS_FUP), MR, 2 * FF, D};
    pg8::MixOrder<2 * FF / 256, D / 64, 1, D, 1, 0, true> S{NMT, bid, 0, 0, pg8::ConvHook{CT_INPROJ0_HI, CT_FFNUP_HI, bid % 5}};
    pg8::EpiSwiglu E{(pg8::bf16_t*)(ws + WS_ACT), FF, 2 * FF / 256};
    pg8::gemm_phase<pg8::EpiSwiglu, decltype(S), true, true>(lds + RING_OFF, g, S, E, tid);
}
__device__ __forceinline__ void ph_ffndn(LAS unsigned char* lds, unsigned char* ws, int bid, int tid) {
    pg8::Gemm g{(const pg8::bf16_t*)(ws + WS_ACT), (const pg8::bf16_t*)(ws + WS_FDN), MR, D, FF};
    pg8::MixOrder<D / 256, FF / 64, 11, 512, 8, 0> S{32, bid, 1, 16, pg8::ConvHook{0, 0, -1}};
    pg8::EpiRes E{ws, nullptr, 0, 5};
    pg8::gemm_phase<pg8::EpiRes, decltype(S), true, true>(lds + RING_OFF, g, S, E, tid);
}
__device__ __forceinline__ void ph_moeup(LAS unsigned char* lds, unsigned char* ws, int bid, int tid) {
    pg8::Gemm g{(const pg8::bf16_t*)(ws + WS_APERM), (const pg8::bf16_t*)(ws + WS_MUP), 0, 0, D};
    pg8::MoeOrder<2 * FFE / 256, 1, D, 128> S{(const int*)(ws + WS_MOEINFO), bid};
    pg8::EpiSwiglu8 E{ws + WS_ACTM, FFE, 2 * FFE / 256};
    static_assert(ACT8_SCALE == 4.f && SC_W8UP == SC_W8 + 0x02020202, "the up half's block scale carries ACT8_SCALE");
    pg8::gemm_phase_f8<pg8::EpiSwiglu8, decltype(S), SC_W8, SC_XN8, SC_W8UP>(lds + RING_OFF, g, S, E, tid);
}
__device__ __forceinline__ void ph_moedn(LAS unsigned char* lds, unsigned char* ws, int bid, int tid) {
    pg8::Gemm g{(const pg8::bf16_t*)(ws + WS_ACTM), (const pg8::bf16_t*)(ws + WS_MDN), 0, 0, FFE};
    pg8::MoeOrder<D / 256, 2, FFE / 2, 128> S{(const int*)(ws + WS_MOEINFO), bid};
    pg8::EpiBf16g8 E{(pg8::bf16_t*)(ws + WS_DOUT), (pg8::bf16_t*)(ws + WS_DOUT2), (pg8::bf16_t*)(ws + WS_XT), (int*)(ws + WS_TT), D, D / 256};
    pg8::gemm_phase_f8<pg8::EpiBf16g8, decltype(S), SC_W8, SC_ACT8>(lds + RING_OFF, g, S, E, tid);
}

#ifndef MK_PER_PHASE
#define MK_PER_PHASE 0
#endif
constexpr int NPH = 24;
__global__ void __launch_bounds__(NTHR, 2) mk_fwd(Args args_unused) {
    extern __shared__ __attribute__((aligned(16))) unsigned char lds_raw[];
    LAS unsigned char* lds = (LAS unsigned char*)lds_raw;
    const int tid0 = threadIdx.x, bid0 = blockIdx.x, G0 = gridDim.x;
#define FRESH() int tid = tid0; asm volatile("" : "+v"(tid)); int bid = bid0, G = G0; asm volatile("" : "+s"(bid), "+s"(G)); const int lane = tid & 63, wave = __builtin_amdgcn_readfirstlane(tid >> 6); (void)lane; (void)wave; (void)bid; (void)G
    const int tid = tid0;
    volatile LAS unsigned* MISC = (volatile LAS unsigned*)(lds + MISC_OFF);
    for (int u = tid; u < (LDS_BYTES - LDSCTL_OFF) / 4; u += NTHR) ((LAS unsigned*)(lds + LDSCTL_OFF))[u] = 0u;
    __syncthreads();
    int lo, hi;
    XcdBarrier bar;
    { FRESH(); KA A = ka_get(); lo = A->ph_lo; hi = A->ph_hi; gu32* ctl = (gu32*)(A->ws + WS_CTL);
      bar.bar = (unsigned*)(ctl + CW_BAR); bar.x = 0; bar.st = nullptr;
      if (!MK_PER_PHASE) bar = xcd_barrier_post((unsigned*)(ctl + CW_BAR), MISC + 8); }
#define IN(k) (lo <= (k) && (k) < hi)
#define SEAM(k) do { if (!MK_PER_PHASE && IN(k) && IN((k) + 1)) xcd_barrier(bar); } while (0)

    if (IN(0)) { FRESH(); KA A = ka_get(); p0a_phase(A, lds, tid, wave, lane, bid, G); SEAM(0); }
    if (IN(1)) { FRESH(); KA A = ka_get(); p0b_phase(A, tid, bid, G); SEAM(1); }

    for (int l = 0; l < 2; ++l) {
        const int pb = 2 + 10 * l;
        if (IN(pb + 0)) { FRESH(); KA A = ka_get(); norm_phase<false, true>(A, lds, l, 0, l ? 11 : 0, (const float*)(A->ws + WS_MODF) + 2 * ADAW + 5 * D, tid, wave, lane, bid); SEAM(pb + 0); }
        if (IN(pb + 1)) { FRESH(); KA A = ka_get(); ph_inproj(lds, A->ws, l, bid, tid); SEAM(pb + 1); }
        if (IN(pb + 2)) {
            { const int c = bid0;
              for (int k = 0; k < 5; ++k) { FRESH(); KA A = ka_get(); int ty = -1, ix = 0;
                if (c < 136) { if (k == 0) { ty = 0; ix = c; } else if (c < 32) { if (k == 1) { ty = 2; ix = 240 + c; } } else if (c < 124) { if (k < 3) { ty = 1; ix = 360 + (c - 32) * 2 + (k - 1); } } }
                else { if (k < 3) { ty = 1; ix = (c - 136) * 3 + k; } else { ty = 2; ix = (c - 136) * 2 + (k - 3); } }
                if (ty == 0) m1_mamba_group(A, lds, l, ix, tid, wave, lane);
                else if (ty == 1) m1_gla_item(A, lds, l, ix, tid, wave, lane);
                else if (ty == 2) m1_sccm_item(A, lds, l, ix, tid, wave, lane); } }
            SEAM(pb + 2);
        }
        if (IN(pb + 3)) { FRESH(); KA A = ka_get(); m2_phase(A, wave, lane, bid, G); SEAM(pb + 3); }
        if (IN(pb + 4)) {
            { const int c = bid0;
              for (int k = 0; k < 5; ++k) { FRESH(); KA A = ka_get(); int ty = -1, ix = 0;
                if (k == 0) { ty = 0; ix = c; } else if (k == 1) { ty = 0; ix = c + 256; }
                else if (k == 2) { if (c < 32) { ty = 0; ix = c + 512; } else { ty = 1; ix = c; } }
                else if (k == 3) { ty = 1; ix = c < 32 ? c : 224 + c; }
                else { if (c >= 32 && c < 96) { ty = 1; ix = 448 + c; } }
                if (ty == 0) m3_mamba_item(A, lds, l, ix, tid, wave, lane);
                else if (ty == 1) m3_gla_item(A, lds, ix, tid, wave, lane); } }
            SEAM(pb + 4);
        }
        if (IN(pb + 5)) { FRESH(); KA A = ka_get(); m4_phase(A, l, wave, lane, bid, G); SEAM(pb + 5); }
        if (IN(pb + 6)) { FRESH(); KA A = ka_get(); ph_outproj(lds, A->ws, A->in[I_X], l, bid, tid); SEAM(pb + 6); }
        if (l == 0) {
            if (IN(9)) { FRESH(); KA A = ka_get(); norm_phase<false, false>(A, lds, 0, 1, 4, (const float*)(A->ws + WS_MODF) + 2 * ADAW + 2 * D, tid, wave, lane, bid); SEAM(9); }
            if (IN(10)) { FRESH(); KA A = ka_get(); ph_ffnup(lds, A->ws, bid, tid); SEAM(10); }
            if (IN(11)) { FRESH(); KA A = ka_get(); ph_ffndn(lds, A->ws, bid, tid); SEAM(11); }
        } else {
            if (IN(19)) { FRESH(); KA A = ka_get(); norm_phase<true, false>(A, lds, 1, 1, 0, nullptr, tid, wave, lane, bid); SEAM(19); }
            if (IN(20)) { FRESH(); KA A = ka_get(); dispatch_phase(A, lds, tid, wave, lane, bid); SEAM(20); }
            if (IN(21)) { FRESH(); KA A = ka_get(); ph_moeup(lds, A->ws, bid, tid); SEAM(21); }
            if (IN(22)) { FRESH(); KA A = ka_get(); ph_moedn(lds, A->ws, bid, tid); SEAM(22); }
            if (IN(23)) { FRESH(); KA A = ka_get(); combine_phase(A, 1, wave, lane, bid, G); }
        }
    }
#undef IN
#undef SEAM
}

extern "C" void kernel_launch(void* const* d_in, const int* in_sizes, int n_in, void* d_out, int out_size, void* d_ws, size_t ws_size, hipStream_t stream) {
    static int grid = 0;
    if (grid == 0) {
        if (n_in != N_IN || out_size != BATCH * SEQ * D || ws_size < WS_END) { fprintf(stderr, "kernel_launch: unexpected shapes: n_in %d out %d ws %zu (need %zu)\n", n_in, out_size, ws_size, (size_t)WS_END); grid = -1; return; }
        int dev = 0, cus = 0, per_cu = 0;
        if (hipGetDevice(&dev) != hipSuccess || hipDeviceGetAttribute(&cus, hipDeviceAttributeMultiprocessorCount, dev) != hipSuccess) { grid = -1; return; }
        if (hipFuncSetAttribute((const void*)mk_fwd, hipFuncAttributeMaxDynamicSharedMemorySize, LDS_BYTES) != hipSuccess) { fprintf(stderr, "kernel_launch: hipFuncSetAttribute failed\n"); grid = -1; return; }
        if (hipOccupancyMaxActiveBlocksPerMultiprocessor(&per_cu, (const void*)mk_fwd, NTHR, LDS_BYTES) != hipSuccess || per_cu < 1) fprintf(stderr, "kernel_launch: occupancy query says %d\n", per_cu);
        (void)hipGetLastError();
        grid = cus;
        if (grid != 256) { fprintf(stderr, "kernel_launch: built for 256 CUs, device has %d\n", grid); grid = -1; return; }
    }
    if (grid < 0) return;
    if (hipMemsetAsync((char*)d_ws + WS_CTL, 0, CTL_ZERO_BYTES, stream) != hipSuccess) return;
    Args a{};
    for (int i = 0; i < N_IN; ++i) a.in[i] = (const float*)d_in[i];
    a.out = (float*)d_out; a.ws = (unsigned char*)d_ws;
#if MK_PER_PHASE
    for (int p = 0; p < NPH; ++p) { a.ph_lo = p; a.ph_hi = p + 1; hipLaunchKernelGGL(mk_fwd, dim3(grid), dim3(NTHR), LDS_BYTES, stream, a); }
#else
    a.ph_lo = 0; a.ph_hi = NPH; hipLaunchKernelGGL(mk_fwd, dim3(grid), dim3(NTHR), LDS_BYTES, stream, a);
#endif
    const hipError_t le = hipPeekAtLastError();
    if (le != hipSuccess) fprintf(stderr, "kernel_launch: launch failed: %s\n", hipGetErrorName(le));
}
```

```cpp
#include <hip/hip_runtime.h>
#include <cstdio>
#include <cstdint>
namespace pg8 {
#define PG8_LAS __attribute__((address_space(3)))
typedef unsigned short bf16_t;
typedef short bf16x8 __attribute__((ext_vector_type(8)));
typedef float f32x4 __attribute__((ext_vector_type(4)));
typedef unsigned u32x4 __attribute__((ext_vector_type(4)));
constexpr int BM = 256, BK = 64, HALF = 128, HTB = HALF * BK * 2  , STAGE_BYTES = 8 * HTB, NXCD = 8, WGM = 8;

__host__ __device__ __forceinline__ int lds_byte(int r, int c) { const int st = (r >> 4) * 2 + (c >> 5), rr = r & 15, cc = c & 31, ob = rr * 64 + cc * 2; return st * 1024 + (ob ^ (((ob >> 9) & 1) << 5)); }
__host__ __device__ __forceinline__ void stage_rc(int b, int& R, int& C) { const int st = b / 1024, sb = b % 1024, swz = sb ^ (((sb >> 9) & 1) << 5); R = (st >> 1) * 16 + swz / 64; C = (st & 1) * 32 + (swz % 64) / 2; }
__host__ __device__ __forceinline__ int perm32(int rho) { const int n = rho >> 4, i = rho & 15; return 8 * (i >> 2) + 4 * n + (i & 3); }

struct Unit { int pm, pn, k0, nt, dst, tt; };
struct Gemm { const bf16_t* A; const bf16_t* Bt; int M, N, K; };
struct ConvHook { int t0, t1, trig; };
template <int NSLOT, bool MOE> __device__ __forceinline__ void conv_burst(const ConvHook& h, int bid, PG8_LAS unsigned char* T, int tid);

__device__ __forceinline__ unsigned cvt_pk_bf16(float lo, float hi) { unsigned r; asm volatile("v_cvt_pk_bf16_f32 %0, %1, %2" : "=v"(r) : "v"(lo), "v"(hi)); return r; }
typedef float f32x2 __attribute__((ext_vector_type(2)));
constexpr int GRID = 256;
template <int NN, int NTF, int PPU, int PK, int XCOLS, int XPN0, bool HOOK = false>
struct MixOrder {
    int nM, c, skipctx, nx; ConvHook cv;
    __device__ bool next(int i, Unit& u) const {
        const int L = i * GRID + c, nwg = nM * NN;
        if (L >= nwg) { const int idx = L - nwg; if (idx >= nx * PPU) return false;
            const int piece = idx % PPU, un = idx / PPU; u.pm = (un / XCOLS) ? 17 : 0; u.pn = XPN0 + un % XCOLS; u.k0 = piece * PK; u.nt = PK / BK; return true; }
        int wgid = L; { const int q = nwg / NXCD, r = nwg % NXCD, xcd = wgid % NXCD, off = wgid / NXCD; wgid = (xcd < r ? xcd * (q + 1) : r * (q + 1) + (xcd - r) * q) + off; }
        const int nig = WGM * NN, gid = wgid / nig, fm = gid * WGM, gsz = (nM - fm) < WGM ? (nM - fm) : WGM;
        int pm = fm + ((wgid % nig) % gsz); u.pn = (wgid % nig) / gsz;
        if (skipctx) pm = pm + 1 + (pm >= 16 ? 1 : 0);
        u.pm = pm; u.k0 = 0; u.nt = NTF; return true;
    }
    __device__ __forceinline__ void a_ready(const Unit&) const {}
    __device__ __forceinline__ void done(const Unit&, int ui, PG8_LAS unsigned char* lds, int tid) const { if constexpr (HOOK) { if (ui == cv.trig) conv_burst<4, true>(cv, c, lds + 131072, tid); } }
};
template <int NT, int KS, int PK, int KT, bool HOOK = false>
struct MoeOrder {
    int mi[9]; int c; ConvHook cv;
    __device__ __forceinline__ MoeOrder(const int* p, int c_) : c(c_), cv{} {
#pragma unroll
        for (int j = 0; j < 9; ++j) mi[j] = __builtin_amdgcn_readfirstlane(p[j]); }
    __device__ bool next(int i, Unit& u) const {
        const int U = mi[8] * NT * KS, x = c & 7, q = U >> 3, r = U & 7;
        const int start = x * q + (x < r ? x : r), len = q + (x < r ? 1 : 0), j = c >> 3;
        int k = i * 32 + j, sub = 0, S = 1, slot = 0;
        if constexpr (KS == 2) {
            const int full = len & ~31, tl = len - full;
            if (i * 32 >= full) {
                if (i * 32 > full || tl == 0) return false;
                S = tl <= 8 ? 4 : (tl <= 16 ? 2 : 1);
                if (j >= tl * S) return false;
                const int ju = j % tl; k = full + ju; sub = j / tl; slot = x * 16 + ju; }
        } else { if (k >= len) return false; }
        const int L = start + k;
        int t0 = mi[0], t1 = mi[1], e = 0;
#pragma unroll
        for (int j = 1; j < 8; ++j) { const bool ge = L >= mi[j] * NT * KS; t0 = ge ? mi[j] : t0; t1 = ge ? mi[j + 1] : t1; e += ge ? 1 : 0; }
        const int me = t1 - t0, local = L - t0 * NT * KS;
        const int m = local % me, rest = local / me, n = rest % NT, piece = rest / NT;
        int kt0 = 0, ntk = PK / KT;
        if constexpr (KS == 2) { static_assert(PK / KT == 28, "tail split assumes 28 K-tiles per piece");
            if (S == 4) { kt0 = (sub >> 1) * 14 + (sub & 1) * 8; ntk = (sub & 1) ? 6 : 8; } else if (S == 2) { kt0 = 14 * sub; ntk = 14; } }
        u.pm = t0 + m; u.pn = e * NT + n; u.k0 = piece * PK + kt0 * KT; u.nt = ntk;
        u.dst = sub == 0 ? piece : 2 + slot * 3 + (sub - 1); u.tt = (S > 1 && sub == 0) ? ((slot << 3) | S) : 0; return true;
    }
    __device__ __forceinline__ void a_ready(const Unit&) const {}
    __device__ __forceinline__ void done(const Unit&, int ui, PG8_LAS unsigned char* lds, int tid) const { if constexpr (HOOK) { if (ui == cv.trig) conv_burst<4, true>(cv, c, lds + 131072, tid); } }
};
template <class Epi, class Sched, bool ALIGN_EPI = false, bool SP2 = false>
__device__ __forceinline__ void gemm_phase(PG8_LAS unsigned char* lds, const Gemm g, const Sched& S, const Epi& E, const int tid) {
    const int wid = __builtin_amdgcn_readfirstlane(tid >> 6), lane = tid & 63, wr = wid >> 2, wc = wid & 3, fr = lane & 15, fq = lane >> 4;
    const int K = g.K; int nt;
    unsigned voffA[2], voffB[2];
#pragma unroll
    for (int i = 0; i < 2; ++i) { int R, C; stage_rc(tid * 16 + i * 8192, R, C); const int Rb = Epi::PERM ? ((R & ~31) + perm32(R & 31)) : R;
        voffA[i] = (unsigned)(R * K + C) * 2u; voffB[i] = (unsigned)(Rb * K + C) * 2u; }
    const size_t kstep = (size_t)(BK * 2);
    const size_t hstep = (size_t)HALF * K * 2;
    const size_t tstep = 2 * hstep;
    const unsigned ldsw = (unsigned)wid * 1024u;
    const int aoff = lds_byte(wr * 64 + fr, fq * 8), boff = lds_byte(wc * 32 + fr, fq * 8);
#define PG8_SA(b, h) (((b) * 2 + (h)) * HTB)
#define PG8_SB(b, h) ((4 + (b) * 2 + (h)) * HTB)
#define PG8_STAGE(bufoff, gbase, voff) do { _Pragma("unroll") for (int _i = 0; _i < 2; ++_i) \
        __builtin_amdgcn_global_load_lds((const unsigned*)((const char*)(gbase) + (voff)[_i]), (PG8_LAS unsigned*)(lds + (bufoff) + ldsw + _i * 8192), 16, 0, 0); } while (0)
#define PG8_LDA(dst, b, h) do { _Pragma("unroll") for (int m = 0; m < 4; ++m) _Pragma("unroll") for (int k = 0; k < 2; ++k) dst[m][k] = *(const PG8_LAS bf16x8*)(lds + PG8_SA(b, h) + aoff + m * 2048 + k * 1024); } while (0)
#define PG8_LDB(dst, b, h) do { _Pragma("unroll") for (int n = 0; n < 2; ++n) _Pragma("unroll") for (int k = 0; k < 2; ++k) dst[n][k] = *(const PG8_LAS bf16x8*)(lds + PG8_SB(b, h) + boff + n * 2048 + k * 1024); } while (0)
#define PG8_MMA(ai, bj, At, Bt) do { __builtin_amdgcn_s_setprio(1); _Pragma("unroll") for (int m = 0; m < 4; ++m) _Pragma("unroll") for (int n = 0; n < 2; ++n) _Pragma("unroll") for (int k = 0; k < 2; ++k) \
        acc[ai][bj][m][n] = __builtin_amdgcn_mfma_f32_16x16x32_bf16(Bt[n][k], At[m][k], acc[ai][bj][m][n], 0, 0, 0); __builtin_amdgcn_s_setprio(0); } while (0)
#define PG8_WAIT_V(n) asm volatile("s_waitcnt vmcnt(" #n ")" ::: "memory")
#define PG8_WAIT_L(n) asm volatile("s_waitcnt lgkmcnt(" #n ")" ::: "memory")
#define PG8_BAR __builtin_amdgcn_s_barrier()
#define PG8_SCHED __builtin_amdgcn_sched_barrier(0)
    Unit cur, nxt; int ui = 0;
    if (!S.next(0, cur)) return;
    f32x4 acc[2][2][4][2];
#pragma unroll
    for (int a = 0; a < 2; ++a)
#pragma unroll
        for (int b = 0; b < 2; ++b)
#pragma unroll
            for (int m = 0; m < 4; ++m)
#pragma unroll
                for (int n = 0; n < 2; ++n) acc[a][b][m][n] = (f32x4){0.f, 0.f, 0.f, 0.f};
    bf16x8 At[4][2], B0[2][2], B1[2][2];
    const char* cA = (const char*)g.A + (size_t)cur.pm * tstep + (size_t)cur.k0 * 2; const char* cB = (const char*)g.Bt + (size_t)cur.pn * tstep + (size_t)cur.k0 * 2; nt = cur.nt;
    S.a_ready(cur);
    if constexpr (SP2) {
        PG8_STAGE(PG8_SB(0, 0), cB, voffB); PG8_STAGE(PG8_SB(0, 1), cB + hstep, voffB); PG8_STAGE(PG8_SA(0, 0), cA, voffA); PG8_STAGE(PG8_SA(0, 1), cA + hstep, voffA);
        if (wr == 1) PG8_BAR;
        PG8_WAIT_V(2); PG8_BAR;
        PG8_STAGE(PG8_SB(1, 0), cB + kstep, voffB); PG8_STAGE(PG8_SA(1, 0), cA + kstep, voffA); PG8_STAGE(PG8_SB(1, 1), cB + hstep + kstep, voffB);
        PG8_WAIT_V(6); PG8_BAR;
    } else {
        PG8_STAGE(PG8_SB(0, 0), cB, voffB); PG8_STAGE(PG8_SA(0, 0), cA, voffA); PG8_STAGE(PG8_SB(0, 1), cB + hstep, voffB); PG8_STAGE(PG8_SA(0, 1), cA + hstep, voffA);
        if (wr == 1) PG8_BAR;
        PG8_WAIT_V(4); PG8_BAR;
        PG8_STAGE(PG8_SB(1, 0), cB + kstep, voffB); PG8_STAGE(PG8_SA(1, 0), cA + kstep, voffA); PG8_STAGE(PG8_SB(1, 1), cB + hstep + kstep, voffB);
        PG8_WAIT_V(6); PG8_BAR;
    }
    for (;;) {
        const bool has_next = S.next(ui + 1, nxt);
        const char* nA = has_next ? (const char*)g.A + (size_t)nxt.pm * tstep + (size_t)nxt.k0 * 2 : cA; const char* nB = has_next ? (const char*)g.Bt + (size_t)nxt.pn * tstep + (size_t)nxt.k0 * 2 : cB;
        for (int t = 0; t < nt; t += 2) {
            const bool last = (t == nt - 2);
            const char* a1 = cA + (size_t)(t + 1) * kstep;
            const char* a2 = last ? nA : cA + (size_t)(t + 2) * kstep; const char* b2 = last ? nB : cB + (size_t)(t + 2) * kstep;
            const char* a3 = a2 + kstep; const char* b3 = b2 + kstep;
            if (last && has_next) S.a_ready(nxt);
            if constexpr (SP2) {
            PG8_LDB(B0, 0, 0); PG8_LDB(B1, 0, 1); PG8_SCHED; PG8_LDA(At, 0, 0); PG8_STAGE(PG8_SA(1, 1), a1 + hstep, voffA);
            PG8_WAIT_V(8); PG8_WAIT_L(0); PG8_BAR; PG8_MMA(0, 0, At, B0); PG8_MMA(0, 1, At, B1); PG8_BAR; PG8_SCHED;
            PG8_LDA(At, 0, 1); PG8_STAGE(PG8_SB(0, 0), b2, voffB); PG8_STAGE(PG8_SB(0, 1), b2 + hstep, voffB); PG8_STAGE(PG8_SA(0, 0), a2, voffA);
            PG8_WAIT_V(8); PG8_WAIT_L(0); PG8_BAR; PG8_MMA(1, 0, At, B0); PG8_MMA(1, 1, At, B1); PG8_BAR; PG8_SCHED;
            PG8_LDB(B0, 1, 0); PG8_LDB(B1, 1, 1); PG8_SCHED; PG8_LDA(At, 1, 0); PG8_STAGE(PG8_SA(0, 1), a2 + hstep, voffA);
            PG8_WAIT_V(8); PG8_WAIT_L(0); PG8_BAR; PG8_MMA(0, 0, At, B0); PG8_MMA(0, 1, At, B1); PG8_BAR; PG8_SCHED;
            PG8_LDA(At, 1, 1); PG8_STAGE(PG8_SB(1, 0), b3, voffB); PG8_STAGE(PG8_SB(1, 1), b3 + hstep, voffB); PG8_STAGE(PG8_SA(1, 0), a3, voffA);
            PG8_WAIT_V(8); PG8_WAIT_L(0); PG8_BAR; PG8_MMA(1, 0, At, B0); PG8_MMA(1, 1, At, B1); PG8_BAR; PG8_SCHED;
            } else {
            PG8_LDB(B0, 0, 0); PG8_SCHED; PG8_LDA(At, 0, 0); PG8_STAGE(PG8_SA(1, 1), a1 + hstep, voffA);
            PG8_WAIT_L(8); PG8_BAR; PG8_WAIT_L(0); PG8_MMA(0, 0, At, B0); PG8_BAR; PG8_SCHED;
            PG8_LDB(B1, 0, 1); PG8_STAGE(PG8_SB(0, 0), b2, voffB);
            PG8_BAR; PG8_WAIT_L(0); PG8_MMA(0, 1, At, B1); PG8_BAR;
            PG8_LDA(At, 0, 1); PG8_STAGE(PG8_SA(0, 0), a2, voffA);
            PG8_BAR; PG8_WAIT_L(0); PG8_MMA(1, 0, At, B0); PG8_BAR; PG8_SCHED;
            PG8_STAGE(PG8_SB(0, 1), b2 + hstep, voffB);
            PG8_WAIT_V(6); PG8_BAR; PG8_MMA(1, 1, At, B1); PG8_BAR;
            PG8_LDB(B0, 1, 0); PG8_SCHED; PG8_LDA(At, 1, 0); PG8_STAGE(PG8_SA(0, 1), a2 + hstep, voffA);
            PG8_WAIT_L(8); PG8_BAR; PG8_WAIT_L(0); PG8_MMA(0, 0, At, B0); PG8_BAR; PG8_SCHED;
            PG8_LDB(B1, 1, 1); PG8_STAGE(PG8_SB(1, 0), b3, voffB);
            PG8_BAR; PG8_WAIT_L(0); PG8_MMA(0, 1, At, B1); PG8_BAR;
            PG8_LDA(At, 1, 1); PG8_STAGE(PG8_SA(1, 0), a3, voffA);
            PG8_BAR; PG8_WAIT_L(0); PG8_MMA(1, 0, At, B0); PG8_BAR; PG8_SCHED;
            PG8_STAGE(PG8_SB(1, 1), b3 + hstep, voffB);
            PG8_WAIT_V(6); PG8_BAR; PG8_MMA(1, 1, At, B1); PG8_BAR;
            }
        }
        if constexpr (ALIGN_EPI) { if (wr == 0) PG8_BAR; }
        if constexpr (!Epi::AFTER_DRAIN) { E(acc, cur, wr, wc, fr, fq); S.done(cur, ui, lds, tid); }
        if (!has_next) break;
#pragma unroll
        for (int a = 0; a < 2; ++a)
#pragma unroll
            for (int b = 0; b < 2; ++b)
#pragma unroll
                for (int m = 0; m < 4; ++m)
#pragma unroll
                    for (int n = 0; n < 2; ++n) acc[a][b][m][n] = (f32x4){0.f, 0.f, 0.f, 0.f};
        cur = nxt; cA = nA; cB = nB; ++ui; nt = cur.nt;
        if constexpr (ALIGN_EPI) { if (wr == 1) PG8_BAR; }
    }
    PG8_WAIT_V(0);
    if constexpr (!ALIGN_EPI) { if (wr == 0) PG8_BAR; }
    PG8_BAR;
    if constexpr (Epi::AFTER_DRAIN) { E.fused(acc, cur, wr, wc, fr, fq, lds, wid, lane); S.done(cur, ui, lds, tid); }
#undef PG8_SA
#undef PG8_SB
#undef PG8_STAGE
#undef PG8_LDA
#undef PG8_LDB
#undef PG8_MMA
#undef PG8_WAIT_V
#undef PG8_WAIT_L
#undef PG8_BAR
#undef PG8_SCHED
}

typedef int v8i __attribute__((ext_vector_type(8)));
typedef float f32x16 __attribute__((ext_vector_type(16)));
typedef float f32x2 __attribute__((ext_vector_type(2)));
__device__ __forceinline__ v8i cat8(bf16x8 lo, bf16x8 hi) { typedef int i4v __attribute__((ext_vector_type(4))); const i4v a = __builtin_bit_cast(i4v, lo), b = __builtin_bit_cast(i4v, hi); return __builtin_shufflevector(a, b, 0, 1, 2, 3, 4, 5, 6, 7); }
__host__ __device__ __forceinline__ int f8swz(int R) { return (R >> 1) & 7; }
__host__ __device__ __forceinline__ int permf8(int rho) { return 16 * ((rho >> 2) & 1) + 4 * (rho >> 3) + (rho & 3); }
template <class Epi, class Sched, int SCW, int SCX, int SCW1 = SCW>
__device__ __forceinline__ void gemm_phase_f8(PG8_LAS unsigned char* lds, const Gemm g, const Sched& S, const Epi& E, const int tid) {
    const int wid = __builtin_amdgcn_readfirstlane(tid >> 6), lane = tid & 63, wr = wid >> 2, wc = wid & 3, r32 = lane & 31, kh = lane >> 5;
    const int K = g.K; int nt;
    unsigned voffA[2], voffB[2];
#pragma unroll
    for (int i = 0; i < 2; ++i) { const int bb = tid * 16 + i * 8192, R = bb >> 7, C = 16 * (((bb >> 4) & 7) ^ f8swz(R)); const int Rb = Epi::PERM ? ((R & ~31) + permf8(R & 31)) : R;
        voffA[i] = (unsigned)(R * K + C); voffB[i] = (unsigned)(Rb * 128 + C); }
    const size_t kstep = 128, hstep = (size_t)HALF * K, tstep = 2 * hstep, kstepB = 32768, hstepB = 16384;
    const unsigned ldsw = (unsigned)wid * 1024u;
    int aoffk[2][2], boffk[2][2];
#pragma unroll
    for (int s = 0; s < 2; ++s)
#pragma unroll
        for (int h2 = 0; h2 < 2; ++h2) { const int ch = 16 * ((4 * s + 2 * kh + h2) ^ f8swz(r32)); aoffk[s][h2] = (wr * 64 + r32) * 128 + ch; boffk[s][h2] = (wc * 32 + r32) * 128 + ch; }
#define PG8_SA(b, h) (((b) * 2 + (h)) * HTB)
#define PG8_SB(b, h) ((4 + (b) * 2 + (h)) * HTB)
#define PG8_STAGE(bufoff, gbase, voff) do { _Pragma("unroll") for (int _i = 0; _i < 2; ++_i) \
        __builtin_amdgcn_global_load_lds((const unsigned*)((const char*)(gbase) + (voff)[_i]), (PG8_LAS unsigned*)(lds + (bufoff) + ldsw + _i * 8192), 16, 0, 0); } while (0)
#define PG8_LDA(dst, b, h) do { _Pragma("unroll") for (int mb = 0; mb < 2; ++mb) _Pragma("unroll") for (int s = 0; s < 2; ++s) \
        dst[mb][s] = cat8(*(const PG8_LAS bf16x8*)(lds + PG8_SA(b, h) + aoffk[s][0] + mb * 4096), *(const PG8_LAS bf16x8*)(lds + PG8_SA(b, h) + aoffk[s][1] + mb * 4096)); } while (0)
#define PG8_LDB(dst, b, h) do { _Pragma("unroll") for (int s = 0; s < 2; ++s) \
        dst[s] = cat8(*(const PG8_LAS bf16x8*)(lds + PG8_SB(b, h) + boffk[s][0]), *(const PG8_LAS bf16x8*)(lds + PG8_SB(b, h) + boffk[s][1])); } while (0)
#define PG8_MMA(ai, bj, At, Bt) do { __builtin_amdgcn_s_setprio(1); _Pragma("unroll") for (int mb = 0; mb < 2; ++mb) _Pragma("unroll") for (int s = 0; s < 2; ++s) \
        acc[ai][bj][mb] = __builtin_amdgcn_mfma_scale_f32_32x32x64_f8f6f4(Bt[s], At[mb][s], acc[ai][bj][mb], 0, 0, 0, (bj) ? SCW1 : SCW, 0, SCX); __builtin_amdgcn_s_setprio(0); } while (0)
#define PG8_WAIT_V(n) asm volatile("s_waitcnt vmcnt(" #n ")" ::: "memory")
#define PG8_WAIT_L(n) asm volatile("s_waitcnt lgkmcnt(" #n ")" ::: "memory")
#define PG8_BAR __builtin_amdgcn_s_barrier()
#define PG8_SCHED __builtin_amdgcn_sched_barrier(0)
#define PG8_ZERO() do { _Pragma("unroll") for (int a = 0; a < 2; ++a) _Pragma("unroll") for (int b = 0; b < 2; ++b) _Pragma("unroll") for (int m = 0; m < 2; ++m) _Pragma("unroll") for (int e = 0; e < 16; ++e) acc[a][b][m][e] = 0.f; } while (0)
    Unit cur, nxt; int ui = 0;
    if (!S.next(0, cur)) return;
    f32x16 acc[2][2][2]; PG8_ZERO();
    v8i At[2][2], B0[2], B1[2];
    const char* cA = (const char*)g.A + (size_t)cur.pm * tstep + (size_t)cur.k0; const char* cB = (const char*)g.Bt + (size_t)cur.pn * tstep + (size_t)cur.k0 * 256; nt = cur.nt;
    S.a_ready(cur);
    PG8_STAGE(PG8_SB(0, 0), cB, voffB); PG8_STAGE(PG8_SB(0, 1), cB + hstepB, voffB); PG8_STAGE(PG8_SA(0, 0), cA, voffA); PG8_STAGE(PG8_SA(0, 1), cA + hstep, voffA);
    if (wr == 1) PG8_BAR;
    PG8_WAIT_V(2); PG8_BAR;
    PG8_STAGE(PG8_SB(1, 0), cB + kstepB, voffB); PG8_STAGE(PG8_SA(1, 0), cA + kstep, voffA); PG8_STAGE(PG8_SB(1, 1), cB + hstepB + kstepB, voffB);
    PG8_WAIT_V(6); PG8_BAR;
    for (;;) {
        const bool has_next = S.next(ui + 1, nxt);
        const char* nA = has_next ? (const char*)g.A + (size_t)nxt.pm * tstep + (size_t)nxt.k0 : cA; const char* nB = has_next ? (const char*)g.Bt + (size_t)nxt.pn * tstep + (size_t)nxt.k0 * 256 : cB;
        for (int t = 0; t < nt; t += 2) {
            const bool last = (t == nt - 2);
            const char* a1 = cA + (size_t)(t + 1) * kstep;
            const char* a2 = last ? nA : cA + (size_t)(t + 2) * kstep; const char* b2 = last ? nB : cB + (size_t)(t + 2) * kstepB;
            const char* a3 = a2 + kstep; const char* b3 = b2 + kstepB;
            if (last && has_next) S.a_ready(nxt);
            PG8_LDB(B0, 0, 0); PG8_LDB(B1, 0, 1); PG8_SCHED; PG8_LDA(At, 0, 0); PG8_STAGE(PG8_SA(1, 1), a1 + hstep, voffA);
            PG8_WAIT_V(8); PG8_WAIT_L(0); PG8_BAR; PG8_MMA(0, 0, At, B0); PG8_MMA(0, 1, At, B1); PG8_BAR; PG8_SCHED;
            PG8_LDA(At, 0, 1); PG8_STAGE(PG8_SB(0, 0), b2, voffB); PG8_STAGE(PG8_SB(0, 1), b2 + hstepB, voffB); PG8_STAGE(PG8_SA(0, 0), a2, voffA);
            PG8_WAIT_V(8); PG8_WAIT_L(0); PG8_BAR; PG8_MMA(1, 0, At, B0); PG8_MMA(1, 1, At, B1); PG8_BAR; PG8_SCHED;
            PG8_LDB(B0, 1, 0); PG8_LDB(B1, 1, 1); PG8_SCHED; PG8_LDA(At, 1, 0); PG8_STAGE(PG8_SA(0, 1), a2 + hstep, voffA);
            PG8_WAIT_V(8); PG8_WAIT_L(0); PG8_BAR; PG8_MMA(0, 0, At, B0); PG8_MMA(0, 1, At, B1); PG8_BAR; PG8_SCHED;
            PG8_LDA(At, 1, 1); PG8_STAGE(PG8_SB(1, 0), b3, voffB); PG8_STAGE(PG8_SB(1, 1), b3 + hstepB, voffB); PG8_STAGE(PG8_SA(1, 0), a3, voffA);
            PG8_WAIT_V(8); PG8_WAIT_L(0); PG8_BAR; PG8_MMA(1, 0, At, B0); PG8_MMA(1, 1, At, B1); PG8_BAR; PG8_SCHED;
        }
        if (wr == 0) PG8_BAR;
        E(acc, cur, wr, wc, r32, kh); S.done(cur, ui, lds, tid);
        if (!has_next) break;
        PG8_ZERO();
        cur = nxt; cA = nA; cB = nB; ++ui; nt = cur.nt;
        if (wr == 1) PG8_BAR;
    }
    PG8_WAIT_V(0);
    PG8_BAR;
#undef PG8_SA
#undef PG8_SB
#undef PG8_STAGE
#undef PG8_LDA
#undef PG8_LDB
#undef PG8_MMA
#undef PG8_WAIT_V
#undef PG8_WAIT_L
#undef PG8_BAR
#undef PG8_SCHED
#undef PG8_ZERO
}
}

constexpr int NWAVES = 8, NTHR = 512;
constexpr int D = 2048, BATCH = 2, SEQ = 4096, CTXL = 256, TB = CTXL + SEQ  , MR = BATCH * TB  ;
constexpr int NMT = MR / 256;
constexpr int PSRC = 5680, NP = 5632, NSM = 48;
constexpr int FF = 5632, FFE = 7168, NE = 8;
constexpr int NMOD = 6, ADAW = NMOD * D;
constexpr int MOE_TILES = 72, MOE_ROWS = MOE_TILES * 256;
constexpr float EPS = 1e-6f;
constexpr int C_BG = 0, C_CG = 512, C_XA = 1024, C_CMU = 1536, C_CMV = 2048, C_Z = 2560, C_XS = 3072, C_BM = 3584, C_CM = 3840, C_Q = 4096, C_K = 4352, C_V = 4608, C_G = 5120;
constexpr int NCH_M = TB / 128  , NCH_G = TB / 64  ;

constexpr size_t MiB = 1u << 20;
constexpr size_t WS_CTL = 0, CTL_ZERO_BYTES = 1 * MiB;
constexpr size_t WS_MODF = 1 * MiB;
constexpr size_t WS_ADAP = 2 * MiB;
constexpr size_t WS_ALAST = 12 * MiB;
constexpr size_t WS_GLAST = 12 * MiB + 65536;
constexpr size_t WS_EA = 13 * MiB;
constexpr size_t WS_ROUTE = 14 * MiB;
constexpr size_t WS_CNT = 14 * MiB + 512 * 1024;
constexpr size_t WS_TOKPOS = 14 * MiB + 768 * 1024;
constexpr size_t WS_MOEINFO = 15 * MiB;
constexpr size_t WS_WSM = 15 * MiB + 65536;
constexpr size_t WS_PS = 1012 * MiB;
constexpr size_t WS_PART = 1579 * MiB;
constexpr size_t WS_DOUT2 = 918 * MiB;
constexpr size_t WS_WIN = 16 * MiB;
constexpr size_t WS_WOUT = 62 * MiB;
constexpr size_t WS_FUP = 78 * MiB;
constexpr size_t WS_FDN = 122 * MiB;
constexpr size_t WS_MUP = 144 * MiB;
constexpr size_t WS_MDN = 592 * MiB;
constexpr size_t WS_H = 816 * MiB;
constexpr size_t WS_XN = 884 * MiB;
constexpr size_t WS_P = 918 * MiB;
constexpr size_t WS_YMIX = 1016 * MiB;
constexpr size_t WS_YMB = 1050 * MiB;
constexpr size_t WS_YGLA = 1067 * MiB;
constexpr size_t WS_CSM = 1084 * MiB;
constexpr size_t WS_CSG = 1118 * MiB;
constexpr size_t WS_QE = 1152 * MiB;
constexpr size_t WS_ACT = 1161 * MiB;
constexpr size_t WS_APERM = 1255 * MiB;
constexpr size_t WS_ACTM = 1327 * MiB;
constexpr size_t WS_DOUT = 1579 * MiB;
constexpr size_t WS_END = 1723 * MiB;
constexpr size_t WS_SSM = 1161 * MiB, WS_SSG = 1180 * MiB;
constexpr size_t WS_XT = 1016 * MiB;
constexpr size_t WS_TT = WS_CTL + 512 * 1024;
static_assert(WS_WIN + (size_t)2 * NP * D * 2 <= WS_WOUT && WS_WOUT + (size_t)2 * D * D * 2 <= WS_FUP && WS_FUP + (size_t)2 * FF * D * 2 <= WS_FDN && WS_FDN + (size_t)D * FF * 2 <= WS_MUP, "ws map 1");
static_assert(WS_MUP + (size_t)NE * 2 * FFE * D * 2 <= WS_MDN && WS_MDN + (size_t)NE * D * FFE * 2 <= WS_H && WS_H + (size_t)MR * D * 4 <= WS_XN && WS_XN + (size_t)MR * D * 2 <= WS_P, "ws map 2");
static_assert(WS_P + (size_t)MR * NP * 2 <= WS_YMIX && WS_YMIX + (size_t)MR * D * 2 <= WS_YMB && WS_YMB + (size_t)MR * 512 * 4 <= WS_YGLA && WS_YGLA + (size_t)MR * 512 * 4 <= WS_CSM, "ws map 3");
static_assert(WS_CSM + (size_t)BATCH * NCH_M * 2 * 8 * 64 * 128 * 4 <= WS_CSG && WS_CSG + (size_t)BATCH * NCH_G * 2 * 4 * 64 * 128 * 4 <= WS_QE && WS_QE + (size_t)MR * 512 * 2 <= WS_ACT && WS_ACT + (size_t)MR * FF * 2 <= WS_APERM, "ws map 4");
static_assert(WS_APERM + (size_t)MOE_ROWS * D * 2 <= WS_ACTM && WS_ACTM + (size_t)MOE_ROWS * FFE * 2 <= WS_DOUT && WS_DOUT + (size_t)MOE_ROWS * D * 4 <= WS_END, "ws map 5");
static_assert(WS_ADAP + (size_t)2 * 32 * 3 * ADAW * 4 <= WS_ALAST && WS_GLAST + (size_t)BATCH * NCH_G * 2 * 4 * 64 * 4 <= WS_EA && WS_EA + (size_t)MR * 16 * 4 <= WS_ROUTE && WS_ROUTE + (size_t)MR * 16 <= WS_CNT, "ws map 6");
constexpr int CW_TMO = 0, CW_BAR = 4096;

constexpr int RING_OFF = 0, RING_BYTES = 131072;
constexpr int CONV_OFF = RING_BYTES, CONV_BYTES = 16384;
constexpr int LDSCTL_OFF = CONV_OFF + CONV_BYTES, MISC_OFF = LDSCTL_OFF + 320;
constexpr int LDS_BYTES = 163840;

enum { I_X = 0, I_C, I_CTX, I_CCTX, I_WADA, I_BADA, I_GMIX, I_GFFN, I_WIN, I_WOUT, I_SCW, I_CMW, I_CMB, I_MBCW, I_MBCB, I_MBALOG, I_MBDTB, I_MBD, I_MBNG, I_GLAWG, I_GLABG, I_GLANG,
       I_FWG, I_FWU, I_FWD, I_MROUTER, I_MWG, I_MWU, I_MWD, I_GFINAL, N_IN };
#define GAS __attribute__((address_space(1)))
#define LAS __attribute__((address_space(3)))
typedef unsigned short bf16;
typedef unsigned v4u __attribute__((ext_vector_type(4)));
typedef float f32x4 __attribute__((ext_vector_type(4)));
typedef short bf16x8 __attribute__((ext_vector_type(8)));
typedef GAS unsigned gu32;
typedef GAS unsigned long long gu64;
#define RLX_AGENT __ATOMIC_RELAXED, __HIP_MEMORY_SCOPE_AGENT
#define LDS_WAIT() asm volatile("s_waitcnt lgkmcnt(0)" ::: "memory")
#define VM_WAIT() asm volatile("s_waitcnt vmcnt(0)" ::: "memory")
__device__ __forceinline__ unsigned long long rt() { return __builtin_amdgcn_s_memrealtime(); }
__device__ __forceinline__ unsigned f2bf(float f) { unsigned u = __builtin_bit_cast(unsigned, f); return (u + 0x7fffu + ((u >> 16) & 1u)) >> 16; }
__device__ __forceinline__ unsigned pk2(float lo, float hi) { return f2bf(lo) | (f2bf(hi) << 16); }

#define XB_TMO      128
#define XB_XCNT(j)  (256  + 64 * (j))
#define XB_XSUB(j)  (1280 + 64 * (j))
#define XB_XGEN(j)  (2304 + 64 * (j))
#define XB_TOP      3328
#define XB_TOPGEN   3392
#define XCD_BAR_WORDS 3456
#define XB_SPIN_CAP (1u << 18)

__device__ __forceinline__ unsigned xb_ld(unsigned* p)              { return __hip_atomic_load(p, __ATOMIC_RELAXED, __HIP_MEMORY_SCOPE_AGENT); }
__device__ __forceinline__ unsigned xb_add(unsigned* p, unsigned v) { return __hip_atomic_fetch_add(p, v, __ATOMIC_RELAXED, __HIP_MEMORY_SCOPE_AGENT); }
__device__ __forceinline__ unsigned xb_xcc_id() { return (unsigned)__builtin_amdgcn_s_getreg((3 << 11) | 20) & 0xFu; }
#define XB_SPIN(cond, bar) do { unsigned _sp = 0; while (cond) { __builtin_amdgcn_s_sleep(1); \
    if ((++_sp & 255u) == 0u) { if (xb_ld(&(bar)[XB_TMO])) break; if (_sp > XB_SPIN_CAP) { atomicAdd(&(bar)[XB_TMO], 1u); break; } } } } while (0)

struct XcdBarrier {
    unsigned* bar; unsigned x;
    volatile LAS unsigned* st;
};

__device__ __forceinline__ XcdBarrier xcd_barrier_post(unsigned* bar, volatile LAS unsigned* st) {
    XcdBarrier b; b.bar = bar; b.x = xb_xcc_id(); b.st = st;
    if (threadIdx.x == 0) (void)xb_add(&bar[XB_XCNT(b.x)], 1u);
    return b;
}
__device__ __forceinline__ void xcd_barrier_complete(unsigned* bar, unsigned x, unsigned& nloc, unsigned& nx) {
    const unsigned G = gridDim.x * gridDim.y * gridDim.z;
    unsigned sum, cnt, mine, sp = 0u;
    for (;;) {
        sum = 0u; cnt = 0u; mine = 0u;
#pragma unroll
        for (unsigned j = 0; j < 16; ++j) { const unsigned c = xb_ld(&bar[XB_XCNT(j)]); sum += c; cnt += (c > 0u) ? 1u : 0u; mine = (j == x) ? c : mine; }
        if (sum == G) break;
        __builtin_amdgcn_s_sleep(1);
        if ((++sp & 255u) == 0u) { if (xb_ld(&bar[XB_TMO])) break; if (sp > XB_SPIN_CAP) { atomicAdd(&bar[XB_TMO], 1u); break; } }
    }
    nloc = mine > 0u ? mine : 1u; nx = cnt > 0u ? cnt : 1u;
}

__device__ __forceinline__ void xcd_barrier(const XcdBarrier& b) {
    asm volatile("s_waitcnt vmcnt(0)" ::: "memory");
    __syncthreads();
    if (threadIdx.x == 0) {
        unsigned* bar = b.bar;
        __builtin_amdgcn_s_waitcnt(0);
        unsigned nloc = b.st[0], nx = b.st[1];
        if (nloc == 0u) { xcd_barrier_complete(bar, b.x, nloc, nx); b.st[0] = nloc; b.st[1] = nx; }
        const unsigned old = xb_add(&bar[XB_XSUB(b.x)], 1u);
        const unsigned gen = old / nloc;
        if (old + 1u == (gen + 1u) * nloc) {
            __builtin_amdgcn_fence(__ATOMIC_RELEASE, "agent");
            asm volatile("s_waitcnt vmcnt(0)" ::: "memory");
            const unsigned og = xb_add(&bar[XB_TOP], 1u);
            const unsigned tg = og / nx;
            if (og + 1u == (tg + 1u) * nx) xb_add(&bar[XB_TOPGEN], 1u);
            else XB_SPIN(xb_ld(&bar[XB_TOPGEN]) == tg, bar);
            __builtin_amdgcn_fence(__ATOMIC_ACQUIRE, "agent");
            xb_add(&bar[XB_XGEN(b.x)], 1u);
            asm volatile("s_waitcnt vmcnt(0)" ::: "memory");
        } else {
            XB_SPIN(xb_ld(&bar[XB_XGEN(b.x)]) == gen, bar);
            __builtin_amdgcn_fence(__ATOMIC_ACQUIRE, "agent");
            asm volatile("s_waitcnt vmcnt(0)" ::: "memory");
        }
    }
    __syncthreads();
}

struct Args { const float* in[N_IN]; float* out; unsigned char* ws; int ph_lo, ph_hi; };
typedef LAS unsigned short lbf16;
typedef const __attribute__((address_space(4))) Args* KA;
__device__ __forceinline__ KA ka_get() { KA p = (KA)__builtin_amdgcn_kernarg_segment_ptr(); asm volatile("" : "+s"(p)); return p; }
__device__ __forceinline__ float bf2f(unsigned short v) { return __uint_as_float((unsigned)v << 16); }
__device__ __forceinline__ void unpack8(const v4u v, float (&f)[8]) {
    f[0] = __uint_as_float(v.x << 16); f[1] = __uint_as_float(v.x & 0xffff0000u); f[2] = __uint_as_float(v.y << 16); f[3] = __uint_as_float(v.y & 0xffff0000u);
    f[4] = __uint_as_float(v.z << 16); f[5] = __uint_as_float(v.z & 0xffff0000u); f[6] = __uint_as_float(v.w << 16); f[7] = __uint_as_float(v.w & 0xffff0000u); }
__device__ __forceinline__ v4u pack8(const float (&f)[8]) { v4u o; o.x = pg8::cvt_pk_bf16(f[0], f[1]); o.y = pg8::cvt_pk_bf16(f[2], f[3]); o.z = pg8::cvt_pk_bf16(f[4], f[5]); o.w = pg8::cvt_pk_bf16(f[6], f[7]); return o; }
__device__ __forceinline__ float silu_f(float x) { return x * __builtin_amdgcn_rcpf(1.f + __expf(-x)); }
__device__ __forceinline__ float softplus_f(float x) { return x > 20.f ? x : log1pf(__expf(x)); }
__device__ __forceinline__ float logsig_f(float x) { return fminf(x, 0.f) - __logf(1.f + __expf(-fabsf(x))); }
__device__ __forceinline__ float gelu_tanh(float x) { const float u = 0.7978845608028654f * (x + 0.044715f * x * x * x); const float t = 1.f - 2.f * __builtin_amdgcn_rcpf(1.f + __expf(2.f * u)); return 0.5f * x * (1.f + t); }
template <int CTRL, int ROWMASK> __device__ __forceinline__ float dpp_f(float v) { return __int_as_float(__builtin_amdgcn_update_dpp(0, __float_as_int(v), CTRL, ROWMASK, 0xF, false)); }
__device__ __forceinline__ float row16_sum(float v) { v += dpp_f<0xB1, 0xF>(v); v += dpp_f<0x4E, 0xF>(v); v += dpp_f<0x141, 0xF>(v); v += dpp_f<0x140, 0xF>(v); return v; }
__device__ __forceinline__ float wave_sum(float v) {
    v = row16_sum(v); v += dpp_f<0x142, 0xA>(v); v += dpp_f<0x143, 0xC>(v);
    return __int_as_float(__builtin_amdgcn_readlane(__float_as_int(v), 63));
}
__device__ __forceinline__ float half_sum(float v, int lane) {
    v = row16_sum(v); v += dpp_f<0x142, 0xA>(v);
    const float lo = __int_as_float(__builtin_amdgcn_readlane(__float_as_int(v), 31)), hi = __int_as_float(__builtin_amdgcn_readlane(__float_as_int(v), 63)); return lane < 32 ? lo : hi;
}
struct Acc32 { f32x4 v[2][2]; };
__device__ __forceinline__ void acc_zero(Acc32& a) { a.v[0][0] = a.v[0][1] = a.v[1][0] = a.v[1][1] = (f32x4){0.f, 0.f, 0.f, 0.f}; }
template <int MASK> __device__ __forceinline__ int tswz(int row, int col) { return (((col >> 3) ^ ((row >> 3) & MASK)) << 3) | (col & 7); }
template <int MA = -1, int MB = -1>
__device__ __forceinline__ void wave_mma32(Acc32& acc, const lbf16* A, int lda, const lbf16* Bt, int ldb, int m0, int n0, int K, int lane) {
    const int l16 = lane & 15, q = lane >> 4;
    const lbf16* a0 = A + (m0 + l16) * lda; const lbf16* a1 = a0 + 16 * lda;
    const lbf16* b0 = Bt + (n0 + l16) * ldb; const lbf16* b1 = b0 + 16 * ldb;
    const int fa0 = MA >= 0 ? ((m0 + l16) >> 3) & MA : 0, fa1 = MA >= 0 ? ((m0 + l16 + 16) >> 3) & MA : 0, fb0 = MB >= 0 ? ((n0 + l16) >> 3) & MB : 0, fb1 = MB >= 0 ? ((n0 + l16 + 16) >> 3) & MB : 0;
    for (int k = 0; k < K; k += 32) { const int c = (k >> 3) + q;
        const bf16x8 fa0v = *(const LAS bf16x8*)(a0 + 8 * (c ^ fa0)), fa1v = *(const LAS bf16x8*)(a1 + 8 * (c ^ fa1)), fb0v = *(const LAS bf16x8*)(b0 + 8 * (c ^ fb0)), fb1v = *(const LAS bf16x8*)(b1 + 8 * (c ^ fb1));
        acc.v[0][0] = __builtin_amdgcn_mfma_f32_16x16x32_bf16(fa0v, fb0v, acc.v[0][0], 0, 0, 0);
        acc.v[0][1] = __builtin_amdgcn_mfma_f32_16x16x32_bf16(fa0v, fb1v, acc.v[0][1], 0, 0, 0);
        acc.v[1][0] = __builtin_amdgcn_mfma_f32_16x16x32_bf16(fa1v, fb0v, acc.v[1][0], 0, 0, 0);
        acc.v[1][1] = __builtin_amdgcn_mfma_f32_16x16x32_bf16(fa1v, fb1v, acc.v[1][1], 0, 0, 0);
    }
}

__device__ __forceinline__ unsigned pk4_fp8(float a, float b, float c, float d) {
    a = __builtin_amdgcn_fmed3f(a, -448.f, 448.f); b = __builtin_amdgcn_fmed3f(b, -448.f, 448.f); c = __builtin_amdgcn_fmed3f(c, -448.f, 448.f); d = __builtin_amdgcn_fmed3f(d, -448.f, 448.f);
    int w = 0; w = __builtin_amdgcn_cvt_pk_fp8_f32(a, b, w, false); w = __builtin_amdgcn_cvt_pk_fp8_f32(c, d, w, true); return (unsigned)w; }
constexpr float XN8_SCALE = 16.f, ACT8_SCALE = 4.f, W8_SCALE = 64.f;
constexpr int SC_W8UP = 0x7b7b7b7b  , SC_W8 = 0x79797979  , SC_XN8 = 0x7b7b7b7b  , SC_ACT8 = 0x7d7d7d7d  ;
namespace pg8 {
struct EpiP {
    static constexpr bool PERM = true, AFTER_DRAIN = false; unsigned char* ws;
    __device__ __forceinline__ void operator()(const f32x4 (&acc)[2][2][4][2], const Unit& u, int wr, int wc, int fr, int fq) const {
        bf16_t* O = (bf16_t*)(ws + WS_P); const int row0 = u.pm * BM + wr * 64 + fr, col0 = u.pn * BM + wc * 32 + 8 * fq;
#pragma unroll
        for (int ai = 0; ai < 2; ++ai)
#pragma unroll
            for (int m = 0; m < 4; ++m) { bf16_t* rowp = O + (size_t)(row0 + ai * HALF + m * 16) * NP + col0;
#pragma unroll
                for (int bj = 0; bj < 2; ++bj) { const f32x4 v0 = acc[ai][bj][m][0], v1 = acc[ai][bj][m][1];
                    u32x4 w; w.x = cvt_pk_bf16(v0[0], v0[1]); w.y = cvt_pk_bf16(v0[2], v0[3]); w.z = cvt_pk_bf16(v1[0], v1[1]); w.w = cvt_pk_bf16(v1[2], v1[3]);
                    *(u32x4*)(rowp + bj * HALF) = w; } }
    }
};
struct EpiRes {
    static constexpr bool PERM = true, AFTER_DRAIN = false;
    unsigned char* ws; const float* x; int l; int gate_idx;
    __device__ __forceinline__ void operator()(const f32x4 (&acc)[2][2][4][2], const Unit& u, int wr, int wc, int fr, int fq) const {
        const int b = u.pm / 17, j = u.pm % 17;
        const int col0 = u.pn * BM + wc * 32 + 8 * fq;
        if (j == 0) {
            bf16_t* out = (bf16_t*)(ws + WS_PART) + ((size_t)(u.k0 >> 9) * 512 + b * 256) * D + col0;
#pragma unroll
            for (int ai = 0; ai < 2; ++ai)
#pragma unroll
                for (int m = 0; m < 4; ++m) { int r = wr * 64 + fr + ai * HALF + m * 16; asm volatile("" : "+v"(r)); bf16_t* o = out + (size_t)(unsigned)(r * D);
#pragma unroll
                    for (int bj = 0; bj < 2; ++bj) { const f32x4 q0 = acc[ai][bj][m][0], q1 = acc[ai][bj][m][1]; u32x4 w;
                        w.x = f2bf(q0[0]) | (f2bf(q0[1]) << 16); w.y = f2bf(q0[2]) | (f2bf(q0[3]) << 16); w.z = f2bf(q1[0]) | (f2bf(q1[1]) << 16); w.w = f2bf(q1[2]) | (f2bf(q1[3]) << 16);
                        *(u32x4*)(o + bj * HALF) = w; }
                    asm volatile("" ::: "memory"); }
            return; }
        const float* base = x ? x + (size_t)(b * SEQ + (j - 1) * 256) * D : nullptr;
        bf16_t* out = (bf16_t*)(ws + WS_H) + (size_t)u.pm * 256 * D;
        const float* gate = (const float*)(ws + WS_MODF) + ((size_t)l * 3 + b) * ADAW + gate_idx * D + col0;
        f32x4 gv[2][2];
#pragma unroll
        for (int bj = 0; bj < 2; ++bj)
#pragma unroll
            for (int n = 0; n < 2; ++n) gv[bj][n] = *(const f32x4*)(gate + bj * HALF + 4 * n);
#pragma unroll
        for (int ai = 0; ai < 2; ++ai)
#pragma unroll
            for (int m = 0; m < 4; ++m) { int r = wr * 64 + fr + ai * HALF + m * 16; asm volatile("" : "+v"(r)); const unsigned off = (unsigned)(r * D) + col0;
                f32x4 bs[2][2];
                if (base) {
#pragma unroll
                    for (int bj = 0; bj < 2; ++bj)
#pragma unroll
                        for (int n = 0; n < 2; ++n) bs[bj][n] = *(const f32x4*)(base + off + bj * HALF + 4 * n);
                } else {
#pragma unroll
                    for (int bj = 0; bj < 2; ++bj) { const u32x4 q = *(const u32x4*)(out + off + bj * HALF);
                        bs[bj][0] = (f32x4){__uint_as_float(q.x << 16), __uint_as_float(q.x & 0xffff0000u), __uint_as_float(q.y << 16), __uint_as_float(q.y & 0xffff0000u)};
                        bs[bj][1] = (f32x4){__uint_as_float(q.z << 16), __uint_as_float(q.z & 0xffff0000u), __uint_as_float(q.w << 16), __uint_as_float(q.w & 0xffff0000u)}; }
                }
#pragma unroll
                for (int bj = 0; bj < 2; ++bj) { const f32x4 r0 = bs[bj][0] + gv[bj][0] * acc[ai][bj][m][0], r1 = bs[bj][1] + gv[bj][1] * acc[ai][bj][m][1];
                    u32x4 w; w.x = cvt_pk_bf16(r0[0], r0[1]); w.y = cvt_pk_bf16(r0[2], r0[3]); w.z = cvt_pk_bf16(r1[0], r1[1]); w.w = cvt_pk_bf16(r1[2], r1[3]);
                    *(u32x4*)(out + off + bj * HALF) = w; }
                asm volatile("" ::: "memory"); }
    }
};
struct EpiSwiglu {
    static constexpr bool PERM = true, AFTER_DRAIN = false; bf16_t* O; int ldc; int nt;
    __device__ __forceinline__ void operator()(const f32x4 (&acc)[2][2][4][2], const Unit& u, int wr, int wc, int fr, int fq) const {
        const int pl = u.pn % nt; const int row0 = u.pm * BM + wr * 64 + fr, col0 = pl * HALF + wc * 32 + 8 * fq;
#pragma unroll
        for (int ai = 0; ai < 2; ++ai)
#pragma unroll
            for (int m = 0; m < 4; ++m) { bf16_t* rowp = O + (size_t)(row0 + ai * HALF + m * 16) * ldc + col0;
                float a[8];
#pragma unroll
                for (int n = 0; n < 2; ++n)
#pragma unroll
                    for (int e = 0; e < 4; e += 2) { typedef float f32x2 __attribute__((ext_vector_type(2)));
                        const f32x2 g = {acc[ai][0][m][n][e], acc[ai][0][m][n][e + 1]}, up = {acc[ai][1][m][n][e], acc[ai][1][m][n][e + 1]};
                        const f32x2 x = g * (f32x2){-1.44269504f, -1.44269504f};
                        const f32x2 d = (f32x2){__builtin_amdgcn_exp2f(x.x), __builtin_amdgcn_exp2f(x.y)} + (f32x2){1.f, 1.f};
                        const f32x2 o = (g * up) * (f32x2){__builtin_amdgcn_rcpf(d.x), __builtin_amdgcn_rcpf(d.y)};
                        a[4 * n + e] = o.x; a[4 * n + e + 1] = o.y; }
                u32x4 w; w.x = cvt_pk_bf16(a[0], a[1]); w.y = cvt_pk_bf16(a[2], a[3]); w.z = cvt_pk_bf16(a[4], a[5]); w.w = cvt_pk_bf16(a[6], a[7]);
                *(u32x4*)rowp = w; }
    }
};
struct EpiSwiglu8 {
    static constexpr bool PERM = true; unsigned char* O; int ldc; int nt;
    __device__ __forceinline__ void operator()(const f32x16 (&acc)[2][2][2], const Unit& u, int wr, int wc, int c32, int h) const {
        const int pl = u.pn % nt; const int row0 = u.pm * BM + wr * 64 + c32, col0 = pl * HALF + wc * 32 + 16 * h;
#pragma unroll
        for (int ai = 0; ai < 2; ++ai)
#pragma unroll
            for (int mb = 0; mb < 2; ++mb) { unsigned char* rowp = O + (size_t)(row0 + ai * HALF + mb * 32) * ldc + col0;
                float a[16];
#pragma unroll
                for (int r = 0; r < 16; r += 2) {
                    const f32x2 g = {acc[ai][0][mb][r], acc[ai][0][mb][r + 1]}, up = {acc[ai][1][mb][r], acc[ai][1][mb][r + 1]};
                    const f32x2 x = g * (f32x2){-1.44269504f, -1.44269504f};
                    const f32x2 d = (f32x2){__builtin_amdgcn_exp2f(x.x), __builtin_amdgcn_exp2f(x.y)} + (f32x2){1.f, 1.f};
                    const f32x2 o = (g * up) * (f32x2){__builtin_amdgcn_rcpf(d.x), __builtin_amdgcn_rcpf(d.y)};
                    a[r] = o.x; a[r + 1] = o.y; }
                u32x4 w; w.x = pk4_fp8(a[0], a[1], a[2], a[3]); w.y = pk4_fp8(a[4], a[5], a[6], a[7]); w.z = pk4_fp8(a[8], a[9], a[10], a[11]); w.w = pk4_fp8(a[12], a[13], a[14], a[15]);
                *(u32x4*)rowp = w; }
    }
};
struct EpiBf16g8 {
    static constexpr bool PERM = true; bf16_t* C0; bf16_t* C1; bf16_t* XT; int* TT; int ldc; int nt;
    __device__ __forceinline__ void operator()(const f32x16 (&acc)[2][2][2], const Unit& u, int wr, int wc, int c32, int h) const {
        const int pl = u.pn % nt; const bool tail = u.dst >= 2;
        const int row0 = (tail ? 0 : u.pm * BM) + wr * 64 + c32, col0 = (tail ? 0 : pl * BM) + wc * 32 + 16 * h, ld = tail ? 256 : ldc;
        bf16_t* C = tail ? XT + (size_t)(u.dst - 2) * 65536 : (u.dst ? C1 : C0);
        if (u.tt != 0 && (wr | wc | c32 | h) == 0) TT[(u.pm * 8 + pl) * 2 + u.dst] = u.tt;
#pragma unroll
        for (int ai = 0; ai < 2; ++ai)
#pragma unroll
            for (int mb = 0; mb < 2; ++mb) { bf16_t* rowp = C + (size_t)(row0 + ai * HALF + mb * 32) * ld + col0;
#pragma unroll
                for (int bj = 0; bj < 2; ++bj) { const f32x16 w = acc[ai][bj][mb]; u32x4 lo, hi;
                    lo.x = cvt_pk_bf16(w[0], w[1]); lo.y = cvt_pk_bf16(w[2], w[3]); lo.z = cvt_pk_bf16(w[4], w[5]); lo.w = cvt_pk_bf16(w[6], w[7]);
                    hi.x = cvt_pk_bf16(w[8], w[9]); hi.y = cvt_pk_bf16(w[10], w[11]); hi.z = cvt_pk_bf16(w[12], w[13]); hi.w = cvt_pk_bf16(w[14], w[15]);
                    *(u32x4*)(rowp + bj * HALF) = lo; *(u32x4*)(rowp + bj * HALF + 8) = hi; } }
    }
};
struct EpiF32g8 {
    static constexpr bool PERM = false; float* C0; float* C1; int ldc; int nt;
    __device__ __forceinline__ void operator()(const f32x16 (&acc)[2][2][2], const Unit& u, int wr, int wc, int c32, int h) const {
        const int pl = u.pn % nt; const int row0 = u.pm * BM + wr * 64 + c32, col0 = pl * BM + wc * 32 + 4 * h; float* C = u.k0 ? C1 : C0;
#pragma unroll
        for (int ai = 0; ai < 2; ++ai)
#pragma unroll
            for (int mb = 0; mb < 2; ++mb) { float* rowp = C + (size_t)(row0 + ai * HALF + mb * 32) * ldc + col0;
#pragma unroll
                for (int bj = 0; bj < 2; ++bj)
#pragma unroll
                    for (int gq = 0; gq < 4; ++gq) { const f32x16 w = acc[ai][bj][mb]; *(f32x4*)(rowp + bj * HALF + 8 * gq) = (f32x4){w[4 * gq], w[4 * gq + 1], w[4 * gq + 2], w[4 * gq + 3]}; } }
    }
};
struct EpiF32g {
    static constexpr bool PERM = false, AFTER_DRAIN = false; float* C0; float* C1; int ldc; int nt;
    __device__ __forceinline__ void operator()(const f32x4 (&acc)[2][2][4][2], const Unit& u, int wr, int wc, int fr, int fq) const {
        const int pl = u.pn % nt; const int row0 = u.pm * BM + wr * 64 + fr, col0 = pl * BM + wc * 32 + 4 * fq; float* C = u.k0 ? C1 : C0;
#pragma unroll
        for (int ai = 0; ai < 2; ++ai)
#pragma unroll
            for (int m = 0; m < 4; ++m) { float* rowp = C + (size_t)(row0 + ai * HALF + m * 16) * ldc + col0;
#pragma unroll
                for (int bj = 0; bj < 2; ++bj)
#pragma unroll
                    for (int n = 0; n < 2; ++n) *(f32x4*)(rowp + bj * HALF + n * 16) = acc[ai][bj][m][n]; }
    }
};
}

constexpr int CT_P0A_HI = 4096;
struct RmOff { int off; __device__ __forceinline__ int operator()(int n) const { return off + n; } };
struct RmWin { __device__ __forceinline__ int operator()(int c) const { return c < 4096 ? c : (c < 4112 ? -1 : (c < 5648 ? c - 16 : -1)); } };
struct RmGU { int half; __device__ __forceinline__ int operator()(int n) const { return 256 * (n >> 7) + 128 * half + (n & 127); } };
#define SCHED_FENCE() __builtin_amdgcn_sched_barrier(0)
#define LDS_BARRIER() do { asm volatile("s_waitcnt lgkmcnt(0)" ::: "memory"); __builtin_amdgcn_s_barrier(); asm volatile("" ::: "memory"); } while (0)
__device__ __forceinline__ void conv_load(const float* W, int N, int k0, int n0, int wave, int lane, f32x4 (&r)[8]) {
    const int n = n0 + 4 * lane; const bool ok = n < N;
    const float* p = W + (size_t)(k0 + 8 * wave) * N + n;
#pragma unroll
    for (int i = 0; i < 8; ++i) r[i] = ok ? __builtin_nontemporal_load((const GAS f32x4*)(p + (size_t)i * N)) : (f32x4){0.f, 0.f, 0.f, 0.f};
}
template <class RowMap>
__device__ __forceinline__ void conv_store_bf16(const f32x4 (&r)[8], unsigned char* WT, int Kbytes, int k0bytes, int n0, const RowMap rm, LAS unsigned char* T, int tid, int wave, int lane) {
    const int c = tid & 7, rr = tid >> 3;
#pragma unroll
    for (int p = 0; p < 2; ++p) {
        if ((lane >> 5) == p) {
#pragma unroll
            for (int j = 0; j < 4; ++j) { v4u o; o.x = pg8::cvt_pk_bf16(r[0][j], r[1][j]); o.y = pg8::cvt_pk_bf16(r[2][j], r[3][j]); o.z = pg8::cvt_pk_bf16(r[4][j], r[5][j]); o.w = pg8::cvt_pk_bf16(r[6][j], r[7][j]);
                *(LAS v4u*)(T + (4 * (lane & 31) + j) * 128 + 16 * (wave ^ (lane & 7))) = o; } }
        LDS_BARRIER();
#pragma unroll
        for (int q = 0; q < 2; ++q) { const int row = rr + 64 * q; const v4u v = *(const LAS v4u*)(T + row * 128 + 16 * (c ^ ((row >> 2) & 7)));
            const int dr = rm(n0 + 128 * p + row); if (dr >= 0) *(GAS v4u*)(WT + (size_t)dr * Kbytes + k0bytes + 16 * c) = v; }
        LDS_BARRIER();
    }
}
template <class RowMap>
__device__ __forceinline__ void conv_store_fp8(const f32x4 (&r)[8], unsigned char* WT, int Kbytes, int k0bytes, int n0, const RowMap rm, LAS unsigned char* T, int tid, int wave, int lane) {
    const int s = 2 * (lane & 3);
#pragma unroll
    for (int j = 0; j < 4; ++j) { const unsigned lo = pk4_fp8(r[0][j] * W8_SCALE, r[1][j] * W8_SCALE, r[2][j] * W8_SCALE, r[3][j] * W8_SCALE), hi = pk4_fp8(r[4][j] * W8_SCALE, r[5][j] * W8_SCALE, r[6][j] * W8_SCALE, r[7][j] * W8_SCALE);
        *(LAS unsigned long long*)(T + (4 * lane + j) * 64 + 8 * (wave ^ s)) = (unsigned long long)lo | ((unsigned long long)hi << 32); }
    LDS_BARRIER();
    const int c16 = tid & 3, rr = tid >> 2;
#pragma unroll
    for (int q = 0; q < 2; ++q) { const int row = rr + 128 * q; const v4u v = *(const LAS v4u*)(T + row * 64 + 16 * (c16 ^ ((row >> 2) & 3)));
        const int dr = rm(n0 + row); if (dr >= 0) *(GAS v4u*)(WT + (unsigned)((((dr >> 8) * (Kbytes >> 7) + (k0bytes >> 7)) << 15) + ((dr & 255) << 7) + (k0bytes & 127) + 16 * c16)) = v; }
    LDS_BARRIER();
}
struct ConvTile { const float* W; unsigned char* WT; int K, N, k0, n0, kind, f8; };
__device__ __forceinline__ bool conv_decode(KA A, int t, ConvTile& c) {
    unsigned char* ws = A->ws; c.f8 = 0;
    if (t >= 25600) return false;
    if (t < 1472) { const int l = t / 736, r = t % 736; c.W = A->in[I_WIN] + (size_t)l * D * PSRC; c.WT = ws + WS_WIN + (size_t)l * NP * D * 2; c.K = D; c.N = PSRC; c.k0 = 64 * (r / 23); c.n0 = 256 * (r % 23); c.kind = 1; return true; } t -= 1472;
    if (t < 512) { const int l = t >> 8, r = t & 255; c.W = A->in[I_WOUT] + (size_t)l * D * D; c.WT = ws + WS_WOUT + (size_t)l * D * D * 2; c.K = D; c.N = D; c.k0 = 64 * (r >> 3); c.n0 = 256 * (r & 7); c.kind = 0; return true; } t -= 512;
    if (t < 1408) { const int hf = t / 704, r = t % 704; c.W = hf ? A->in[I_FWU] : A->in[I_FWG]; c.WT = ws + WS_FUP; c.K = D; c.N = FF; c.k0 = 64 * (r / 22); c.n0 = 256 * (r % 22); c.kind = 2 + hf; return true; } t -= 1408;
    if (t < 704) { c.W = A->in[I_FWD]; c.WT = ws + WS_FDN; c.K = FF; c.N = D; c.k0 = 64 * (t >> 3); c.n0 = 256 * (t & 7); c.kind = 0; return true; } t -= 704;
    c.f8 = 1;
    if (t < 14336) { const int hf = t / 7168, r2 = t % 7168, e = r2 / 896, r = r2 % 896, hk = r & 1, q = r >> 1; c.W = (hf ? A->in[I_MWU] : A->in[I_MWG]) + (size_t)e * D * FFE; c.WT = ws + WS_MUP + (size_t)e * 2 * FFE * D; c.K = D; c.N = FFE; c.k0 = 128 * (q / 28) + 64 * hk; c.n0 = 256 * (q % 28); c.kind = 2 + hf; return true; } t -= 14336;
    { const int e = t / 896, r = t % 896, hk = r & 1, q = r >> 1; c.W = A->in[I_MWD] + (size_t)e * FFE * D; c.WT = ws + WS_MDN + (size_t)e * D * FFE; c.K = FFE; c.N = D; c.k0 = 128 * (q >> 3) + 64 * hk; c.n0 = 256 * (q & 7); c.kind = 0; return true; }
}
__device__ __forceinline__ bool conv_decode_moe(KA A, int t, ConvTile& c) {
    unsigned char* ws = A->ws; c.f8 = 1; c.K = D; c.N = FFE; t -= 4096;
    if (t < 14336) { const int hf = t / 7168, r2 = t % 7168, e = r2 / 896, r = r2 % 896, hk = r & 1, q = r >> 1; c.W = (hf ? A->in[I_MWU] : A->in[I_MWG]) + (size_t)e * D * FFE; c.WT = ws + WS_MUP + (size_t)e * 2 * FFE * D; c.k0 = 128 * (q / 28) + 64 * hk; c.n0 = 256 * (q % 28); c.kind = 2 + hf; return true; } t -= 14336;
    if (t >= 7168) return false;
    { const int e = t / 896, r = t % 896, hk = r & 1, q = r >> 1; c.W = A->in[I_MWD] + (size_t)e * FFE * D; c.WT = ws + WS_MDN + (size_t)e * D * FFE; c.K = FFE; c.N = D; c.k0 = 128 * (q >> 3) + 64 * hk; c.n0 = 256 * (q & 7); c.kind = 0; return true; }
}
__device__ __forceinline__ void conv_emit_moe(const ConvTile& c, const f32x4 (&r)[8], LAS unsigned char* T, int tid, int wave, int lane) {
    if (c.kind == 0) conv_store_fp8(r, c.WT, c.K, c.k0, c.n0, RmOff{0}, T, tid, wave, lane); else conv_store_fp8(r, c.WT, c.K, c.k0, c.n0, RmGU{c.kind - 2}, T, tid, wave, lane);
}
__device__ __forceinline__ void conv_emit(const ConvTile& c, const f32x4 (&r)[8], LAS unsigned char* T, int tid, int wave, int lane) {
    if (c.f8) { if (c.kind == 0) conv_store_fp8(r, c.WT, c.K, c.k0, c.n0, RmOff{0}, T, tid, wave, lane); else conv_store_fp8(r, c.WT, c.K, c.k0, c.n0, RmGU{c.kind - 2}, T, tid, wave, lane); }
    else if (c.kind == 0) conv_store_bf16(r, c.WT, c.K * 2, c.k0 * 2, c.n0, RmOff{0}, T, tid, wave, lane);
    else if (c.kind == 1) conv_store_bf16(r, c.WT, c.K * 2, c.k0 * 2, c.n0, RmWin{}, T, tid, wave, lane);
    else conv_store_bf16(r, c.WT, c.K * 2, c.k0 * 2, c.n0, RmGU{c.kind - 2}, T, tid, wave, lane);
}
namespace pg8 {
template <int NSLOT, bool MOE> __device__ __forceinline__ void conv_burst(const ConvHook& h, int bid, PG8_LAS unsigned char* T_, int tid) {
    KA A = ka_get(); const int lane = tid & 63, wave = __builtin_amdgcn_readfirstlane(tid >> 6); LAS unsigned char* T = (LAS unsigned char*)T_;
    const int p0 = (h.t0 >> 1) + bid, p1 = h.t1 >> 1;
#define CV_TILE(j) (2 * (p0 + 256 * ((j) >> 1)) + ((j) & 1))
#define CV_VALID(j) ((p0 + 256 * ((j) >> 1)) < p1)
#define CV_DEC(t, c) (MOE ? conv_decode_moe(A, (t), (c)) : conv_decode(A, (t), (c)))
#define CV_LOAD(j, R) do { ConvTile c_; if (CV_VALID(j) && CV_DEC(CV_TILE(j), c_)) conv_load(c_.W, c_.N, c_.k0, c_.n0, wave, lane, R); } while (0)
#define CV_PROC(j, R) { ConvTile c_; if (!CV_VALID(j) || !CV_DEC(CV_TILE(j), c_)) break; if constexpr (MOE) conv_emit_moe(c_, R, T, tid, wave, lane); else conv_emit(c_, R, T, tid, wave, lane); }
    if constexpr (NSLOT == 4) {
        f32x4 R0[8], R1[8], R2[8], R3[8];
        CV_LOAD(0, R0); CV_LOAD(1, R1); CV_LOAD(2, R2);
        for (int j = 0;; j += 4) {
            CV_LOAD(j + 3, R3); CV_PROC(j, R0)
            CV_LOAD(j + 4, R0); CV_PROC(j + 1, R1)
            CV_LOAD(j + 5, R1); CV_PROC(j + 2, R2)
            CV_LOAD(j + 6, R2); CV_PROC(j + 3, R3)
        }
    } else {
        f32x4 R0[8], R1[8], R2[8];
        CV_LOAD(0, R0); CV_LOAD(1, R1);
        for (int j = 0;; j += 3) {
            CV_LOAD(j + 2, R2); CV_PROC(j, R0)
            CV_LOAD(j + 3, R0); CV_PROC(j + 1, R1)
            CV_LOAD(j + 4, R1); CV_PROC(j + 2, R2)
        }
    }
#undef CV_TILE
#undef CV_VALID
#undef CV_LOAD
#undef CV_PROC
#undef CV_DEC
}
}
__device__ __forceinline__ void ada_item(const float* wada, float* adap, const LAS float* S, int it, int lane) {
    const int l = it / 1536, rem = it - l * 1536, cg = rem >> 5, ks = rem & 31; const int k0 = ks * 64, col = cg * 256 + 4 * lane;
    const float* w = wada + ((size_t)l * D + k0) * ADAW + col;
    f32x4 a0 = {0.f, 0.f, 0.f, 0.f}, a1 = a0, a2 = a0;
#pragma unroll 8
    for (int kk = 0; kk < 64; ++kk) { const f32x4 v = *(const GAS f32x4*)(w + (size_t)kk * ADAW); const float s0 = S[k0 + kk], s1 = S[2048 + k0 + kk], s2 = S[4096 + k0 + kk];
        a0 += v * s0; a1 += v * s1; a2 += v * s2; }
    float* o = adap + (((size_t)l * 32 + ks) * 3) * ADAW + col;
    *(GAS f32x4*)o = a0; *(GAS f32x4*)(o + ADAW) = a1; *(GAS f32x4*)(o + 2 * ADAW) = a2;
}
__device__ __forceinline__ void p0a_phase(KA A, LAS unsigned char* lds, int tid, int wave, int lane, int bid, int G) {
    unsigned char* ws = A->ws;
    LAS float* S = (LAS float*)(lds + 73728);
    { float cv[12];
#pragma unroll
      for (int it = 0; it < 12; ++it) { const int i = tid + it * NTHR; cv[it] = i < 2 * D ? A->in[I_C][i] : A->in[I_CCTX][i - 2 * D]; }
      SCHED_FENCE();
#pragma unroll
      for (int it = 0; it < 12; ++it) S[tid + it * NTHR] = silu_f(cv[it]); }
    __syncthreads();
    const int gw = bid * NWAVES + wave, NGW = G * NWAVES;
    for (int it = gw; it < 3072; it += NGW) ada_item(A->in[I_WADA], (float*)(ws + WS_ADAP), S, it, lane);
    { bf16* wsm = (bf16*)(ws + WS_WSM); const float* win = A->in[I_WIN];
      for (int idx = bid * NTHR + tid; idx < 2 * NSM * D; idx += G * NTHR) { const int l = idx / (NSM * D), j = (idx / D) % NSM, k = idx % D; const int col = j < 16 ? 4096 + j : 5648 + (j - 16);
          wsm[idx] = (unsigned short)f2bf(win[((size_t)l * D + k) * PSRC + col]); } }
    __syncthreads();
    pg8::conv_burst<4, false>(pg8::ConvHook{0, CT_P0A_HI, -1}, bid, lds + CONV_OFF, tid);
    __syncthreads();
}
__device__ __forceinline__ void p0b_phase(KA A, int tid, int bid, int G) {
    const float* adap = (const float*)(A->ws + WS_ADAP); float* modf = (float*)(A->ws + WS_MODF);
    constexpr int NV = 2 * 3 * ADAW / 4;
    for (int v = bid * NTHR + tid; v < NV; v += G * NTHR) {
        const int l = v / (3 * ADAW / 4), rem = v % (3 * ADAW / 4), r = rem / (ADAW / 4), c4 = rem % (ADAW / 4);
        f32x4 s = *(const GAS f32x4*)(A->in[I_BADA] + (size_t)l * ADAW + 4 * c4);
        f32x4 t[32];
#pragma unroll
        for (int ks = 0; ks < 32; ++ks) t[ks] = *(const GAS f32x4*)(adap + (((size_t)l * 32 + ks) * 3 + r) * ADAW + 4 * c4);
        SCHED_FENCE();
#pragma unroll
        for (int ks = 0; ks < 32; ++ks) s += t[ks];
        *(GAS f32x4*)(modf + ((size_t)l * 3 + r) * ADAW + 4 * c4) = s;
    }
}

__device__ __forceinline__ int wg_row(int bid, int rl) { if (rl < 32) return (bid >> 7) * TB + CTXL + 32 * (bid & 127) + rl; const int q = 2 * bid + (rl - 32); return (q >> 8) * TB + (q & 255); }
#define VIDX(j) (128 * ((j) >> 1) + ((j) & 1))
template <bool ROUTER, bool SMALLP>
__device__ __forceinline__ void norm_phase(KA A, LAS unsigned char* lds, int l, int which, int npart, const float* pgate, int tid, int wave, int lane, int bid) {
    unsigned char* ws = A->ws;
    const float* modl = (const float*)(ws + WS_MODF) + (size_t)l * 3 * ADAW;
    const float* gvec = (which ? A->in[I_GFFN] : A->in[I_GMIX]) + (size_t)l * D;
    const int bw = bid >> 7;
    LAS float* cA = (LAS float*)lds;
    LAS float* cB = cA + 2 * D;
    LAS float* wrT = (LAS float*)(lds + 32768);
    LAS int* rt = (LAS int*)(lds + 98304);
    {   float gv[8], m1[8], m0[8];
#pragma unroll
        for (int it = 0; it < 8; ++it) { const int i = tid + it * NTHR; const int t = i >> 11, col = i & (D - 1); const float* m = modl + (size_t)(t ? 2 : bw) * ADAW;
            gv[it] = gvec[col]; m1[it] = m[(which ? 4 : 1) * D + col]; m0[it] = m[(which ? 3 : 0) * D + col]; }
        SCHED_FENCE();
#pragma unroll
        for (int it = 0; it < 8; ++it) { const int i = tid + it * NTHR; cA[i] = gv[it] * (1.f + m1[it]); cB[i] = m0[it]; }
    }
    if (ROUTER) { const float* wr = A->in[I_MROUTER]; float w32[32];
#pragma unroll
        for (int it = 0; it < 32; ++it) w32[it] = wr[tid + it * NTHR];
        SCHED_FENCE();
#pragma unroll
        for (int it = 0; it < 32; ++it) { const int i = tid + it * NTHR; wrT[(i & 7) * D + (i >> 3)] = w32[it]; } }
    __syncthreads();
    bf16* XN = (bf16*)(ws + WS_XN); bf16* H = (bf16*)(ws + WS_H); const bf16* PART = (const bf16*)(ws + WS_PART);
#define NORM_LOAD(rl_) do { const int row_ = wg_row(bid, (rl_)), s_ = row_ % TB, b_ = row_ / TB; const bool isctx_ = s_ < CTXL; const bool from_in_ = (l == 0) && (which == 0 || (isctx_ && npart > 0)); nb = !from_in_; \
        if (from_in_) { const GAS f32x4* xr_ = (const GAS f32x4*)(isctx_ ? A->in[I_CTX] + (size_t)(b_ * CTXL + s_) * D : A->in[I_X] + (size_t)(b_ * SEQ + s_ - CTXL) * D) + 2 * lane; \
            _Pragma("unroll") for (int j = 0; j < 8; ++j) vnx[j] = xr_[VIDX(j)]; } \
        else { const GAS v4u* hr_ = (const GAS v4u*)(H + (size_t)row_ * D) + lane; _Pragma("unroll") for (int jj = 0; jj < 4; ++jj) vnb[jj] = hr_[64 * jj]; } } while (0)
    f32x4 vnx[8]; v4u vnb[4]; bool nb;
    NORM_LOAD(wave);
    for (int rl = wave; rl < 34; rl += NWAVES) {
        const int row = wg_row(bid, rl), s = row % TB; const bool isctx = s < CTXL; const int b = row / TB;
        f32x4 v[8]; float ss = 0.f;
        if (nb) {
#pragma unroll
            for (int jj = 0; jj < 4; ++jj) { float f[8]; unpack8(vnb[jj], f); v[2 * jj] = (f32x4){f[0], f[1], f[2], f[3]}; v[2 * jj + 1] = (f32x4){f[4], f[5], f[6], f[7]}; }
        } else {
#pragma unroll
            for (int j = 0; j < 8; ++j) v[j] = vnx[j];
        }
        if (rl + NWAVES < 34) NORM_LOAD(rl + NWAVES);
        if (isctx && npart > 0) {
            f32x4 acc[8];
#pragma unroll
            for (int j = 0; j < 8; ++j) acc[j] = (f32x4){0.f, 0.f, 0.f, 0.f};
            for (int p0 = 0; p0 < npart; p0 += 6) { v4u t[6][4];
#pragma unroll
                for (int q = 0; q < 6; ++q) { const int p = (p0 + q < npart) ? p0 + q : p0; const GAS v4u* pr = (const GAS v4u*)(PART + ((size_t)p * 512 + b * CTXL + s) * D) + lane;
#pragma unroll
                    for (int jj = 0; jj < 4; ++jj) t[q][jj] = pr[64 * jj]; }
                SCHED_FENCE();
#pragma unroll
                for (int q = 0; q < 6; ++q) if (p0 + q < npart) {
#pragma unroll
                    for (int jj = 0; jj < 4; ++jj) { float f[8]; unpack8(t[q][jj], f); acc[2 * jj] += (f32x4){f[0], f[1], f[2], f[3]}; acc[2 * jj + 1] += (f32x4){f[4], f[5], f[6], f[7]}; } } }
            const GAS f32x4* gp = (const GAS f32x4*)pgate + 2 * lane; GAS v4u* hw = (GAS v4u*)(H + (size_t)row * D) + lane;
#pragma unroll
            for (int j = 0; j < 8; ++j) v[j] += gp[VIDX(j)] * acc[j];
#pragma unroll
            for (int jj = 0; jj < 4; ++jj) { const float f[8] = {v[2 * jj].x, v[2 * jj].y, v[2 * jj].z, v[2 * jj].w, v[2 * jj + 1].x, v[2 * jj + 1].y, v[2 * jj + 1].z, v[2 * jj + 1].w}; hw[64 * jj] = pack8(f); }
        }
#pragma unroll
        for (int j = 0; j < 8; ++j) ss += (v[j].x * v[j].x + v[j].y * v[j].y) + (v[j].z * v[j].z + v[j].w * v[j].w);
        const float rstd = __builtin_amdgcn_rsqf(wave_sum(ss) * (1.f / D) + EPS);
        const LAS f32x4* ca = (const LAS f32x4*)(cA + (isctx ? D : 0)) + 2 * lane; const LAS f32x4* cb = (const LAS f32x4*)(cB + (isctx ? D : 0)) + 2 * lane;
        GAS v4u* o16 = (GAS v4u*)(XN + (size_t)row * D) + lane; GAS unsigned long long* o8 = (GAS unsigned long long*)((unsigned char*)XN + (size_t)row * D) + lane;
#pragma unroll
        for (int j = 0; j < 8; ++j) v[j] = v[j] * rstd * ca[VIDX(j)] + cb[VIDX(j)];
#pragma unroll
        for (int jj = 0; jj < 4; ++jj) { const f32x4 x0 = v[2 * jj], x1 = v[2 * jj + 1];
            if (ROUTER) o8[64 * jj] = (unsigned long long)pk4_fp8(x0.x * XN8_SCALE, x0.y * XN8_SCALE, x0.z * XN8_SCALE, x0.w * XN8_SCALE) | ((unsigned long long)pk4_fp8(x1.x * XN8_SCALE, x1.y * XN8_SCALE, x1.z * XN8_SCALE, x1.w * XN8_SCALE) << 32);
            else { v4u o; o.x = pg8::cvt_pk_bf16(x0.x, x0.y); o.y = pg8::cvt_pk_bf16(x0.z, x0.w); o.z = pg8::cvt_pk_bf16(x1.x, x1.y); o.w = pg8::cvt_pk_bf16(x1.z, x1.w); o16[64 * jj] = o; } }
        if (ROUTER) {
            float lg[8];
#pragma unroll
            for (int e = 0; e < 8; ++e) { const LAS f32x4* wv = (const LAS f32x4*)(wrT + e * D) + 2 * lane; float a = 0.f;
#pragma unroll
                for (int j = 0; j < 8; ++j) { const f32x4 w = wv[VIDX(j)]; a += (v[j].x * w.x + v[j].y * w.y) + (v[j].z * w.z + v[j].w * w.w); }
                lg[e] = wave_sum(a); }
            int e1 = 0; float v1 = lg[0];
#pragma unroll
            for (int e = 1; e < 8; ++e) if (lg[e] > v1) { v1 = lg[e]; e1 = e; }
            int e2 = -1; float v2 = -3.0e38f;
#pragma unroll
            for (int e = 0; e < 8; ++e) if (e != e1 && lg[e] > v2) { v2 = lg[e]; e2 = e; }
            const float ex = __expf(v2 - v1), w1 = 1.f / (1.f + ex), w2 = ex * w1;
            if (lane == 0) { rt[rl * 4 + 0] = isctx ? -1 : e1; rt[rl * 4 + 1] = e2; rt[rl * 4 + 2] = __float_as_int(w1); rt[rl * 4 + 3] = __float_as_int(w2); }
        }
    }
    if (ROUTER) {
        __syncthreads();
        if (tid < 34) { const int rl = tid; const int e1 = rt[rl * 4];
            if (e1 >= 0) { const int e2 = rt[rl * 4 + 1]; int r1 = 0, r2 = 0;
#pragma unroll 2
                for (int q = 0; q < 34; ++q) { const int f1 = rt[q * 4], f2 = rt[q * 4 + 1]; if (q < rl && f1 >= 0) { r1 += (f1 == e1 ? 1 : 0) + (f2 == e1 ? 1 : 0); r2 += (f1 == e2 ? 1 : 0) + (f2 == e2 ? 1 : 0); } }
                int4* route = (int4*)(ws + WS_ROUTE);
                route[wg_row(bid, rl)] = make_int4(e1 | (e2 << 4) | (r1 << 8) | (r2 << 16), rt[rl * 4 + 2], rt[rl * 4 + 3], 0); } }
        else if (tid >= 64 && tid < 72) { const int e = tid - 64; int cn = 0;
#pragma unroll 2
            for (int q = 0; q < 34; ++q) { const int f1 = rt[q * 4], f2 = rt[q * 4 + 1]; if (f1 >= 0) cn += (f1 == e ? 1 : 0) + (f2 == e ? 1 : 0); }
            ((int*)(ws + WS_CNT))[bid * 8 + e] = cn; }
    }
    if (SMALLP) {
        asm volatile("s_waitcnt vmcnt(0)" ::: "memory"); __syncthreads();
        const bf16* wsm = (const bf16*)(ws + WS_WSM) + (size_t)l * NSM * D;
        const int l16 = lane & 15, q = lane >> 4;
        f32x4 acc[3][3];
#pragma unroll
        for (int a = 0; a < 3; ++a)
#pragma unroll
            for (int c = 0; c < 3; ++c) acc[a][c] = (f32x4){0.f, 0.f, 0.f, 0.f};
        const bf16* ap[3]; const bf16* bp[3];
#pragma unroll
        for (int a = 0; a < 3; ++a) { int r = 16 * a + l16; r = r < 34 ? r : 33; ap[a] = XN + (size_t)wg_row(bid, r) * D + 256 * wave + 8 * q; bp[a] = wsm + (size_t)(16 * a + l16) * D + 256 * wave + 8 * q; }
#pragma unroll
        for (int k4 = 0; k4 < 2; ++k4) { bf16x8 fa[4][3], fb[4][3];
#pragma unroll
            for (int kq = 0; kq < 4; ++kq)
#pragma unroll
                for (int a = 0; a < 3; ++a) { fa[kq][a] = *(const GAS bf16x8*)(ap[a] + 32 * (4 * k4 + kq)); fb[kq][a] = *(const GAS bf16x8*)(bp[a] + 32 * (4 * k4 + kq)); }
            SCHED_FENCE();
#pragma unroll
            for (int kq = 0; kq < 4; ++kq)
#pragma unroll
                for (int a = 0; a < 3; ++a)
#pragma unroll
                    for (int c = 0; c < 3; ++c) acc[a][c] = __builtin_amdgcn_mfma_f32_16x16x32_bf16(fa[kq][a], fb[kq][c], acc[a][c], 0, 0, 0); }
        LAS float* red = (LAS float*)(lds + 32768);
#pragma unroll
        for (int a = 0; a < 3; ++a)
#pragma unroll
            for (int c = 0; c < 3; ++c)
#pragma unroll
                for (int j = 0; j < 4; ++j) red[(wave * 48 + 16 * a + 4 * q + j) * 48 + 16 * c + l16] = acc[a][c][j];
        __syncthreads();
        float* PS = (float*)(ws + WS_PS);
#pragma unroll
        for (int it = 0; it < 4; ++it) { const int i = tid + it * NTHR; if (i >= 34 * 48) break; float s = 0.f;
#pragma unroll
            for (int w = 0; w < 8; ++w) s += red[w * 2304 + i];
            PS[(size_t)wg_row(bid, i / 48) * NSM + (i % 48)] = s; }
    }
    __syncthreads();
}

__device__ __forceinline__ void seg_flags(int row, bool& hl, bool& hr) { const int s = row % TB; if (s < CTXL) { hl = s != 0; hr = s != CTXL - 1; } else { const int t = (s - CTXL) & 63; hl = t != 0; hr = t != 63; } }
__device__ __forceinline__ void conv8(const bf16* P, const float* cw, const float* cb, int row, int pcol, int xc, float (&o)[8]) {
    bool hl, hr; seg_flags(row, hl, hr);
    const bf16* p = P + (size_t)row * NP + pcol; const v4u z = {0u, 0u, 0u, 0u};
    const v4u vc = *(const GAS v4u*)p, vl = hl ? *(const GAS v4u*)(p - NP) : z, vr = hr ? *(const GAS v4u*)(p + NP) : z;
    float c[8], lf[8], rg[8]; unpack8(vc, c); unpack8(vl, lf); unpack8(vr, rg);
    const f32x4 w0a = *(const GAS f32x4*)(cw + xc), w0b = *(const GAS f32x4*)(cw + xc + 4), w1a = *(const GAS f32x4*)(cw + 1024 + xc), w1b = *(const GAS f32x4*)(cw + 1024 + xc + 4),
                w2a = *(const GAS f32x4*)(cw + 2048 + xc), w2b = *(const GAS f32x4*)(cw + 2048 + xc + 4), ba = *(const GAS f32x4*)(cb + xc), bb = *(const GAS f32x4*)(cb + xc + 4);
#pragma unroll
    for (int e = 0; e < 4; ++e) { o[e] = silu_f(w0a[e] * lf[e] + w1a[e] * c[e] + w2a[e] * rg[e] + ba[e]); o[4 + e] = silu_f(w0b[e] * lf[4 + e] + w1b[e] * c[4 + e] + w2b[e] * rg[4 + e] + bb[e]); }
}

struct ConvW { f32x4 w0a, w0b, w1a, w1b, w2a, w2b, ba, bb; };
__device__ __forceinline__ void convw_load(ConvW& w, const float* cw, const float* cb, int xc) {
    w.w0a = *(const GAS f32x4*)(cw + xc); w.w0b = *(const GAS f32x4*)(cw + xc + 4); w.w1a = *(const GAS f32x4*)(cw + 1024 + xc); w.w1b = *(const GAS f32x4*)(cw + 1024 + xc + 4);
    w.w2a = *(const GAS f32x4*)(cw + 2048 + xc); w.w2b = *(const GAS f32x4*)(cw + 2048 + xc + 4); w.ba = *(const GAS f32x4*)(cb + xc); w.bb = *(const GAS f32x4*)(cb + xc + 4); }
struct ConvIn { v4u vc, vl, vr; };
__device__ __forceinline__ void convin_load(ConvIn& x, const bf16* P, int row, int pcol) {
    bool hl, hr; seg_flags(row, hl, hr); const bf16* p = P + (size_t)row * NP + pcol; const v4u z = {0u, 0u, 0u, 0u};
    x.vc = *(const GAS v4u*)p; x.vl = hl ? *(const GAS v4u*)(p - NP) : z; x.vr = hr ? *(const GAS v4u*)(p + NP) : z; }
__device__ __forceinline__ void conv8w(const ConvIn& x, const ConvW& w, float (&o)[8]) {
    float c[8], lf[8], rg[8]; unpack8(x.vc, c); unpack8(x.vl, lf); unpack8(x.vr, rg);
#pragma unroll
    for (int e = 0; e < 4; ++e) { o[e] = silu_f(w.w0a[e] * lf[e] + w.w1a[e] * c[e] + w.w2a[e] * rg[e] + w.ba[e]); o[4 + e] = silu_f(w.w0b[e] * lf[4 + e] + w.w1b[e] * c[4 + e] + w.w2b[e] * rg[4 + e] + w.bb[e]); }
}
__device__ __forceinline__ void m1_sccm_item(KA A, LAS unsigned char* lds, int l, int item, int tid, int wave, int lane) {
    unsigned char* ws = A->ws; const bf16* P = (const bf16*)(ws + WS_P); bf16* YM = (bf16*)(ws + WS_YMIX);
    const int cc = item >> 2, g = item & 3; const int b = cc / NCH_M, c = cc % NCH_M, row0 = b * TB + c * 128;
    const float* scw = A->in[I_SCW] + (size_t)l * 3 * 512;
    {   const int v = tid & 15, ch = 128 * g + 8 * v; const v4u z = {0u, 0u, 0u, 0u}; v4u in[4][7]; f32x4 sw[6];
#pragma unroll
        for (int it = 0; it < 4; ++it) { const int row = row0 + (tid >> 4) + 32 * it; bool hl, hr; seg_flags(row, hl, hr); const bf16* p = P + (size_t)row * NP;
            in[it][0] = *(const GAS v4u*)(p + C_BG + ch); in[it][1] = *(const GAS v4u*)(p + C_CG + ch); in[it][2] = *(const GAS v4u*)(p + C_XA + ch);
            in[it][3] = hl ? *(const GAS v4u*)(p - NP + C_CG + ch) : z; in[it][4] = hl ? *(const GAS v4u*)(p - NP + C_XA + ch) : z;
            in[it][5] = hr ? *(const GAS v4u*)(p + NP + C_CG + ch) : z; in[it][6] = hr ? *(const GAS v4u*)(p + NP + C_XA + ch) : z; }
#pragma unroll
        for (int k = 0; k < 3; ++k) { sw[2 * k] = *(const GAS f32x4*)(scw + 512 * k + ch); sw[2 * k + 1] = *(const GAS f32x4*)(scw + 512 * k + ch + 4); }
        SCHED_FENCE();
#pragma unroll
        for (int it = 0; it < 4; ++it) { const int row = row0 + (tid >> 4) + 32 * it; float bg[8], u0[8], u1[8], u2[8], t0[8], t1[8];
            unpack8(in[it][0], bg); unpack8(in[it][1], t0); unpack8(in[it][2], t1);
#pragma unroll
            for (int e = 0; e < 8; ++e) u1[e] = t0[e] * t1[e];
            unpack8(in[it][3], t0); unpack8(in[it][4], t1);
#pragma unroll
            for (int e = 0; e < 8; ++e) u0[e] = t0[e] * t1[e];
            unpack8(in[it][5], t0); unpack8(in[it][6], t1);
#pragma unroll
            for (int e = 0; e < 8; ++e) u2[e] = t0[e] * t1[e];
            float o[8];
#pragma unroll
            for (int e = 0; e < 8; ++e) o[e] = bg[e] * (sw[e >> 2][e & 3] * u0[e] + sw[2 + (e >> 2)][e & 3] * u1[e] + sw[4 + (e >> 2)][e & 3] * u2[e]);
            *(GAS v4u*)(YM + (size_t)row * D + ch) = pack8(o); }
    }
    lbf16* Ws = (lbf16*)lds; lbf16* Vt = (lbf16*)(lds + 34816);
    const float* wsrc = A->in[I_CMW] + ((size_t)l * 4 + g) * 128 * 128; const float* bsrc = A->in[I_CMB] + ((size_t)l * 4 + g) * 128;
    f32x4 wv[8]; v4u vin[4]; unsigned long long uu[2][2][2]; float bias[2][2];
#pragma unroll
    for (int it = 0; it < 8; ++it) { const int task = tid + it * NTHR; const int i = task >> 5, j4 = task & 31; wv[it] = *(const GAS f32x4*)(wsrc + i * 128 + 4 * j4); }
#pragma unroll
    for (int it = 0; it < 4; ++it) { const int task = tid + it * NTHR; const int j = task >> 4, v = task & 15; vin[it] = *(const GAS v4u*)(P + (size_t)(row0 + j) * NP + C_CMV + 128 * g + 8 * v); }
#pragma unroll
    for (int qb = 0; qb < 2; ++qb) { const int blk = wave + qb * NWAVES; const int m0 = 32 * (blk >> 2), n0 = 32 * (blk & 3);
#pragma unroll
        for (int bq = 0; bq < 2; ++bq) { const int i = n0 + 16 * bq + (lane & 15); bias[qb][bq] = bsrc[i];
#pragma unroll
            for (int a = 0; a < 2; ++a) { const int d = m0 + 16 * a + 4 * (lane >> 4); uu[qb][a][bq] = *(const GAS unsigned long long*)(P + (size_t)(row0 + i) * NP + C_CMU + 128 * g + d); } } }
    SCHED_FENCE();
#pragma unroll
    for (int it = 0; it < 8; ++it) { const int task = tid + it * NTHR; const int i = task >> 5, j4 = task & 31; const f32x4 w = wv[it];
        *(LAS unsigned long long*)(Ws + i * 136 + 4 * j4) = (unsigned long long)pg8::cvt_pk_bf16(w.x, w.y) | ((unsigned long long)pg8::cvt_pk_bf16(w.z, w.w) << 32); }
#pragma unroll
    for (int it = 0; it < 4; ++it) { const int task = tid + it * NTHR; const int j = task >> 4, v = task & 15; float f[8]; unpack8(vin[it], f);
#pragma unroll
        for (int e = 0; e < 8; ++e) Vt[(8 * v + e) * 136 + tswz<15>(8 * v + e, j)] = (unsigned short)f2bf(gelu_tanh(f[e])); }
    __syncthreads();
#pragma unroll
    for (int qb = 0; qb < 2; ++qb) { const int blk = wave + qb * NWAVES; const int m0 = 32 * (blk >> 2), n0 = 32 * (blk & 3);
        Acc32 acc; acc_zero(acc); wave_mma32<15, -1>(acc, Vt, 136, Ws, 136, m0, n0, 128, lane);
#pragma unroll
        for (int a = 0; a < 2; ++a)
#pragma unroll
            for (int bq = 0; bq < 2; ++bq) { const int d = m0 + 16 * a + 4 * (lane >> 4), i = n0 + 16 * bq + (lane & 15); const float bi = bias[qb][bq];
                const size_t prow = (size_t)(row0 + i); const unsigned long long u8 = uu[qb][a][bq];
                const float u0 = gelu_tanh(__uint_as_float((unsigned)u8 << 16)), u1 = gelu_tanh(__uint_as_float((unsigned)u8 & 0xffff0000u)), u2 = gelu_tanh(__uint_as_float((unsigned)(u8 >> 32) << 16)), u3 = gelu_tanh(__uint_as_float((unsigned)(u8 >> 32) & 0xffff0000u));
                const f32x4 sv = acc.v[a][bq];
                *(GAS unsigned long long*)(YM + prow * D + 512 + 128 * g + d) = (unsigned long long)pg8::cvt_pk_bf16(u0 * (sv[0] + bi), u1 * (sv[1] + bi)) | ((unsigned long long)pg8::cvt_pk_bf16(u2 * (sv[2] + bi), u3 * (sv[3] + bi)) << 32); }
    }
    __syncthreads();
}

__device__ __forceinline__ void m1_mamba_group(KA A, LAS unsigned char* lds, int l, int item, int tid, int wave, int lane) {
    unsigned char* ws = A->ws; const bf16* P = (const bf16*)(ws + WS_P);
    const int cc = item >> 1, g = item & 1; const int b = cc / NCH_M, c = cc % NCH_M, row0 = b * TB + c * 128;
    const float* cw = A->in[I_MBCW] + (size_t)l * 3 * 1024; const float* cb = A->in[I_MBCB] + (size_t)l * 1024;
    lbf16* Cm = (lbf16*)lds; lbf16* Bm = (lbf16*)(lds + 34816); lbf16* BmT = (lbf16*)(lds + 69632); lbf16* Xt = (lbf16*)(lds + 104448);
    LAS float* sm = (LAS float*)(lds + 121856);
    {
        const int v = tid & 15; ConvIn xb[4], xc[4]; ConvW wB, wC;
#pragma unroll
        for (int q = 0; q < 4; ++q) convin_load(xb[q], P, row0 + (tid >> 4) + 32 * q, C_BM + 128 * g + 8 * v);
#pragma unroll
        for (int q = 0; q < 4; ++q) convin_load(xc[q], P, row0 + (tid >> 4) + 32 * q, C_CM + 128 * g + 8 * v);
        convw_load(wB, cw, cb, 512 + 128 * g + 8 * v); convw_load(wC, cw, cb, 768 + 128 * g + 8 * v);
        SCHED_FENCE();
#pragma unroll
        for (int q = 0; q < 4; ++q) { const int t = (tid >> 4) + 32 * q; float o[8]; conv8w(xb[q], wB, o); *(LAS v4u*)(Bm + t * 136 + 8 * v) = pack8(o);
#pragma unroll
            for (int e = 0; e < 8; ++e) BmT[(8 * v + e) * 136 + tswz<15>(8 * v + e, t)] = (unsigned short)f2bf(o[e]); }
#pragma unroll
        for (int q = 0; q < 4; ++q) { const int t = (tid >> 4) + 32 * q; float o[8]; conv8w(xc[q], wC, o); *(LAS v4u*)(Cm + t * 136 + 8 * v) = pack8(o); }
    }
    __syncthreads();
    Acc32 cbraw[2];
#pragma unroll
    for (int q2 = 0; q2 < 2; ++q2) { const int blk = wave + 8 * q2; acc_zero(cbraw[q2]); wave_mma32(cbraw[q2], Cm, 136, Bm, 136, 32 * (blk >> 2), 32 * (blk & 3), 128, lane); }
    __syncthreads();
    lbf16* Wl = Cm; lbf16* XwT = Bm;
    ConvIn xn[2]; ConvW wn; float dtn = 0.f, al0n, al1n, d0n, d1n;
#define MG_ISSUE(hx) do { const int v_ = tid & 7; _Pragma("unroll") for (int i = 0; i < 2; ++i) convin_load(xn[i], P, row0 + (tid >> 3) + 64 * i, C_XS + 64 * (hx) + 8 * v_); convw_load(wn, cw, cb, 64 * (hx) + 8 * v_); \
        if (tid < 256) dtn = ((const float*)(ws + WS_PS))[(size_t)(row0 + (tid & 127)) * NSM + (tid >> 7) * 8 + (hx)] + A->in[I_MBDTB][(l * 2 + (tid >> 7)) * 8 + (hx)]; \
        al0n = A->in[I_MBALOG][(l * 2 + 0) * 8 + (hx)]; al1n = A->in[I_MBALOG][(l * 2 + 1) * 8 + (hx)]; d0n = A->in[I_MBD][(l * 2 + 0) * 8 + (hx)]; d1n = A->in[I_MBD][(l * 2 + 1) * 8 + (hx)]; } while (0)
    MG_ISSUE(4 * g);
#pragma unroll 1
    for (int hh = 0; hh < 4; ++hh) { const int h = 4 * g + hh; float al0c, al1c, dsc;
    {
        const int v = tid & 7; const ConvW w = wn; const ConvIn x[2] = {xn[0], xn[1]}; const float dtx = dtn; al0c = al0n; al1c = al1n; dsc = d0n + d1n;
        asm volatile("" : "+v"(tid), "+v"(lane)); asm volatile("" : "+s"(wave));
        if (hh < 3) MG_ISSUE(h + 1);
        SCHED_FENCE();
#pragma unroll
        for (int i = 0; i < 2; ++i) { const int t = (tid >> 3) + 64 * i; float o[8]; conv8w(x[i], w, o);
#pragma unroll
            for (int e = 0; e < 8; ++e) Xt[(8 * v + e) * 136 + tswz<15>(8 * v + e, t)] = (unsigned short)f2bf(o[e]); }
        if (tid < 256) sm[(tid >> 7) * 128 + (tid & 127)] = softplus_f(dtx);
    }
    __syncthreads();
    const float an0 = -__expf(al0c), an1 = -__expf(al1c);
    if (wave == 0) {
        const float x0 = sm[2 * lane] * an0, x1 = sm[2 * lane + 1] * an0; float S = x0 + x1;
#pragma unroll
        for (int off = 1; off < 64; off <<= 1) { const float y = __shfl_up(S, off); if (lane >= off) S += y; }
        float E = __shfl_up(S, 1); if (lane == 0) E = 0.f;
        sm[256 + 2 * lane] = E + x0; sm[256 + 2 * lane + 1] = E + (x0 + x1);
    } else if (wave == 1) {
        const float x0 = sm[128 + 2 * lane] * an1, x1 = sm[128 + 2 * lane + 1] * an1; float S = x0 + x1;
#pragma unroll
        for (int off = 1; off < 64; off <<= 1) { const float y = __shfl_down(S, off); if (lane + off < 64) S += y; }
        float E = __shfl_down(S, 1); if (lane == 63) E = 0.f;
        sm[384 + 2 * lane + 1] = E + x1; sm[384 + 2 * lane] = E + (x1 + x0);
    }
    __syncthreads();
    const LAS float* dt0 = sm; const LAS float* dt1 = sm + 128; const LAS float* ac0 = sm + 256; const LAS float* ac1 = sm + 384;
#pragma unroll
    for (int q2 = 0; q2 < 2; ++q2) { const int blk = wave + 8 * q2;
#pragma unroll
        for (int a = 0; a < 2; ++a)
#pragma unroll
            for (int bq = 0; bq < 2; ++bq) { const int jj = 32 * (blk & 3) + 16 * bq + (lane & 15); const float a0j = ac0[jj], a1j = ac1[jj], d0j = dt0[jj], d1j = dt1[jj];
#pragma unroll
                for (int j = 0; j < 4; ++j) { const int i = 32 * (blk >> 2) + 16 * a + 4 * (lane >> 4) + j; float f = 0.f;
                    if (jj <= i) f += __expf(ac0[i] - a0j) * d0j;
                    if (jj >= i) f += __expf(ac1[i] - a1j) * d1j;
                    Wl[i * 136 + jj] = (unsigned short)f2bf(cbraw[q2].v[a][bq][j] * f); } }
    }
    const float al0 = ac0[127], al1 = ac1[0];
#pragma unroll
    for (int it = 0; it < 2048 / NTHR; ++it) { const int task = tid + it * NTHR; const int d = task >> 10, p = (task >> 4) & 63, v = task & 15; float f[8]; unpack8(*(const LAS v4u*)(Xt + p * 136 + 8 * (v ^ ((p >> 3) & 15))), f);
#pragma unroll
        for (int e = 0; e < 8; ++e) { const int j = 8 * v + e; f[e] *= d ? __expf(al1 - ac1[j]) * dt1[j] : __expf(al0 - ac0[j]) * dt0[j]; }
        *(LAS v4u*)(XwT + d * 8704 + p * 136 + 8 * v) = pack8(f); }
    __syncthreads();
    {
        const int m0 = 32 * (wave >> 2), n0 = 32 * (wave & 3); Acc32 y; acc_zero(y); wave_mma32<15, -1>(y, Xt, 136, Wl, 136, m0, n0, 128, lane);
        const float dsum = dsc;
        float* YMB = (float*)(ws + WS_YMB);
#pragma unroll
        for (int a = 0; a < 2; ++a)
#pragma unroll
            for (int bq = 0; bq < 2; ++bq) { const int p = m0 + 16 * a + 4 * (lane >> 4), i = n0 + 16 * bq + (lane & 15); f32x4 o = y.v[a][bq];
#pragma unroll
                for (int j = 0; j < 4; ++j) o[j] += bf2f(Xt[(p + j) * 136 + tswz<15>(p + j, i)]) * dsum;
                *(GAS f32x4*)(YMB + (size_t)(row0 + i) * 512 + 64 * h + p) = o; }
    }
    float* CSM = (float*)(ws + WS_CSM);
#pragma unroll
    for (int d = 0; d < 2; ++d) {
        const int m0 = 32 * (wave >> 1), n0 = 32 * (wave & 1); Acc32 s; acc_zero(s); wave_mma32<15, -1>(s, BmT, 136, XwT + d * 8704, 136, m0, n0, 128, lane);
        float* cs = CSM + ((((size_t)b * NCH_M + c) * 2 + d) * 8 + h) * 8192;
#pragma unroll
        for (int a = 0; a < 2; ++a)
#pragma unroll
            for (int bq = 0; bq < 2; ++bq) { const int n = m0 + 16 * a + 4 * (lane >> 4), p = n0 + 16 * bq + (lane & 15); *(GAS f32x4*)(cs + p * 128 + n) = s.v[a][bq]; }
    }
    if (tid < 256) { const int d = tid >> 7, t = tid & 127; ((float*)(ws + WS_EA))[(size_t)(row0 + t) * 16 + d * 8 + h] = __expf(sm[256 + d * 128 + t]); }
    if (tid < 2) ((float*)(ws + WS_ALAST))[(((size_t)b * NCH_M + c) * 2 + tid) * 8 + h] = tid ? al1 : al0;
    __syncthreads();
    }
#undef MG_ISSUE
}

__device__ __forceinline__ void m1_gla_item(KA A, LAS unsigned char* lds, int l, int item, int tid, int wave, int lane) {
    unsigned char* ws = A->ws; const bf16* P = (const bf16*)(ws + WS_P);
    const int cgi = item >> 2, h = item & 3; const int b = cgi / NCH_G, c = cgi % NCH_G, row0 = b * TB + c * 64;
    LAS float* G = (LAS float*)lds;
    LAS float* wgs = (LAS float*)(lds + 33280);
    LAS float* bgs = (LAS float*)(lds + 41472);
    lbf16* Qs = (lbf16*)(lds + 41984); lbf16* Ks = (lbf16*)(lds + 60416); lbf16* KsT = (lbf16*)(lds + 78848); lbf16* Vt = (lbf16*)(lds + 97280); lbf16* Att = (lbf16*)(lds + 115712);
    float wg4[4]; float bg1 = 0.f; f32x4 glv[4]; v4u qv, kv8, vv2[2];
#pragma unroll
    for (int it = 0; it < 4; ++it) { const int i = tid + it * NTHR; const int d = i >> 10, r = (i >> 6) & 15, k = i & 63; wg4[it] = A->in[I_GLAWG][(((size_t)l * 2 + d) * 16 + r) * 256 + 64 * h + k]; }
    if (tid < 128) bg1 = A->in[I_GLABG][((size_t)l * 2 + (tid >> 6)) * 256 + 64 * h + (tid & 63)];
    { const int d = tid >> 8, t = (tid >> 2) & 63; const GAS f32x4* p = (const GAS f32x4*)((const float*)(ws + WS_PS) + (size_t)(row0 + t) * NSM + 16 + d * 16);
#pragma unroll
      for (int e = 0; e < 4; ++e) glv[e] = p[e]; }
    { const int t = tid >> 3, kv = tid & 7; qv = *(const GAS v4u*)(P + (size_t)(row0 + t) * NP + C_Q + 64 * h + 8 * kv); kv8 = *(const GAS v4u*)(P + (size_t)(row0 + t) * NP + C_K + 64 * h + 8 * kv); }
#pragma unroll
    for (int it = 0; it < 2; ++it) { const int task = tid + it * NTHR; const int t = task >> 4, vv = task & 15; vv2[it] = *(const GAS v4u*)(P + (size_t)(row0 + t) * NP + C_V + 128 * h + 8 * vv); }
    SCHED_FENCE();
#pragma unroll
    for (int it = 0; it < 4; ++it) wgs[tid + it * NTHR] = wg4[it];
    if (tid < 128) bgs[tid] = bg1;
    __syncthreads();
    {   const int d = tid >> 8, t = (tid >> 2) & 63, kq = tid & 3;
        float gl[16];
#pragma unroll
        for (int e = 0; e < 4; ++e) { const f32x4 f = glv[e]; gl[4 * e] = f.x; gl[4 * e + 1] = f.y; gl[4 * e + 2] = f.z; gl[4 * e + 3] = f.w; }
        f32x4 acc[4] = {{0.f, 0.f, 0.f, 0.f}, {0.f, 0.f, 0.f, 0.f}, {0.f, 0.f, 0.f, 0.f}, {0.f, 0.f, 0.f, 0.f}};
#pragma unroll
        for (int r = 0; r < 16; ++r) { const LAS f32x4* w = (const LAS f32x4*)(wgs + (d * 16 + r) * 64 + kq * 16);
#pragma unroll
            for (int q = 0; q < 4; ++q) acc[q] += w[q] * gl[r]; }
#pragma unroll
        for (int q = 0; q < 4; ++q)
#pragma unroll
            for (int e = 0; e < 4; ++e) { const int k = kq * 16 + 4 * q + e; G[(d * 64 + t) * 65 + k] = logsig_f(acc[q][e] + bgs[d * 64 + k]) * (1.f / 16.f); }
    }
    __syncthreads();
#pragma unroll 4
    for (int ci = 0; ci < 128 / NWAVES; ++ci) { const int col = wave + ci * NWAVES;
        const int d = col >> 6, k = col & 63; float S = G[(d * 64 + lane) * 65 + k];
        if (d == 0) {
#pragma unroll
            for (int off = 1; off < 64; off <<= 1) { const float y = __shfl_up(S, off); if (lane >= off) S += y; }
        } else {
#pragma unroll
            for (int off = 1; off < 64; off <<= 1) { const float y = __shfl_down(S, off); if (lane + off < 64) S += y; }
        }
        G[(d * 64 + lane) * 65 + k] = S; }
    __syncthreads();
    {   const int t = tid >> 3, kv = tid & 7; float qf[8], kf[8];
        unpack8(qv, qf); unpack8(kv8, kf);
        bf16* QE = (bf16*)(ws + WS_QE);
#pragma unroll
        for (int d = 0; d < 2; ++d) { float qs[8], ks[8], qe[8];
#pragma unroll
            for (int e = 0; e < 8; ++e) { const int k = 8 * kv + e; const float gv = G[(d * 64 + t) * 65 + k], gref = G[(d * 64 + (d ? 31 : 32)) * 65 + k], glast = G[(d * 64 + (d ? 0 : 63)) * 65 + k];
                const float q = qf[e] * 0.125f; qs[e] = q * __expf(gv - gref); ks[e] = kf[e] * __expf(gref - gv); qe[e] = q * __expf(gv);
                KsT[d * 4608 + k * 72 + tswz<7>(k, t)] = (unsigned short)f2bf(kf[e] * __expf(glast - gv)); }
            *(LAS v4u*)(Qs + d * 4608 + t * 72 + 8 * kv) = pack8(qs); *(LAS v4u*)(Ks + d * 4608 + t * 72 + 8 * kv) = pack8(ks);
            *(GAS v4u*)(QE + (size_t)(row0 + t) * 512 + d * 256 + 64 * h + 8 * kv) = pack8(qe); }
    }
#pragma unroll
    for (int it = 0; it < 2; ++it) { const int task = tid + it * NTHR; const int t = task >> 4, vv = task & 15; float f[8]; unpack8(vv2[it], f);
#pragma unroll
        for (int e = 0; e < 8; ++e) Vt[(8 * vv + e) * 72 + tswz<7>(8 * vv + e, t)] = (unsigned short)f2bf(f[e]); }
    if (tid < 128) { const int d = tid >> 6, k = tid & 63; ((float*)(ws + WS_GLAST))[((((size_t)b * NCH_G + c) * 2 + d) * 4 + h) * 64 + k] = G[(d * 64 + (d ? 0 : 63)) * 65 + k]; }
    __syncthreads();
    if (wave < 4) { const int m0 = 32 * (wave >> 1), n0 = 32 * (wave & 1); Acc32 a0, a1; acc_zero(a0); acc_zero(a1);
        wave_mma32(a0, Qs, 72, Ks, 72, m0, n0, 64, lane); wave_mma32(a1, Qs + 4608, 72, Ks + 4608, 72, m0, n0, 64, lane);
#pragma unroll
        for (int a = 0; a < 2; ++a)
#pragma unroll
            for (int bq = 0; bq < 2; ++bq) { const int jj = n0 + 16 * bq + (lane & 15);
#pragma unroll
                for (int j = 0; j < 4; ++j) { const int i = m0 + 16 * a + 4 * (lane >> 4) + j; const float val = (jj <= i ? a0.v[a][bq][j] : 0.f) + (jj >= i ? a1.v[a][bq][j] : 0.f); Att[i * 72 + jj] = (unsigned short)f2bf(val); } }
    }
    __syncthreads();
    const int m0 = 32 * (wave >> 1), n0 = 32 * (wave & 1);
    {   Acc32 o; acc_zero(o); wave_mma32<7, -1>(o, Vt, 72, Att, 72, m0, n0, 64, lane);
        float* YG = (float*)(ws + WS_YGLA);
#pragma unroll
        for (int a = 0; a < 2; ++a)
#pragma unroll
            for (int bq = 0; bq < 2; ++bq) { const int v = m0 + 16 * a + 4 * (lane >> 4), i = n0 + 16 * bq + (lane & 15); *(GAS f32x4*)(YG + (size_t)(row0 + i) * 512 + 128 * h + v) = o.v[a][bq]; }
    }
    float* CSG = (float*)(ws + WS_CSG);
#pragma unroll
    for (int d = 0; d < 2; ++d) { Acc32 s; acc_zero(s); wave_mma32<7, 7>(s, Vt, 72, KsT + d * 4608, 72, m0, n0, 64, lane);
        float* cs = CSG + ((((size_t)b * NCH_G + c) * 2 + d) * 4 + h) * 8192;
#pragma unroll
        for (int a = 0; a < 2; ++a)
#pragma unroll
            for (int bq = 0; bq < 2; ++bq) { const int v = m0 + 16 * a + 4 * (lane >> 4), k = n0 + 16 * bq + (lane & 15); *(GAS f32x4*)(cs + k * 128 + v) = s.v[a][bq]; }
    }
    __syncthreads();
}

__device__ __forceinline__ void m2_phase(KA A, int wave, int lane, int bid, int G) {
    unsigned char* ws = A->ws; const int gw = bid * NWAVES + wave, NGW = G * NWAVES;
    float* CSM = (float*)(ws + WS_CSM); const float* AL = (const float*)(ws + WS_ALAST);
    for (int line = gw; line < BATCH * 2 * 8 * 64; line += NGW) {
        const int p = line & 63, h = (line >> 6) & 7, d = (line >> 9) & 1, b = line >> 10;
        float c0[NCH_M], c1[NCH_M], dc[NCH_M];
#pragma unroll
        for (int i = 0; i < NCH_M; ++i) { const int c = d == 0 ? i : (i < 2 ? 1 - i : NCH_M + 1 - i);
            const float* cs = CSM + (((((size_t)b * NCH_M + c) * 2 + d) * 8 + h) * 64 + p) * 128;
            c0[i] = cs[lane]; c1[i] = cs[lane + 64]; dc[i] = AL[(((size_t)b * NCH_M + c) * 2 + d) * 8 + h]; }
        SCHED_FENCE();
        float s0 = 0.f, s1 = 0.f;
#pragma unroll
        for (int i = 0; i < NCH_M; ++i) { const int c = d == 0 ? i : (i < 2 ? 1 - i : NCH_M + 1 - i);
            bf16* ss = (bf16*)(ws + WS_SSM) + (((((size_t)b * NCH_M + c) * 2 + d) * 8 + h) * 64 + p) * 128;
            ss[lane] = (unsigned short)f2bf(s0); ss[lane + 64] = (unsigned short)f2bf(s1); const float dec = __expf(dc[i]); s0 = dec * s0 + c0[i]; s1 = dec * s1 + c1[i]; }
    }
    float* CSG = (float*)(ws + WS_CSG); const float* GL = (const float*)(ws + WS_GLAST);
    for (int line = gw; line < BATCH * 2 * 4 * 64; line += NGW) {
        const int k = line & 63, h = (line >> 6) & 3, d = (line >> 8) & 1, b = line >> 9;
        float s0 = 0.f, s1 = 0.f;
#pragma unroll
        for (int half = 0; half < 2; ++half) {
            float c0[34], c1[34], dc[34];
#pragma unroll
            for (int ii = 0; ii < 34; ++ii) { const int i = half * 34 + ii; const int c = d == 0 ? i : (i < 4 ? 3 - i : NCH_G + 3 - i);
                const float* cs = CSG + (((((size_t)b * NCH_G + c) * 2 + d) * 4 + h) * 64 + k) * 128;
                c0[ii] = cs[lane]; c1[ii] = cs[lane + 64]; dc[ii] = GL[((((size_t)b * NCH_G + c) * 2 + d) * 4 + h) * 64 + k]; }
            SCHED_FENCE();
#pragma unroll
            for (int ii = 0; ii < 34; ++ii) { const int i = half * 34 + ii; const int c = d == 0 ? i : (i < 4 ? 3 - i : NCH_G + 3 - i);
                bf16* ss = (bf16*)(ws + WS_SSG) + (((((size_t)b * NCH_G + c) * 2 + d) * 4 + h) * 64 + k) * 128;
                ss[lane] = (unsigned short)f2bf(s0); ss[lane + 64] = (unsigned short)f2bf(s1); const float dec = __expf(dc[ii]); s0 = dec * s0 + c0[ii]; s1 = dec * s1 + c1[ii]; }
        }
    }
}

__device__ __forceinline__ void m3_mamba_item(KA A, LAS unsigned char* lds, int l, int item, int tid, int wave, int lane) {
    unsigned char* ws = A->ws; const bf16* P = (const bf16*)(ws + WS_P);
    const int cc = item >> 3, h = item & 7, g = h >> 2; const int b = cc / NCH_M, c = cc % NCH_M, row0 = b * TB + c * 128;
    const float* cw = A->in[I_MBCW] + (size_t)l * 3 * 1024; const float* cb = A->in[I_MBCB] + (size_t)l * 1024;
    lbf16* Sc = (lbf16*)lds; lbf16* Cc = (lbf16*)(lds + 33792);
    const bf16* CSM = (const bf16*)(ws + WS_SSM); const float* EA = (const float*)(ws + WS_EA);
    {   unsigned long long s[8]; ConvIn x[4]; float e0[4], e1[4]; const int v = tid & 15; ConvW w;
#pragma unroll
        for (int it = 0; it < 8; ++it) { const int task = tid + it * NTHR; const int d = task >> 11, p = (task >> 5) & 63, n4 = task & 31;
            s[it] = *(const GAS unsigned long long*)(CSM + (((((size_t)b * NCH_M + c) * 2 + d) * 8 + h) * 64 + p) * 128 + 4 * n4); }
#pragma unroll
        for (int it = 0; it < 4; ++it) { const int i = (tid >> 4) + 32 * it; convin_load(x[it], P, row0 + i, C_CM + 128 * g + 8 * v);
            e0[it] = EA[(size_t)(row0 + i) * 16 + h]; e1[it] = EA[(size_t)(row0 + i) * 16 + 8 + h]; }
        convw_load(w, cw, cb, 768 + 128 * g + 8 * v);
        SCHED_FENCE();
#pragma unroll
        for (int it = 0; it < 8; ++it) { const int task = tid + it * NTHR; const int d = task >> 11, p = (task >> 5) & 63, n4 = task & 31;
            *(LAS unsigned long long*)(Sc + p * 264 + d * 128 + 4 * n4) = s[it]; }
#pragma unroll
        for (int it = 0; it < 4; ++it) { const int i = (tid >> 4) + 32 * it; float o[8], o1[8]; conv8w(x[it], w, o);
#pragma unroll
            for (int e = 0; e < 8; ++e) { o1[e] = o[e] * e1[it]; o[e] *= e0[it]; }
            *(LAS v4u*)(Cc + i * 264 + 8 * v) = pack8(o); *(LAS v4u*)(Cc + i * 264 + 128 + 8 * v) = pack8(o1); }
    }
    __syncthreads();
    {   const int m0 = 32 * (wave >> 2), n0 = 32 * (wave & 3); Acc32 y; acc_zero(y);
        float* YMB = (float*)(ws + WS_YMB); f32x4 old[2][2];
#pragma unroll
        for (int a = 0; a < 2; ++a)
#pragma unroll
            for (int bq = 0; bq < 2; ++bq) { const int p = m0 + 16 * a + 4 * (lane >> 4), i = n0 + 16 * bq + (lane & 15); old[a][bq] = *(const GAS f32x4*)(YMB + (size_t)(row0 + i) * 512 + 64 * h + p); }
        SCHED_FENCE();
        wave_mma32(y, Sc, 264, Cc, 264, m0, n0, 256, lane);
#pragma unroll
        for (int a = 0; a < 2; ++a)
#pragma unroll
            for (int bq = 0; bq < 2; ++bq) { const int p = m0 + 16 * a + 4 * (lane >> 4), i = n0 + 16 * bq + (lane & 15); *(GAS f32x4*)(YMB + (size_t)(row0 + i) * 512 + 64 * h + p) = old[a][bq] + y.v[a][bq]; }
    }
    __syncthreads();
}
__device__ __forceinline__ void m3_gla_item(KA A, LAS unsigned char* lds, int item, int tid, int wave, int lane) {
    unsigned char* ws = A->ws;
    const int cgi = item >> 2, h = item & 3; const int b = cgi / NCH_G, c = cgi % NCH_G, row0 = b * TB + c * 64;
    lbf16* St = (lbf16*)lds; lbf16* Qc = (lbf16*)(lds + 34816);
    const bf16* CSG = (const bf16*)(ws + WS_SSG); const bf16* QE = (const bf16*)(ws + WS_QE);
    {   unsigned long long s[8]; v4u q[2];
#pragma unroll
        for (int it = 0; it < 8; ++it) { const int task = tid + it * NTHR; const int d = task >> 11, k = (task >> 5) & 63, v4 = task & 31;
            s[it] = *(const GAS unsigned long long*)(CSG + (((((size_t)b * NCH_G + c) * 2 + d) * 4 + h) * 64 + k) * 128 + 4 * v4); }
#pragma unroll
        for (int it = 0; it < 2; ++it) { const int task = tid + it * NTHR; const int i = task >> 4, d = (task >> 3) & 1, kv = task & 7;
            q[it] = *(const GAS v4u*)(QE + (size_t)(row0 + i) * 512 + d * 256 + 64 * h + 8 * kv); }
        SCHED_FENCE();
#pragma unroll
        for (int it = 0; it < 8; ++it) { const int task = tid + it * NTHR; const int d = task >> 11, k = (task >> 5) & 63, v4 = task & 31;
#pragma unroll
            for (int e = 0; e < 4; ++e) St[(4 * v4 + e) * 136 + tswz<15>(4 * v4 + e, d * 64 + k)] = (unsigned short)(s[it] >> (16 * e)); }
#pragma unroll
        for (int it = 0; it < 2; ++it) { const int task = tid + it * NTHR; const int i = task >> 4, d = (task >> 3) & 1, kv = task & 7; *(LAS v4u*)(Qc + i * 136 + d * 64 + 8 * kv) = q[it]; }
    }
    __syncthreads();
    {   const int m0 = 32 * (wave >> 1), n0 = 32 * (wave & 1); Acc32 o; acc_zero(o);
        float* YG = (float*)(ws + WS_YGLA); f32x4 old[2][2];
#pragma unroll
        for (int a = 0; a < 2; ++a)
#pragma unroll
            for (int bq = 0; bq < 2; ++bq) { const int v = m0 + 16 * a + 4 * (lane >> 4), i = n0 + 16 * bq + (lane & 15); old[a][bq] = *(const GAS f32x4*)(YG + (size_t)(row0 + i) * 512 + 128 * h + v); }
        SCHED_FENCE();
        wave_mma32<15, -1>(o, St, 136, Qc, 136, m0, n0, 128, lane);
#pragma unroll
        for (int a = 0; a < 2; ++a)
#pragma unroll
            for (int bq = 0; bq < 2; ++bq) { const int v = m0 + 16 * a + 4 * (lane >> 4), i = n0 + 16 * bq + (lane & 15); *(GAS f32x4*)(YG + (size_t)(row0 + i) * 512 + 128 * h + v) = old[a][bq] + o.v[a][bq]; }
    }
    __syncthreads();
}

struct M4Row { f32x4 y[2], o[2]; v4u zz, gz; };
__device__ __forceinline__ void m4_load(M4Row& r, const float* YMB, const float* YG, const bf16* P, int row, int lane) {
    const bf16* p = P + (size_t)row * NP; const int idx = 8 * lane;
#pragma unroll
    for (int hh = 0; hh < 2; ++hh) { r.y[hh] = *(const GAS f32x4*)(YMB + (size_t)row * 512 + idx + 4 * hh); r.o[hh] = *(const GAS f32x4*)(YG + (size_t)row * 512 + idx + 4 * hh); }
    r.zz = *(const GAS v4u*)(p + C_Z + idx); r.gz = *(const GAS v4u*)(p + C_G + idx);
}
__device__ __forceinline__ void m4_phase(KA A, int l, int wave, int lane, int bid, int G) {
    unsigned char* ws = A->ws; const bf16* P = (const bf16*)(ws + WS_P); bf16* YM = (bf16*)(ws + WS_YMIX);
    const float* YMB = (const float*)(ws + WS_YMB); const float* YG = (const float*)(ws + WS_YGLA);
    const float* mng = A->in[I_MBNG] + (size_t)l * 512; const float* gng = A->in[I_GLANG] + (size_t)l * 128;
    const int idx = 8 * lane;
    f32x4 mg[2], gn[2];
#pragma unroll
    for (int hh = 0; hh < 2; ++hh) { mg[hh] = *(const GAS f32x4*)(mng + idx + 4 * hh); gn[hh] = *(const GAS f32x4*)(gng + ((idx + 4 * hh) & 127)); }
    const int stride = G * NWAVES; int row = bid * NWAVES + wave;
    M4Row rws[5];
#pragma unroll
    for (int k = 0; k < 5; ++k) if (row + k * stride < MR) m4_load(rws[k], YMB, YG, P, row + k * stride, lane);
    SCHED_FENCE();
#pragma unroll
    for (int k = 0; k < 5; ++k) { if (row + k * stride >= MR) break; const M4Row& cur = rws[k]; const int rowk = row + k * stride;
        float z[8], g[8]; unpack8(cur.zz, z); unpack8(cur.gz, g);
        float y[8]; float ss = 0.f;
#pragma unroll
        for (int e = 0; e < 8; ++e) { y[e] = cur.y[e >> 2][e & 3] * silu_f(z[e]); ss += y[e] * y[e]; }
        const float r = __builtin_amdgcn_rsqf(wave_sum(ss) * (1.f / 512.f) + EPS);
        float o1[8];
#pragma unroll
        for (int e = 0; e < 8; ++e) o1[e] = y[e] * r * mg[e >> 2][e & 3];
        *(GAS v4u*)(YM + (size_t)rowk * D + 1024 + idx) = pack8(o1);
        float q = 0.f;
#pragma unroll
        for (int e = 0; e < 8; ++e) { const float ov = cur.o[e >> 2][e & 3]; q += ov * ov; }
        const float rr = __builtin_amdgcn_rsqf(row16_sum(q) * (1.f / 128.f) + EPS);
        float o2[8];
#pragma unroll
        for (int e = 0; e < 8; ++e) o2[e] = cur.o[e >> 2][e & 3] * rr * gn[e >> 2][e & 3] * silu_f(g[e]);
        *(GAS v4u*)(YM + (size_t)rowk * D + 1536 + idx) = pack8(o2);
    }
}

__device__ __forceinline__ void dispatch_phase(KA A, LAS unsigned char* lds, int tid, int wave, int lane, int bid) {
    unsigned char* ws = A->ws;
    LAS int* cnt = (LAS int*)lds;
    LAS int* tab = cnt + 2048;
    const int* gc = (const int*)(ws + WS_CNT);
    { int c4[4];
#pragma unroll
      for (int it = 0; it < 4; ++it) c4[it] = gc[tid + it * NTHR];
      SCHED_FENCE();
#pragma unroll
      for (int it = 0; it < 4; ++it) cnt[tid + it * NTHR] = c4[it]; }
    __syncthreads();
    {
        const int e = tid & 7, w2 = tid >> 3; int tot = 0, pre = 0;
#pragma unroll
        for (int q = 0; q < 4; ++q) { const int w = w2 + 64 * q; const int v = cnt[w * 8 + e]; tot += v; pre += (w < bid) ? v : 0; }
#pragma unroll
        for (int off = 8; off < 64; off <<= 1) { tot += __shfl_xor(tot, off); pre += __shfl_xor(pre, off); }
        LAS int* red = tab + 64;
        if (lane < 8) { red[wave * 16 + lane] = tot; red[wave * 16 + 8 + lane] = pre; }
        __syncthreads();
        if (tid < 8) { int t2 = 0, p2 = 0;
#pragma unroll
            for (int w = 0; w < 8; ++w) { t2 += red[w * 16 + tid]; p2 += red[w * 16 + 8 + tid]; }
            tab[8 + tid] = p2; tab[32 + tid] = (t2 + 255) >> 8; }
    }
    __syncthreads();
    if (tid == 0) { int tb = 0; for (int e = 0; e < 8; ++e) { tab[16 + e] = tb; tab[e] = tb * 256; tb += tab[32 + e]; } tab[24] = tb;
        if (bid == 0) { int* mi = (int*)(ws + WS_MOEINFO); for (int e = 0; e < 9; ++e) mi[e] = tab[16 + e]; } }
    __syncthreads();
    const int4* route = (const int4*)(ws + WS_ROUTE); int* tokpos = (int*)(ws + WS_TOKPOS);
    const bf16* XN = (const bf16*)(ws + WS_XN); bf16* AP = (bf16*)(ws + WS_APERM);
    {   int4 rr[4]; v4u xv[4][2];
#pragma unroll
        for (int k = 0; k < 4; ++k) { const int row = wg_row(bid, wave + NWAVES * k); rr[k] = route[row]; const GAS v4u* src = (const GAS v4u*)((const unsigned char*)XN + (size_t)row * D);
#pragma unroll
            for (int j = 0; j < 2; ++j) xv[k][j] = src[lane + 64 * j]; }
        SCHED_FENCE();
#pragma unroll
        for (int k = 0; k < 4; ++k) { const int row = wg_row(bid, wave + NWAVES * k); const int4 r = rr[k]; const int e1 = r.x & 15, e2 = (r.x >> 4) & 15, r1 = (r.x >> 8) & 255, r2 = (r.x >> 16) & 255;
            const int p1 = tab[e1] + tab[8 + e1] + r1, p2 = tab[e2] + tab[8 + e2] + r2;
            if (lane == 0) { tokpos[row * 2] = p1; tokpos[row * 2 + 1] = p2; }
            GAS v4u* d1 = (GAS v4u*)((unsigned char*)AP + (size_t)p1 * D); GAS v4u* d2 = (GAS v4u*)((unsigned char*)AP + (size_t)p2 * D);
#pragma unroll
            for (int j = 0; j < 2; ++j) { d1[lane + 64 * j] = xv[k][j]; d2[lane + 64 * j] = xv[k][j]; } }
    }
    __syncthreads();
}

__device__ __forceinline__ void combine_phase(KA A, int l, int wave, int lane, int bid, int G) {
    unsigned char* ws = A->ws; const bf16* H = (const bf16*)(ws + WS_H); const bf16* DO = (const bf16*)(ws + WS_DOUT); const bf16* DO2 = (const bf16*)(ws + WS_DOUT2);
    const int4* route = (const int4*)(ws + WS_ROUTE); const int* tokpos = (const int*)(ws + WS_TOKPOS);
    const int2* TT2 = (const int2*)(ws + WS_TT); const bf16* XT = (const bf16*)(ws + WS_XT);
    const float* modl = (const float*)(ws + WS_MODF) + (size_t)l * 3 * ADAW; const float* gf = A->in[I_GFINAL];
    f32x4 gq[4][2]; int bcur = -1;
    f32x4 gfq[4][2];
#pragma unroll
    for (int j = 0; j < 4; ++j) { gfq[j][0] = *(const GAS f32x4*)(gf + 8 * lane + 512 * j); gfq[j][1] = *(const GAS f32x4*)(gf + 8 * lane + 512 * j + 4); }
    int4 rn = make_int4(0, 0, 0, 0); int p1n = 0, p2n = 0;
    { const int row = bid * NWAVES + wave; if (row < MR) { rn = route[row]; p1n = tokpos[row * 2]; p2n = tokpos[row * 2 + 1]; } }
    for (int row = bid * NWAVES + wave; row < MR; row += G * NWAVES) { const int b = row / TB, s = row % TB;
        const int4 r = rn; const int p1 = p1n, p2 = p2n;
        { const int nrow = row + G * NWAVES; if (nrow < MR) { rn = route[nrow]; p1n = tokpos[nrow * 2]; p2n = tokpos[nrow * 2 + 1]; } }
        if (s < CTXL) continue;
        const float w1 = __int_as_float(r.y), w2 = __int_as_float(r.z);
        const GAS v4u* a1 = (const GAS v4u*)(DO + (size_t)p1 * D) + lane; const GAS v4u* a2 = (const GAS v4u*)(DO + (size_t)p2 * D) + lane; const GAS v4u* a3 = (const GAS v4u*)(DO2 + (size_t)p1 * D) + lane; const GAS v4u* a4 = (const GAS v4u*)(DO2 + (size_t)p2 * D) + lane;
        const GAS v4u* hr = (const GAS v4u*)(H + (size_t)row * D) + lane; const float* gt = modl + (size_t)b * ADAW + 5 * D + 8 * lane;
        v4u q1[4], q2[4], q3[4], q4[4], hq[4]; int2 t1v[4], t2v[4];
#pragma unroll
        for (int j = 0; j < 4; ++j) { q1[j] = a1[64 * j]; q2[j] = a2[64 * j]; q3[j] = a3[64 * j]; q4[j] = a4[64 * j]; hq[j] = hr[64 * j];
            const int n = 2 * j + (lane >> 5); t1v[j] = TT2[(p1 >> 8) * 8 + n]; t2v[j] = TT2[(p2 >> 8) * 8 + n];
            if (b != bcur) { gq[j][0] = *(const GAS f32x4*)(gt + 512 * j); gq[j][1] = *(const GAS f32x4*)(gt + 512 * j + 4); } }
        bcur = b;
        SCHED_FENCE();
        float v[4][8]; float ss = 0.f;
#pragma unroll
        for (int j = 0; j < 4; ++j) { float e1[8], e2[8], e3[8], e4[8]; unpack8(q1[j], e1); unpack8(q2[j], e2); unpack8(q3[j], e3); unpack8(q4[j], e4);
            {
                const int2 t1 = t1v[j], t2 = t2v[j];
#define CMB_TAIL(tt, p, ev) if (tt) { const int sl = (tt) >> 3, S_ = (tt) & 7; for (int q = 1; q < S_; ++q) { float t8[8]; \
                    unpack8(*(const GAS v4u*)(XT + ((size_t)((sl * 3 + q - 1) * 256 + ((p) & 255)) * 256 + ((8 * lane) & 255))), t8); _Pragma("unroll") for (int e = 0; e < 8; ++e) ev[e] += t8[e]; } }
                CMB_TAIL(t1.x, p1, e1) CMB_TAIL(t1.y, p1, e3) CMB_TAIL(t2.x, p2, e2) CMB_TAIL(t2.y, p2, e4)
#undef CMB_TAIL
            }
            float hf[8]; unpack8(hq[j], hf); const f32x4 g0 = gq[j][0], g1 = gq[j][1];
#pragma unroll
            for (int e = 0; e < 8; ++e) { const float hh = hf[e], gg = e < 4 ? g0[e] : g1[e - 4]; v[j][e] = hh + gg * ((e1[e] + e3[e]) * w1 + (e2[e] + e4[e]) * w2); ss += v[j][e] * v[j][e]; } }
        const float rstd = __builtin_amdgcn_rsqf(wave_sum(ss) * (1.f / D) + EPS);
        float* o = A->out + (size_t)(b * SEQ + s - CTXL) * D + 8 * lane;
#pragma unroll
        for (int j = 0; j < 4; ++j) { const f32x4 f0 = gfq[j][0], f1 = gfq[j][1];
            *(GAS f32x4*)(o + 512 * j) = (f32x4){v[j][0] * rstd * f0[0], v[j][1] * rstd * f0[1], v[j][2] * rstd * f0[2], v[j][3] * rstd * f0[3]};
            *(GAS f32x4*)(o + 512 * j + 4) = (f32x4){v[j][4] * rstd * f1[0], v[j][5] * rstd * f1[1], v[j][6] * rstd * f1[2], v[j][7] * rstd * f1[3]}; }
    }
}
constexpr int CT_INPROJ0_HI = 8596, CT_FFNUP_HI = 19596, CT_INPROJ1_HI = 25600;
__device__ __forceinline__ void ph_inproj(LAS unsigned char* lds, unsigned char* ws, int l, int bid, int tid) {
    pg8::Gemm g{(const pg8::bf16_t*)(ws + WS_XN), (const pg8::bf16_t*)(ws + WS_WIN) + (size_t)l * NP * D, MR, NP, D};
    pg8::MixOrder<NP / 256, D / 64, 1, D, 12, 10, true> S{l ? 32 : NMT, bid, l, l ? 24 : 0, pg8::ConvHook{l ? CT_FFNUP_HI : CT_P0A_HI, l ? CT_INPROJ1_HI : CT_INPROJ0_HI, bid & 1}};
    pg8::EpiP E{ws};
    pg8::gemm_phase<pg8::EpiP, decltype(S), true, true>(lds + RING_OFF, g, S, E, tid);
}
__device__ __forceinline__ void ph_outproj(LAS unsigned char* lds, unsigned char* ws, const float* x, int l, int bid, int tid) {
    pg8::Gemm g{(const pg8::bf16_t*)(ws + WS_YMIX), (const pg8::bf16_t*)(ws + WS_WOUT) + (size_t)l * D * D, MR, D, D};
    pg8::MixOrder<D / 256, D / 64, 4, 512, 8, 0> S{32, bid, 1, l == 0 ? 16 : 0, pg8::ConvHook{0, 0, -1}};
    pg8::EpiRes E{ws, l == 0 ? x : nullptr, l, 2};
    pg8::gemm_phase<pg8::EpiRes, decltype(S), true, true>(lds + RING_OFF, g, S, E, tid);
}
__device__ __forceinline__ void ph_ffnup(LAS unsigned char* lds, unsigned char* ws, int bid, int tid) {
    pg8::Gemm g{(const pg8::bf16_t*)(ws + WS_XN), (const pg8::bf16_t*)(ws + WS_FUP), MR, 2 * FF, D};
    pg8::MixOrder<2 * FF / 256, D / 64, 1, D, 1, 0, true> S{NMT, bid, 0, 0, pg8::ConvHook{CT_INPROJ0_HI, CT_FFNUP_HI, bid % 5}};
    pg8::EpiSwiglu E{(pg8::bf16_t*)(ws + WS_ACT), FF, 2 * FF / 256};
    pg8::gemm_phase<pg8::EpiSwiglu, decltype(S), true, true>(lds + RING_OFF, g, S, E, tid);
}
__device__ __forceinline__ void ph_ffndn(LAS unsigned char* lds, unsigned char* ws, int bid, int tid) {
    pg8::Gemm g{(const pg8::bf16_t*)(ws + WS_ACT), (const pg8::bf16_t*)(ws + WS_FDN), MR, D, FF};
    pg8::MixOrder<D / 256, FF / 64, 11, 512, 8, 0> S{32, bid, 1, 16, pg8::ConvHook{0, 0, -1}};
    pg8::EpiRes E{ws, nullptr, 0, 5};
    pg8::gemm_phase<pg8::EpiRes, decltype(S), true, true>(lds + RING_OFF, g, S, E, tid);
}
__device__ __forceinline__ void ph_moeup(LAS unsigned char* lds, unsigned char* ws, int bid, int tid) {
    pg8::Gemm g{(const pg8::bf16_t*)(ws + WS_APERM), (const pg8::bf16_t*)(ws + WS_MUP), 0, 0, D};
    pg8::MoeOrder<2 * FFE / 256, 1, D, 128> S{(const int*)(ws + WS_MOEINFO), bid};
    pg8::EpiSwiglu8 E{ws + WS_ACTM, FFE, 2 * FFE / 256};
    static_assert(ACT8_SCALE == 4.f && SC_W8UP == SC_W8 + 0x02020202, "the up half's block scale carries ACT8_SCALE");
    pg8::gemm_phase_f8<pg8::EpiSwiglu8, decltype(S), SC_W8, SC_XN8, SC_W8UP>(lds + RING_OFF, g, S, E, tid);
}
__device__ __forceinline__ void ph_moedn(LAS unsigned char* lds, unsigned char* ws, int bid, int tid) {
    pg8::Gemm g{(const pg8::bf16_t*)(ws + WS_ACTM), (const pg8::bf16_t*)(ws + WS_MDN), 0, 0, FFE};
    pg8::MoeOrder<D / 256, 2, FFE / 2, 128> S{(const int*)(ws + WS_MOEINFO), bid};
    pg8::EpiBf16g8 E{(pg8::bf16_t*)(ws + WS_DOUT), (pg8::bf16_t*)(ws + WS_DOUT2), (pg8::bf16_t*)(ws + WS_XT), (int*)(ws + WS_TT), D, D / 256};
    pg8::gemm_phase_f8<pg8::EpiBf16g8, decltype(S), SC_W8, SC_ACT8>(lds + RING_OFF, g, S, E, tid);
}

#ifndef MK_PER_PHASE
#define MK_PER_PHASE 0
#endif
constexpr int NPH = 24;
__global__ void __launch_bounds__(NTHR, 2) mk_fwd(Args args_unused) {
    extern __shared__ __attribute__((aligned(16))) unsigned char lds_raw[];
    LAS unsigned char* lds = (LAS unsigned char*)lds_raw;
    const int tid0 = threadIdx.x, bid0 = blockIdx.x, G0 = gridDim.x;
#define FRESH() int tid = tid0; asm volatile("" : "+v"(tid)); int bid = bid0, G = G0; asm volatile("" : "+s"(bid), "+s"(G)); const int lane = tid & 63, wave = __builtin_amdgcn_readfirstlane(tid >> 6); (void)lane; (void)wave; (void)bid; (void)G
    const int tid = tid0;
    volatile LAS unsigned* MISC = (volatile LAS unsigned*)(lds + MISC_OFF);
    for (int u = tid; u < (LDS_BYTES - LDSCTL_OFF) / 4; u += NTHR) ((LAS unsigned*)(lds + LDSCTL_OFF))[u] = 0u;
    __syncthreads();
    int lo, hi;
    XcdBarrier bar;
    { FRESH(); KA A = ka_get(); lo = A->ph_lo; hi = A->ph_hi; gu32* ctl = (gu32*)(A->ws + WS_CTL);
      bar.bar = (unsigned*)(ctl + CW_BAR); bar.x = 0; bar.st = nullptr;
      if (!MK_PER_PHASE) bar = xcd_barrier_post((unsigned*)(ctl + CW_BAR), MISC + 8); }
#define IN(k) (lo <= (k) && (k) < hi)
#define SEAM(k) do { if (!MK_PER_PHASE && IN(k) && IN((k) + 1)) xcd_barrier(bar); } while (0)

    if (IN(0)) { FRESH(); KA A = ka_get(); p0a_phase(A, lds, tid, wave, lane, bid, G); SEAM(0); }
    if (IN(1)) { FRESH(); KA A = ka_get(); p0b_phase(A, tid, bid, G); SEAM(1); }

    for (int l = 0; l < 2; ++l) {
        const int pb = 2 + 10 * l;
        if (IN(pb + 0)) { FRESH(); KA A = ka_get(); norm_phase<false, true>(A, lds, l, 0, l ? 11 : 0, (const float*)(A->ws + WS_MODF) + 2 * ADAW + 5 * D, tid, wave, lane, bid); SEAM(pb + 0); }
        if (IN(pb + 1)) { FRESH(); KA A = ka_get(); ph_inproj(lds, A->ws, l, bid, tid); SEAM(pb + 1); }
        if (IN(pb + 2)) {
            { const int c = bid0;
              for (int k = 0; k < 5; ++k) { FRESH(); KA A = ka_get(); int ty = -1, ix = 0;
                if (c < 136) { if (k == 0) { ty = 0; ix = c; } else if (c < 32) { if (k == 1) { ty = 2; ix = 240 + c; } } else if (c < 124) { if (k < 3) { ty = 1; ix = 360 + (c - 32) * 2 + (k - 1); } } }
                else { if (k < 3) { ty = 1; ix = (c - 136) * 3 + k; } else { ty = 2; ix = (c - 136) * 2 + (k - 3); } }
                if (ty == 0) m1_mamba_group(A, lds, l, ix, tid, wave, lane);
                else if (ty == 1) m1_gla_item(A, lds, l, ix, tid, wave, lane);
                else if (ty == 2) m1_sccm_item(A, lds, l, ix, tid, wave, lane); } }
            SEAM(pb + 2);
        }
        if (IN(pb + 3)) { FRESH(); KA A = ka_get(); m2_phase(A, wave, lane, bid, G); SEAM(pb + 3); }
        if (IN(pb + 4)) {
            { const int c = bid0;
              for (int k = 0; k < 5; ++k) { FRESH(); KA A = ka_get(); int ty = -1, ix = 0;
                if (c < 96) { if (k < 3) { ty = 0; ix = 3 * c + k; } else if (k == 3) { ty = 1; ix = c; } }
                else if (c < 192) { if (k < 2) { ty = 0; ix = 288 + 2 * (c - 96) + k; } else if (k < 4) { ty = 1; ix = 96 + 2 * (c - 96) + (k - 2); } }
                else { if (k == 0) { ty = 0; ix = 480 + (c - 192); } else { ty = 1; ix = 288 + 4 * (c - 192) + (k - 1); } }
                if (ty == 0) m3_mamba_item(A, lds, l, ix, tid, wave, lane);
                else if (ty == 1) m3_gla_item(A, lds, ix, tid, wave, lane); } }
            SEAM(pb + 4);
        }
        if (IN(pb + 5)) { FRESH(); KA A = ka_get(); m4_phase(A, l, wave, lane, bid, G); SEAM(pb + 5); }
        if (IN(pb + 6)) { FRESH(); KA A = ka_get(); ph_outproj(lds, A->ws, A->in[I_X], l, bid, tid); SEAM(pb + 6); }
        if (l == 0) {
            if (IN(9)) { FRESH(); KA A = ka_get(); norm_phase<false, false>(A, lds, 0, 1, 4, (const float*)(A->ws + WS_MODF) + 2 * ADAW + 2 * D, tid, wave, lane, bid); SEAM(9); }
            if (IN(10)) { FRESH(); KA A = ka_get(); ph_ffnup(lds, A->ws, bid, tid); SEAM(10); }
            if (IN(11)) { FRESH(); KA A = ka_get(); ph_ffndn(lds, A->ws, bid, tid); SEAM(11); }
        } else {
            if (IN(19)) { FRESH(); KA A = ka_get(); norm_phase<true, false>(A, lds, 1, 1, 0, nullptr, tid, wave, lane, bid); SEAM(19); }
            if (IN(20)) { FRESH(); KA A = ka_get(); dispatch_phase(A, lds, tid, wave, lane, bid); SEAM(20); }
            if (IN(21)) { FRESH(); KA A = ka_get(); ph_moeup(lds, A->ws, bid, tid); SEAM(21); }
            if (IN(22)) { FRESH(); KA A = ka_get(); ph_moedn(lds, A->ws, bid, tid); SEAM(22); }
            if (IN(23)) { FRESH(); KA A = ka_get(); combine_phase(A, 1, wave, lane, bid, G); }
        }
    }
#undef IN
#undef SEAM
}

extern "C" void kernel_launch(void* const* d_in, const int* in_sizes, int n_in, void* d_out, int out_size, void* d_ws, size_t ws_size, hipStream_t stream) {
    static int grid = 0;
    if (grid == 0) {
        if (n_in != N_IN || out_size != BATCH * SEQ * D || ws_size < WS_END) { fprintf(stderr, "kernel_launch: unexpected shapes: n_in %d out %d ws %zu (need %zu)\n", n_in, out_size, ws_size, (size_t)WS_END); grid = -1; return; }
        int dev = 0, cus = 0, per_cu = 0;
        if (hipGetDevice(&dev) != hipSuccess || hipDeviceGetAttribute(&cus, hipDeviceAttributeMultiprocessorCount, dev) != hipSuccess) { grid = -1; return; }
        if (hipFuncSetAttribute((const void*)mk_fwd, hipFuncAttributeMaxDynamicSharedMemorySize, LDS_BYTES) != hipSuccess) { fprintf(stderr, "kernel_launch: hipFuncSetAttribute failed\n"); grid = -1; return; }
        if (hipOccupancyMaxActiveBlocksPerMultiprocessor(&per_cu, (const void*)mk_fwd, NTHR, LDS_BYTES) != hipSuccess || per_cu < 1) fprintf(stderr, "kernel_launch: occupancy query says %d\n", per_cu);
        (void)hipGetLastError();
        grid = cus;
        if (grid != 256) { fprintf(stderr, "kernel_launch: built for 256 CUs, device has %d\n", grid); grid = -1; return; }
    }
    if (grid < 0) return;
    if (hipMemsetAsync((char*)d_ws + WS_CTL, 0, CTL_ZERO_BYTES, stream) != hipSuccess) return;
    Args a{};
    for (int i = 0; i < N_IN; ++i) a.in[i] = (const float*)d_in[i];
    a.out = (float*)d_out; a.ws = (unsigned char*)d_ws;
#if MK_PER_PHASE
    for (int p = 0; p < NPH; ++p) { a.ph_lo = p; a.ph_hi = p + 1; hipLaunchKernelGGL(mk_fwd, dim3(grid), dim3(NTHR), LDS_BYTES, stream, a); }
#else
    a.ph_lo = 0; a.ph_hi = NPH; hipLaunchKernelGGL(mk_fwd, dim3(grid), dim3(NTHR), LDS_BYTES, stream, a);
#endif
    const hipError_t le = hipPeekAtLastError();
    if (le != hipSuccess) fprintf(stderr, "kernel_launch: launch failed: %s\n", hipGetErrorName(le));
}
```
